# Optimizing an MI355X kernel written in HIP

```python
import jax, jax.numpy as jnp
from jax import lax
import numpy as np

D_MODEL = 1024
BATCH = 32
SEQ = 2048
DEPTH = 2

HEAD_DIM = 64
N_HEADS_A = 8
N_HEADS_B = 8
WIDTH_AB = (N_HEADS_A + N_HEADS_B) * HEAD_DIM
IN_AB = 3 * WIDTH_AB + N_HEADS_B
DILATED_CONFIGS = ((128, 1), (512, 4), (2048, 16))
ROPE_THETA = 500000.0
ROPE_DIM = HEAD_DIM // 4
BLOCK = 128
HGRN_EXPAND = 128
N_HEADS_C = D_MODEL // HGRN_EXPAND
HGRN_DK = HGRN_EXPAND
HGRN_DV = D_MODEL // N_HEADS_C
HGRN_CHUNK = 64
D_FF = 2816
N_EXPERTS = 8
TOP_K = 2
D_FF_EXPERT = 3584
N_EVEN = (DEPTH + 1) // 2
N_ODD = DEPTH // 2
EPS = 1e-6

kernel_name = "hybrid_dilated_fox_hgrn2_moe"


def _rmsnorm(x, gain):
    x32 = x.astype(jnp.float32)
    y = x32 * lax.rsqrt(jnp.mean(x32 * x32, axis=-1, keepdims=True) + EPS)
    return (y * gain.astype(jnp.float32)).astype(x.dtype)


def _partial_rope(x, positions):
    half = ROPE_DIM // 2
    inv_freq = jnp.power(jnp.float32(ROPE_THETA), -jnp.arange(half, dtype=jnp.float32) / half)
    ang = positions.astype(jnp.float32)[..., None] * inv_freq
    cos = jnp.cos(ang)[:, :, None, :]
    sin = jnp.sin(ang)[:, :, None, :]
    xr = x[..., :ROPE_DIM].astype(jnp.float32)
    x1, x2 = xr[..., :half], xr[..., half:]
    rot = jnp.concatenate([x1 * cos - x2 * sin, x2 * cos + x1 * sin], axis=-1)
    return jnp.concatenate([rot.astype(x.dtype), x[..., ROPE_DIM:]], axis=-1)


def _dilated_branch(q, k, v, window, dilation):
    B_, H_, S_, Dh = q.shape
    r = dilation
    n = window // dilation
    assert n <= BLOCK
    L = S_ // r
    nb = -(-L // BLOCK)
    Lp = nb * BLOCK

    def to_sub(t):
        t = t.reshape(B_, H_, L, r, Dh).transpose(0, 1, 3, 2, 4)
        t = jnp.pad(t, ((0, 0), (0, 0), (0, 0), (0, Lp - L), (0, 0)))
        return t.reshape(B_, H_, r, nb, BLOCK, Dh)

    def band(t):
        prev = jnp.pad(t[:, :, :, :-1], ((0, 0), (0, 0), (0, 0), (1, 0), (0, 0), (0, 0)))
        return jnp.concatenate([prev, t], axis=-2)

    qs = to_sub(q)
    kb = band(to_sub(k))
    vb = band(to_sub(v))
    logits = jnp.einsum('bhrnqd,bhrnkd->bhrnqk', qs, kb).astype(jnp.float32)
    qi = jnp.arange(BLOCK)[:, None]
    kj = jnp.arange(2 * BLOCK)[None, :]
    dist = BLOCK + qi - kj
    key_pos = (jnp.arange(nb)[:, None, None] - 1) * BLOCK + kj[None]
    valid = (dist >= 0) & (dist <= n) & (key_pos >= 0)
    logits = jnp.where(valid, logits, -jnp.inf)
    m = jnp.max(logits, axis=-1, keepdims=True)
    e = jnp.exp(logits - m)
    l = jnp.sum(e, axis=-1, keepdims=True)
    o = jnp.einsum('bhrnqk,bhrnkd->bhrnqd', (e / l).astype(v.dtype), vb)
    lse = (m + jnp.log(l))[..., 0]

    def from_sub(t):
        extra = t.shape[5:]
        t = t.reshape((B_, H_, r, Lp) + extra)[:, :, :, :L]
        t = jnp.moveaxis(t, 2, 3)
        return t.reshape((B_, H_, S_) + extra)

    return from_sub(o), from_sub(lse)


def _forgetting_attention(q, k, v, logf):
    B_, H_, S_, Dh = q.shape
    nq = S_ // BLOCK
    c = jnp.cumsum(logf, axis=-1)
    qb = q.reshape(B_, H_, nq, BLOCK, Dh).transpose(2, 0, 1, 3, 4)
    cb = c.reshape(B_, H_, nq, BLOCK).transpose(2, 0, 1, 3)
    kpos = jnp.arange(S_)

    def one_block(args):
        qblk, cblk, j = args
        logits = jnp.einsum('bhqd,bhkd->bhqk', qblk, k).astype(jnp.float32)
        logits = logits + cblk[..., None] - c[:, :, None, :]
        qpos = j * BLOCK + jnp.arange(BLOCK)
        logits = jnp.where(kpos[None, :] <= qpos[:, None], logits, -jnp.inf)
        p = jax.nn.softmax(logits, axis=-1)
        return jnp.einsum('bhqk,bhkd->bhqd', p.astype(v.dtype), v)

    o = lax.map(one_block, (qb, cb, jnp.arange(nq)))
    return o.transpose(1, 2, 0, 3, 4).reshape(B_, H_, S_, Dh)


def _hgrn2_chunkwise(q, k, v, logf):
    B_, H_, S_, dk = q.shape
    dv = v.shape[-1]
    nc = S_ // HGRN_CHUNK

    def chunks(t):
        return t.reshape(B_, H_, nc, HGRN_CHUNK, t.shape[-1]).transpose(2, 0, 1, 3, 4)

    causal = jnp.tril(jnp.ones((HGRN_CHUNK, HGRN_CHUNK), dtype=bool))[:, :, None]

    def step(state, xs):
        qc, kc, vc, gc = xs
        b = jnp.cumsum(gc, axis=-2)
        o_inter = jnp.einsum('bhtd,bhde->bhte', qc * jnp.exp(b), state)
        rel = jnp.where(causal, b[:, :, :, None, :] - b[:, :, None, :, :], -jnp.inf)
        scores = jnp.einsum('bhtd,bhtsd,bhsd->bhts', qc, jnp.exp(rel), kc)
        o_intra = jnp.einsum('bhts,bhse->bhte', scores, vc)
        b_last = b[:, :, -1, :]
        new_state = jnp.exp(b_last)[..., None] * state + jnp.einsum(
            'bhsd,bhse->bhde', kc * jnp.exp(b_last[:, :, None, :] - b), vc)
        return new_state, o_inter + o_intra

    state0 = jnp.zeros((B_, H_, dk, dv), jnp.float32)
    _, o = lax.scan(step, state0, (chunks(q), chunks(k), chunks(v), chunks(logf)))
    return o.transpose(1, 2, 0, 3, 4).reshape(B_, H_, S_, dv)


def _mixer_ab(h, positions, w_in, f_bias, w_out):
    B_, S_, _ = h.shape
    proj = h @ w_in
    wa = N_HEADS_A * HEAD_DIM
    wb = N_HEADS_B * HEAD_DIM
    splits = np.cumsum([wa, wa, wa, wb, wb, wb]).tolist()
    qa, ka, va, qb, kb, vb, f_logit = jnp.split(proj, splits, axis=-1)
    scale = HEAD_DIM ** -0.5

    def heads(t, n):
        return t.reshape(B_, S_, n, HEAD_DIM)

    def bhsd(t):
        return t.transpose(0, 2, 1, 3)

    qa = bhsd(_partial_rope(heads(qa, N_HEADS_A), positions) * scale)
    ka = bhsd(_partial_rope(heads(ka, N_HEADS_A), positions))
    va = bhsd(heads(va, N_HEADS_A))
    outs, lses = [], []
    for window, dilation in DILATED_CONFIGS:
        o_i, lse_i = _dilated_branch(qa, ka, va, window, dilation)
        outs.append(o_i.astype(jnp.float32))
        lses.append(lse_i)
    mix = jax.nn.softmax(jnp.stack(lses, axis=0), axis=0)
    out_a = jnp.sum(mix[..., None] * jnp.stack(outs, axis=0), axis=0).astype(h.dtype)

    logf = jax.nn.log_sigmoid((f_logit + f_bias).astype(jnp.float32)).transpose(0, 2, 1)
    out_b = _forgetting_attention(bhsd(heads(qb, N_HEADS_B)) * scale,
                                  bhsd(heads(kb, N_HEADS_B)),
                                  bhsd(heads(vb, N_HEADS_B)), logf).astype(h.dtype)

    o = jnp.concatenate([out_a, out_b], axis=1)
    o = o.transpose(0, 2, 1, 3).reshape(B_, S_, WIDTH_AB)
    return o @ w_out


def _mixer_c(h, w_in, lower_bound, gnorm, w_out):
    B_, S_, _ = h.shape
    proj = h @ w_in
    q, f_logit, i_in, g = jnp.split(proj, 4, axis=-1)

    def bhsd(t, d):
        return t.reshape(B_, S_, N_HEADS_C, d).transpose(0, 2, 1, 3).astype(jnp.float32)

    lb = lower_bound.astype(jnp.float32).reshape(N_HEADS_C, HGRN_DK)[None, :, None, :]
    f = lb + (1.0 - lb) * jax.nn.sigmoid(bhsd(f_logit, HGRN_DK))
    logf = jnp.log(f)
    k = 1.0 - f
    o = _hgrn2_chunkwise(bhsd(q, HGRN_DK) * (HGRN_DK ** -0.5), k, bhsd(i_in, HGRN_DV), logf)
    o = _rmsnorm(o, gnorm)
    o = o.transpose(0, 2, 1, 3).reshape(B_, S_, D_MODEL).astype(h.dtype)
    return (o * jax.nn.silu(g)) @ w_out


def _swiglu(h, w_gate, w_up, w_down):
    return (jax.nn.silu(h @ w_gate) * (h @ w_up)) @ w_down


def _moe_swiglu(h, router, w_gate, w_up, w_down):
    logits = (h @ router).astype(jnp.float32)
    top_vals, top_idx = lax.top_k(logits, TOP_K)
    gates = jax.nn.softmax(top_vals, axis=-1)
    combine = jnp.sum(jax.nn.one_hot(top_idx, N_EXPERTS, dtype=jnp.float32) * gates[..., None], axis=-2)
    y = jnp.zeros(h.shape, jnp.float32)
    for e in range(N_EXPERTS):
        y = y + combine[..., e:e + 1] * _swiglu(h, w_gate[e], w_up[e], w_down[e]).astype(jnp.float32)
    return y.astype(h.dtype)


def setup_inputs(seed: int = 0) -> dict:
    key = jax.random.key(seed)
    ks = jax.random.split(key, 20)

    def w(k, shape, fan_in):
        return jax.random.normal(k, shape, jnp.float32) * fan_in ** -0.5

    def gain(k, shape):
        return 1.0 + 0.02 * jax.random.normal(k, shape, jnp.float32)

    x = jax.random.normal(ks[0], (BATCH, SEQ, D_MODEL), jnp.float32)
    offsets = jax.random.randint(ks[1], (BATCH, 1), 0, 4096, dtype=jnp.int32)
    positions = offsets + jnp.arange(SEQ, dtype=jnp.int32)[None, :]
    return {
        "x": x,
        "positions": positions,
        "norm_mix": gain(ks[2], (DEPTH, D_MODEL)),
        "norm_ffn": gain(ks[3], (DEPTH, D_MODEL)),
        "w_in_ab": w(ks[4], (N_EVEN, D_MODEL, IN_AB), D_MODEL),
        "fgate_bias": 3.0 + 0.5 * jax.random.normal(ks[5], (N_EVEN, N_HEADS_B), jnp.float32),
        "w_out_ab": w(ks[6], (N_EVEN, WIDTH_AB, D_MODEL), WIDTH_AB),
        "w_in_c": w(ks[7], (N_ODD, D_MODEL, 4 * D_MODEL), D_MODEL),
        "lower_bounds": 0.1 * jax.random.normal(ks[8], (DEPTH, D_MODEL), jnp.float32),
        "gnorm_c": gain(ks[9], (N_ODD, HGRN_DV)),
        "w_out_c": w(ks[10], (N_ODD, D_MODEL, D_MODEL), D_MODEL),
        "w_gate_ffn": w(ks[11], (N_EVEN, D_MODEL, D_FF), D_MODEL),
        "w_up_ffn": w(ks[12], (N_EVEN, D_MODEL, D_FF), D_MODEL),
        "w_down_ffn": w(ks[13], (N_EVEN, D_FF, D_MODEL), D_FF),
        "router": w(ks[14], (N_ODD, D_MODEL, N_EXPERTS), D_MODEL),
        "w_gate_moe": w(ks[15], (N_ODD, N_EXPERTS, D_MODEL, D_FF_EXPERT), D_MODEL),
        "w_up_moe": w(ks[16], (N_ODD, N_EXPERTS, D_MODEL, D_FF_EXPERT), D_MODEL),
        "w_down_moe": w(ks[17], (N_ODD, N_EXPERTS, D_FF_EXPERT, D_MODEL), D_FF_EXPERT),
        "norm_final": gain(ks[18], (D_MODEL,)),
    }


def reference(x, positions, norm_mix, norm_ffn, w_in_ab, fgate_bias, w_out_ab, w_in_c,
              lower_bounds, gnorm_c, w_out_c, w_gate_ffn, w_up_ffn, w_down_ffn, router,
              w_gate_moe, w_up_moe, w_down_moe, norm_final):
    lb_all = jnp.cumsum(jax.nn.softmax(lower_bounds.astype(jnp.float32), axis=0), axis=0)
    lb_all = lb_all - lb_all[0:1]
    for i in range(DEPTH):
        j = i // 2
        h = _rmsnorm(x, norm_mix[i])
        if i % 2 == 0:
            x = x + _mixer_ab(h, positions, w_in_ab[j], fgate_bias[j], w_out_ab[j])
            h = _rmsnorm(x, norm_ffn[i])
            x = x + _swiglu(h, w_gate_ffn[j], w_up_ffn[j], w_down_ffn[j])
        else:
            x = x + _mixer_c(h, w_in_c[j], lb_all[i], gnorm_c[j], w_out_c[j])
            h = _rmsnorm(x, norm_ffn[i])
            x = x + _moe_swiglu(h, router[j], w_gate_moe[j], w_up_moe[j], w_down_moe[j])
    return _rmsnorm(x, norm_final)
```

```cpp
#include <hip/hip_runtime.h>
#include <cstdio>
#include <cstdint>

#ifndef DIL_MFMA
#define DIL_MFMA 1
#endif
#ifndef FOX_MFMA
#define FOX_MFMA 1
#endif
#ifndef PER_PHASE_LAUNCH
#define PER_PHASE_LAUNCH 0
#endif

namespace pg8 {
#define PG8_LAS __attribute__((address_space(3)))
typedef unsigned short bf16_t;
typedef short bf16x8 __attribute__((ext_vector_type(8)));
typedef float f32x4 __attribute__((ext_vector_type(4)));
typedef unsigned u32x4 __attribute__((ext_vector_type(4)));
typedef int i32x4 __attribute__((ext_vector_type(4)));
typedef int i32x8 __attribute__((ext_vector_type(8)));
template <int MODE> struct AccSel { typedef f32x4 T; };
template <> struct AccSel<1> { typedef i32x4 T; };
constexpr int BM = 256, BK = 64, HALF = 128, HTB = HALF * BK * 2  , STAGE_BYTES = 8 * HTB, NXCD = 8, WGM = 8;

__host__ __device__ __forceinline__ int lds_byte(int r, int c) { const int st = (r >> 4) * 2 + (c >> 5), rr = r & 15, cc = c & 31, ob = rr * 64 + cc * 2; return st * 1024 + (ob ^ (((ob >> 9) & 1) << 5)); }
__host__ __device__ __forceinline__ void stage_rc(int b, int& R, int& C) { const int st = b / 1024, sb = b % 1024, swz = sb ^ (((sb >> 9) & 1) << 5); R = (st >> 1) * 16 + swz / 64; C = (st & 1) * 32 + (swz % 64) / 2; }
__host__ __device__ __forceinline__ int perm32(int rho) { const int n = rho >> 4, i = rho & 15; return 8 * (i >> 2) + 4 * n + (i & 3); }

struct Unit { int pm, pn, aux; };
struct Gemm { const bf16_t* A; const bf16_t* Bt; int M, N, K; };

struct StaticOrder {
    int nM, nN, nwg, G, c;
    __host__ __device__ void init(int M, int N, int G_, int c_) { nM = M / BM; nN = N / BM; nwg = nM * nN; G = G_; c = c_; }
    __host__ __device__ bool next(int i, Unit& u) const {
        const long L = (long)i * G + c; if (L >= nwg) return false;
        int wgid = (int)L; { const int q = nwg / NXCD, r = nwg % NXCD, xcd = wgid % NXCD, off = wgid / NXCD; wgid = (xcd < r ? xcd * (q + 1) : r * (q + 1) + (xcd - r) * q) + off; }
        const int nig = WGM * nN, gid = wgid / nig, fm = gid * WGM, gsz = (nM - fm) < WGM ? (nM - fm) : WGM;
        u.pm = fm + ((wgid % nig) % gsz); u.pn = (wgid % nig) / gsz; u.aux = u.pn; return true;
    }
};
struct MoeOrder {
    int p_lo, p_n, p_tail, nN, G, c, a_local; const int* pexp;
    unsigned nreg, R, ntail; int uni, fast, cm, cd, gd, e_fast; int xd, xpl, xpn, e_x0, e_x1;
    __device__ __forceinline__ void init() {
#define PG8_U(x) ((unsigned)__builtin_amdgcn_readfirstlane((int)(x)))
        nreg = (unsigned)p_n * (unsigned)nN; ntail = (unsigned)p_tail * (unsigned)nN; const unsigned qr = PG8_U(nreg / (unsigned)G), rr = PG8_U(nreg % (unsigned)G); R = qr + (rr != 0u);
        uni = (p_tail > 0 && rr != 0u); fast = (p_n > 0) && (PG8_U((unsigned)G % (unsigned)(p_n > 0 ? p_n : 1)) == 0u);
        cm = fast ? (int)PG8_U((unsigned)c % (unsigned)p_n) : 0; cd = fast ? (int)PG8_U((unsigned)c / (unsigned)p_n) : 0; gd = fast ? (int)PG8_U((unsigned)G / (unsigned)p_n) : 0;
        xd = (!uni && G == 256 && p_n == 128 && nN == 4 && a_local == 1);
        xpl = 8 * (c & 7) + (c >> 5); xpn = (c >> 3) & 3;
        e_x0 = xd ? __builtin_amdgcn_readfirstlane(pexp[p_lo + xpl]) : 0; e_x1 = xd ? __builtin_amdgcn_readfirstlane(pexp[p_lo + xpl + 64]) : 0;
        e_fast = fast ? __builtin_amdgcn_readfirstlane(pexp[p_lo + cm]) : 0;
    }
    __device__ __forceinline__ bool next(int i, Unit& u) const {
        int pl, pn; bool known = false; int ek = 0;
        if (xd && i < 2) { pl = xpl + 64 * i; pn = xpn; known = true; ek = i ? e_x1 : e_x0; }
        else if (uni) { const unsigned P = (unsigned)(p_n + p_tail); const unsigned L = (unsigned)i * (unsigned)G + (unsigned)c; if (L >= P * (unsigned)nN) return false; pl = (int)PG8_U(L % P); pn = (int)PG8_U(L / P); }
        else if ((unsigned)i < R) { const unsigned L = (unsigned)i * (unsigned)G + (unsigned)c; if (L >= nreg) return false;
            if (fast) { pl = cm; pn = i * gd + cd; known = true; ek = e_fast; } else { pl = (int)PG8_U(L % (unsigned)p_n); pn = (int)PG8_U(L / (unsigned)p_n); } }
        else { const unsigned L = ((unsigned)i - R) * (unsigned)G + (unsigned)c; if (L >= ntail) return false; pl = p_n + (int)PG8_U(L % (unsigned)p_tail); pn = (int)PG8_U(L / (unsigned)p_tail); }
        const int panel = p_lo + pl;
        int e; if (known) e = ek; else e = __builtin_amdgcn_readfirstlane(pexp[panel]);
        u.pm = __builtin_amdgcn_readfirstlane(a_local ? pl : panel); u.pn = __builtin_amdgcn_readfirstlane(e * nN + pn); u.aux = __builtin_amdgcn_readfirstlane(pn); return true;
    }
};

__device__ __forceinline__ unsigned cvt_pk_bf16(float lo, float hi) { unsigned r; asm volatile("v_cvt_pk_bf16_f32 %0, %1, %2" : "=v"(r) : "v"(lo), "v"(hi)); return r; }


struct EpiBf16S {
    static constexpr bool PERM = true, AFTER_DRAIN = false;
    bf16_t* O; int ldc; int nsc; float sc; const float* sa; const float* sb;
    static constexpr bool LDS_SCALES = true;
    __device__ __forceinline__ const float* row_scales(const Unit& u) const { return sa + (size_t)u.pm * BM; }
    __device__ __forceinline__ const float* col_scales(const Unit& u) const { return sb + (size_t)u.pn * BM; }
    __device__ __forceinline__ void operator()(const i32x4 (&acc)[2][2][4][2], const Unit& u, int wr, int wc, int fr, int fq, const PG8_LAS float* scl) const {
        const int row0 = u.pm * BM + wr * 64 + fr; const int col0 = u.aux * BM + wc * 32 + 8 * fq; const float s = (u.aux < nsc) ? sc : 1.f;
        float srv[2][4];
#pragma unroll
        for (int ai = 0; ai < 2; ++ai)
#pragma unroll
            for (int m = 0; m < 4; ++m) srv[ai][m] = scl[wr * 64 + fr + ai * HALF + m * 16];
#pragma unroll
        for (int bj = 0; bj < 2; ++bj) { const f32x4 sb0 = *(const PG8_LAS f32x4*)(scl + 256 + wc * 32 + 8 * fq + bj * HALF) * s, sb1 = *(const PG8_LAS f32x4*)(scl + 256 + wc * 32 + 8 * fq + bj * HALF + 4) * s;
#pragma unroll
            for (int ai = 0; ai < 2; ++ai)
#pragma unroll
                for (int m = 0; m < 4; ++m) { const int row = row0 + ai * HALF + m * 16; const float sr = srv[ai][m];
                    const f32x4 v0 = __builtin_convertvector(acc[ai][bj][m][0], f32x4) * sb0 * sr, v1 = __builtin_convertvector(acc[ai][bj][m][1], f32x4) * sb1 * sr;
                    u32x4 w; w.x = cvt_pk_bf16(v0[0], v0[1]); w.y = cvt_pk_bf16(v0[2], v0[3]); w.z = cvt_pk_bf16(v1[0], v1[1]); w.w = cvt_pk_bf16(v1[2], v1[3]);
                    *(u32x4*)(O + (size_t)row * ldc + col0 + bj * HALF) = w; } }
    }
};
__device__ __forceinline__ float xor16(float v, int fq) { auto r = __builtin_amdgcn_permlane16_swap(__builtin_bit_cast(unsigned, v), __builtin_bit_cast(unsigned, v), false, false); return __builtin_bit_cast(float, (fq & 1) ? r[0] : r[1]); }
struct EpiProjAB {
    static constexpr bool PERM = true, AFTER_DRAIN = false;
    bf16_t* O; int ldc; const float* rope; float qscale; const float* sa; const float* sb;
    static constexpr bool LDS_SCALES = true;
    __device__ __forceinline__ const float* row_scales(const Unit& u) const { return sa + (size_t)u.pm * BM; }
    __device__ __forceinline__ const float* col_scales(const Unit& u) const { return sb + (size_t)u.pn * BM; }
    __device__ __forceinline__ void operator()(const i32x4 (&acc)[2][2][4][2], const Unit& u, int wr, int wc, int fr, int fq, const PG8_LAS float* scl) const {
        const int row0 = u.pm * BM + wr * 64 + fr; const int col0 = u.aux * BM + wc * 32 + 8 * fq;
        const int tt = u.aux >> 1; const bool do_rope = tt < 2; const float s = (tt == 0 || tt == 3) ? qscale : 1.f;
        const bool rl = ((wc & 1) == 0) && (fq < 2);
        float srv[2][4];
#pragma unroll
        for (int ai = 0; ai < 2; ++ai)
#pragma unroll
            for (int m = 0; m < 4; ++m) srv[ai][m] = scl[wr * 64 + fr + ai * HALF + m * 16];
        f32x4 sbv[2][2];
#pragma unroll
        for (int bj = 0; bj < 2; ++bj) { sbv[bj][0] = *(const PG8_LAS f32x4*)(scl + 256 + wc * 32 + 8 * fq + bj * HALF) * s; sbv[bj][1] = *(const PG8_LAS f32x4*)(scl + 256 + wc * 32 + 8 * fq + bj * HALF + 4) * s; }
        if (!do_rope) {
#pragma unroll
            for (int bj = 0; bj < 2; ++bj)
#pragma unroll
                for (int ai = 0; ai < 2; ++ai)
#pragma unroll
                    for (int m = 0; m < 4; ++m) { const int row = row0 + ai * HALF + m * 16; const float sr = srv[ai][m];
                        const f32x4 v0 = __builtin_convertvector(acc[ai][bj][m][0], f32x4) * sbv[bj][0] * sr, v1 = __builtin_convertvector(acc[ai][bj][m][1], f32x4) * sbv[bj][1] * sr;
                        u32x4 w; w.x = cvt_pk_bf16(v0[0], v0[1]); w.y = cvt_pk_bf16(v0[2], v0[3]); w.z = cvt_pk_bf16(v1[0], v1[1]); w.w = cvt_pk_bf16(v1[2], v1[3]);
                        *(u32x4*)(O + (size_t)row * ldc + col0 + bj * HALF) = w; }
        } else {
            const float sg = (fq == 0) ? -1.f : 1.f;
            f32x4 rc[4];
            { const f32x4* rp = (const f32x4*)(rope + (size_t)row0 * 16); rc[0] = rp[0]; rc[1] = rp[1]; rc[2] = rp[2]; rc[3] = rp[3]; }
#pragma unroll
            for (int idx = 0; idx < 8; ++idx) { const int ai = idx >> 2, m = idx & 3; const int row = row0 + ai * HALF + m * 16; const float sr = srv[ai][m];
                f32x4 rn[4];
                if (idx + 1 < 8) { const int rown = row0 + ((idx + 1) >> 2) * HALF + ((idx + 1) & 3) * 16; const f32x4* rp = (const f32x4*)(rope + (size_t)rown * 16); rn[0] = rp[0]; rn[1] = rp[1]; rn[2] = rp[2]; rn[3] = rp[3]; }
                const f32x4 s0 = rc[2] * sg, s1 = rc[3] * sg;
#pragma unroll
                for (int bj = 0; bj < 2; ++bj) {
                    f32x4 v0 = __builtin_convertvector(acc[ai][bj][m][0], f32x4) * sbv[bj][0] * sr, v1 = __builtin_convertvector(acc[ai][bj][m][1], f32x4) * sbv[bj][1] * sr;
                    f32x4 p0, p1;
#pragma unroll
                    for (int c = 0; c < 4; ++c) { p0[c] = xor16(v0[c], fq); p1[c] = xor16(v1[c], fq); }
                    const f32x4 r0 = v0 * rc[0] + p0 * s0, r1 = v1 * rc[1] + p1 * s1;
#pragma unroll
                    for (int c = 0; c < 4; ++c) { v0[c] = rl ? r0[c] : v0[c]; v1[c] = rl ? r1[c] : v1[c]; }
                    u32x4 w; w.x = cvt_pk_bf16(v0[0], v0[1]); w.y = cvt_pk_bf16(v0[2], v0[3]); w.z = cvt_pk_bf16(v1[0], v1[1]); w.w = cvt_pk_bf16(v1[2], v1[3]);
                    *(u32x4*)(O + (size_t)row * ldc + col0 + bj * HALF) = w; }
                if (idx + 1 < 8) { rc[0] = rn[0]; rc[1] = rn[1]; rc[2] = rn[2]; rc[3] = rn[3]; } }
        }
    }
};
struct EpiSwiGLU {
    static constexpr bool PERM = true, AFTER_DRAIN = false;
    bf16_t* O; int ldc;
    __device__ __forceinline__ void operator()(const f32x4 (&acc)[2][2][4][2], const Unit& u, int wr, int wc, int fr, int fq) const {
        const int row0 = u.pm * BM + wr * 64 + fr; const int col0 = u.aux * HALF + wc * 32 + 8 * fq;
#pragma unroll
        for (int ai = 0; ai < 2; ++ai)
#pragma unroll
            for (int m = 0; m < 4; ++m) { bf16_t* rowp = O + (size_t)(row0 + ai * HALF + m * 16) * ldc + col0;
                float h[8];
#pragma unroll
                for (int n = 0; n < 2; ++n)
#pragma unroll
                    for (int c = 0; c < 4; ++c) { const float g = acc[ai][0][m][n][c], up = acc[ai][1][m][n][c];
                        h[4 * n + c] = g * up * __builtin_amdgcn_rcpf(1.f + __builtin_amdgcn_exp2f(-1.4426950408889634f * g)); }
                u32x4 w; w.x = cvt_pk_bf16(h[0], h[1]); w.y = cvt_pk_bf16(h[2], h[3]); w.z = cvt_pk_bf16(h[4], h[5]); w.w = cvt_pk_bf16(h[6], h[7]);
                *(u32x4*)rowp = w; }
    }
};
struct EpiSwiGLURows {
    static constexpr bool PERM = true, AFTER_DRAIN = false;
    bf16_t* O; int ldc; int p_lo;
    __device__ __forceinline__ void operator()(const f32x4 (&acc)[2][2][4][2], const Unit& u, int wr, int wc, int fr, int fq) const {
        Unit v = u; v.pm = u.pm - p_lo; EpiSwiGLU E{O, ldc}; E(acc, v, wr, wc, fr, fq); }
};
typedef float f32x2v __attribute__((ext_vector_type(2)));
__device__ __forceinline__ f32x2v pkmul(f32x2v a, f32x2v b) { f32x2v d; asm("v_pk_mul_f32 %0, %1, %2" : "=v"(d) : "v"(a), "v"(b)); return d; }
template <bool OUT_F8> struct EpiSwiGLUI8T {
    static constexpr bool PERM = true, AFTER_DRAIN = false;
    bf16_t* O; int ldc; int p_lo; const float* sa; const float* sb;
    static constexpr bool LDS_SCALES = true;
    __device__ __forceinline__ const float* row_scales(const Unit& u) const { return sa + (size_t)u.pm * BM; }
    __device__ __forceinline__ const float* col_scales(const Unit& u) const { return sb + (size_t)u.pn * BM; }
    __device__ __forceinline__ void operator()(const i32x4 (&acc)[2][2][4][2], const Unit& u, int wr, int wc, int fr, int fq, const PG8_LAS float* scl) const {
        const int rl = wr * 64 + fr; const int row0 = (u.pm - p_lo) * BM + rl; const int col0 = u.aux * HALF + wc * 32 + 8 * fq;
        const PG8_LAS float* sbp = scl + 256 + wc * 32 + 8 * fq; const PG8_LAS float* sap = scl + rl;
        f32x4 sg[2], su[2]; float sr[2][4];
#pragma unroll
        for (int n = 0; n < 2; ++n) { sg[n] = *(const PG8_LAS f32x4*)(sbp + 4 * n); su[n] = *(const PG8_LAS f32x4*)(sbp + HALF + 4 * n); }
        f32x2v sgE[2][2], cP[2][2];
#pragma unroll
        for (int n = 0; n < 2; ++n)
#pragma unroll
            for (int hh = 0; hh < 2; ++hh) { sgE[n][hh] = (f32x2v){sg[n][2 * hh], sg[n][2 * hh + 1]} * -1.4426950408889634f; cP[n][hh] = (f32x2v){sg[n][2 * hh] * su[n][2 * hh], sg[n][2 * hh + 1] * su[n][2 * hh + 1]} * (OUT_F8 ? 16.f : 1.f); }
#pragma unroll
        for (int ai = 0; ai < 2; ++ai)
#pragma unroll
            for (int m = 0; m < 4; ++m) sr[ai][m] = sap[ai * HALF + m * 16];
#pragma unroll
        for (int ai = 0; ai < 2; ++ai)
#pragma unroll
            for (int m = 0; m < 4; ++m) { const float r1 = sr[ai][m], rq = r1 * r1; const f32x2v r1p = {r1, r1}, rqp = {rq, rq}; float h[8];
#pragma unroll
                for (int n = 0; n < 2; ++n)
#pragma unroll
                    for (int hh = 0; hh < 2; ++hh) { const f32x2v ag = {(float)acc[ai][0][m][n][2 * hh], (float)acc[ai][0][m][n][2 * hh + 1]}, au = {(float)acc[ai][1][m][n][2 * hh], (float)acc[ai][1][m][n][2 * hh + 1]};
                        const f32x2v e2 = pkmul(ag, pkmul(sgE[n][hh], r1p)), num = pkmul(pkmul(ag, au), pkmul(cP[n][hh], rqp));
                        const f32x2v d2 = (f32x2v){__builtin_amdgcn_exp2f(e2.x), __builtin_amdgcn_exp2f(e2.y)} + 1.f;
                        const f32x2v hv = num * (f32x2v){__builtin_amdgcn_rcpf(d2.x), __builtin_amdgcn_rcpf(d2.y)};
                        h[4 * n + 2 * hh] = hv.x; h[4 * n + 2 * hh + 1] = hv.y; }
                if constexpr (OUT_F8) {
#pragma unroll
                    for (int c = 0; c < 8; ++c) h[c] = __builtin_amdgcn_fmed3f(h[c], -448.f, 448.f);
                    int w0 = 0, w1 = 0; w0 = __builtin_amdgcn_cvt_pk_fp8_f32(h[0], h[1], w0, false); w0 = __builtin_amdgcn_cvt_pk_fp8_f32(h[2], h[3], w0, true);
                    w1 = __builtin_amdgcn_cvt_pk_fp8_f32(h[4], h[5], w1, false); w1 = __builtin_amdgcn_cvt_pk_fp8_f32(h[6], h[7], w1, true);
                    typedef int i32x2 __attribute__((ext_vector_type(2)));
                    *(i32x2*)((unsigned char*)O + (size_t)(row0 + ai * HALF + m * 16) * ldc + col0) = (i32x2){w0, w1};
                } else {
                    u32x4 w; w.x = cvt_pk_bf16(h[0], h[1]); w.y = cvt_pk_bf16(h[2], h[3]); w.z = cvt_pk_bf16(h[4], h[5]); w.w = cvt_pk_bf16(h[6], h[7]);
                    *(u32x4*)(O + (size_t)(row0 + ai * HALF + m * 16) * ldc + col0) = w; } }
    }
};
typedef EpiSwiGLUI8T<false> EpiSwiGLUI8;
typedef EpiSwiGLUI8T<true> EpiSwiGLUI8F8;
struct EpiBf16RowsF8 {
    static constexpr bool PERM = true, AFTER_DRAIN = false;
    bf16_t* O; int ldc; int row_off; const unsigned* wmax;
    __device__ __forceinline__ void operator()(const f32x4 (&acc)[2][2][4][2], const Unit& u, int wr, int wc, int fr, int fq) const {
        const int row0 = row_off + u.pm * BM + wr * 64 + fr; const int col0 = u.aux * BM + wc * 32 + 8 * fq;
        const float sc = __uint_as_float(wmax[u.pn >> 2]) * (1.f / 4096.f);
#pragma unroll
        for (int ai = 0; ai < 2; ++ai)
#pragma unroll
            for (int m = 0; m < 4; ++m) { bf16_t* rowp = O + (size_t)(row0 + ai * HALF + m * 16) * ldc + col0;
#pragma unroll
                for (int bj = 0; bj < 2; ++bj) { const f32x4 v0 = acc[ai][bj][m][0] * sc, v1 = acc[ai][bj][m][1] * sc;
                    u32x4 w; w.x = cvt_pk_bf16(v0[0], v0[1]); w.y = cvt_pk_bf16(v0[2], v0[3]); w.z = cvt_pk_bf16(v1[0], v1[1]); w.w = cvt_pk_bf16(v1[2], v1[3]);
                    *(u32x4*)(rowp + bj * HALF) = w; } }
    }
};
struct EpiResidual {
    static constexpr bool PERM = false, AFTER_DRAIN = false;
    const float* base; float* out; int ldc;
    __device__ __forceinline__ void operator()(const f32x4 (&acc)[2][2][4][2], const Unit& u, int wr, int wc, int fr, int fq) const {
        const int row0 = u.pm * BM + wr * 64 + fr; const int col0 = u.aux * BM + wc * 32 + 4 * fq;
#pragma unroll
        for (int ai = 0; ai < 2; ++ai) {
            f32x4 bb[4][2][2];
#pragma unroll
            for (int m = 0; m < 4; ++m) { const size_t off = (size_t)(row0 + ai * HALF + m * 16) * ldc + col0;
#pragma unroll
                for (int bj = 0; bj < 2; ++bj)
#pragma unroll
                    for (int n = 0; n < 2; ++n) bb[m][bj][n] = *(const f32x4*)(base + off + bj * HALF + n * 16); }
#pragma unroll
            for (int m = 0; m < 4; ++m) { const size_t off = (size_t)(row0 + ai * HALF + m * 16) * ldc + col0;
#pragma unroll
                for (int bj = 0; bj < 2; ++bj)
#pragma unroll
                    for (int n = 0; n < 2; ++n) *(f32x4*)(out + off + bj * HALF + n * 16) = bb[m][bj][n] + acc[ai][bj][m][n]; }
        }
    }
};
template <bool BASE_F32> struct EpiResidualB {
    static constexpr bool PERM = true, AFTER_DRAIN = false;
    const void* base; bf16_t* out;
    __device__ __forceinline__ void operator()(const f32x4 (&acc)[2][2][4][2], const Unit& u, int wr, int wc, int fr, int fq) const {
        const int row0 = u.pm * BM + wr * 64 + fr; const int col0 = u.aux * BM + wc * 32 + 8 * fq;
        static_assert(!BASE_F32, "the stream is bf16 from the first phase on");
        u32x4 raw[2][4][2];
#pragma unroll
        for (int ai = 0; ai < 2; ++ai)
#pragma unroll
            for (int m = 0; m < 4; ++m) { const size_t off = (size_t)(row0 + ai * HALF + m * 16) * 1024 + col0;
#pragma unroll
                for (int bj = 0; bj < 2; ++bj) raw[ai][m][bj] = *(const u32x4*)((const bf16_t*)base + off + bj * HALF); }
#pragma unroll
        for (int ai = 0; ai < 2; ++ai)
#pragma unroll
            for (int m = 0; m < 4; ++m) { const size_t off = (size_t)(row0 + ai * HALF + m * 16) * 1024 + col0;
#pragma unroll
                for (int bj = 0; bj < 2; ++bj) { const u32x4 r = raw[ai][m][bj];
                    const f32x4 v0 = (f32x4){__uint_as_float(r.x << 16), __uint_as_float(r.x & 0xffff0000u), __uint_as_float(r.y << 16), __uint_as_float(r.y & 0xffff0000u)} + acc[ai][bj][m][0];
                    const f32x4 v1 = (f32x4){__uint_as_float(r.z << 16), __uint_as_float(r.z & 0xffff0000u), __uint_as_float(r.w << 16), __uint_as_float(r.w & 0xffff0000u)} + acc[ai][bj][m][1];
                    u32x4 w; w.x = cvt_pk_bf16(v0[0], v0[1]); w.y = cvt_pk_bf16(v0[2], v0[3]); w.z = cvt_pk_bf16(v1[0], v1[1]); w.w = cvt_pk_bf16(v1[2], v1[3]);
                    *(u32x4*)(out + off + bj * HALF) = w; } }
    }
};
struct EpiBf16Rows {
    static constexpr bool PERM = true, AFTER_DRAIN = false;
    bf16_t* O; int ldc; int row_off;
    __device__ __forceinline__ void operator()(const f32x4 (&acc)[2][2][4][2], const Unit& u, int wr, int wc, int fr, int fq) const {
        const int row0 = row_off + u.pm * BM + wr * 64 + fr; const int col0 = u.aux * BM + wc * 32 + 8 * fq;
#pragma unroll
        for (int ai = 0; ai < 2; ++ai)
#pragma unroll
            for (int m = 0; m < 4; ++m) { bf16_t* rowp = O + (size_t)(row0 + ai * HALF + m * 16) * ldc + col0;
#pragma unroll
                for (int bj = 0; bj < 2; ++bj) { const f32x4 v0 = acc[ai][bj][m][0], v1 = acc[ai][bj][m][1];
                    u32x4 w; w.x = cvt_pk_bf16(v0[0], v0[1]); w.y = cvt_pk_bf16(v0[2], v0[3]); w.z = cvt_pk_bf16(v1[0], v1[1]); w.w = cvt_pk_bf16(v1[2], v1[3]);
                    *(u32x4*)(rowp + bj * HALF) = w; } }
    }
};

template <class Epi, class Sched, bool ALIGN_EPI, bool GATHER, int MODE = 0>
__device__ __forceinline__ void gemm_phase(PG8_LAS unsigned char* lds, const Gemm g, const Sched& S, const Epi& E, const int* rowmap, int wave_) {
    int lane; asm volatile("v_mbcnt_lo_u32_b32 %0, -1, 0\n\tv_mbcnt_hi_u32_b32 %0, -1, %0" : "=v"(lane));
    const int wid = wave_, tid = wid * 64 + lane, wr = wid >> 2, wc = wid & 3, fr = lane & 15, fq = lane >> 4;
    typedef typename AccSel<MODE>::T AccT;
    const int K = MODE ? g.K / 2 : g.K, nt = K / BK;
    unsigned voffB[2]; int Rr[2], Cc[2];
#pragma unroll
    for (int i = 0; i < 2; ++i) { int R, C; stage_rc(tid * 16 + i * 8192, R, C); Rr[i] = R; Cc[i] = C; const int Rb = Epi::PERM ? ((R & ~31) + perm32(R & 31)) : R;
        voffB[i] = (unsigned)(Rb * K + C) * 2u; }
    const size_t kstep = (size_t)(BK * 2);
    const size_t hstep = (size_t)HALF * K * 2;
    const size_t tstep = 2 * hstep;
    const unsigned ldsw = (unsigned)wid * 1024u;
    const int aoff = lds_byte(wr * 64 + fr, fq * 8), boff = lds_byte(wc * 32 + fr, fq * 8);
#define PG8_SA(b, h) (((b) * 2 + (h)) * HTB)
#define PG8_SB(b, h) ((4 + (b) * 2 + (h)) * HTB)
#define PG8_STAGE(bufoff, gbase, voff) do { _Pragma("unroll") for (int _i = 0; _i < 2; ++_i) \
        __builtin_amdgcn_global_load_lds((const unsigned*)((const char*)(gbase) + (voff)[_i]), (PG8_LAS unsigned*)(lds + (bufoff) + ldsw + _i * 8192), 16, 0, 0); } while (0)
#define PG8_LD16(off) (*(const PG8_LAS i32x4*)(lds + (off)))
#define PG8_LDA(dst, b, h) do { if constexpr (MODE == 2) { _Pragma("unroll") for (int m = 0; m < 4; ++m) dst##8[m] = __builtin_shufflevector(PG8_LD16(PG8_SA(b, h) + aoff + m * 2048), PG8_LD16(PG8_SA(b, h) + aoff + m * 2048 + 1024), 0, 1, 2, 3, 4, 5, 6, 7); } \
        else { _Pragma("unroll") for (int m = 0; m < 4; ++m) _Pragma("unroll") for (int k = 0; k < 2; ++k) dst[m][k] = *(const PG8_LAS bf16x8*)(lds + PG8_SA(b, h) + aoff + m * 2048 + k * 1024); } } while (0)
#define PG8_LDB(dst, b, h) do { if constexpr (MODE == 2) { _Pragma("unroll") for (int n = 0; n < 2; ++n) dst##8[n] = __builtin_shufflevector(PG8_LD16(PG8_SB(b, h) + boff + n * 2048), PG8_LD16(PG8_SB(b, h) + boff + n * 2048 + 1024), 0, 1, 2, 3, 4, 5, 6, 7); } \
        else { _Pragma("unroll") for (int n = 0; n < 2; ++n) _Pragma("unroll") for (int k = 0; k < 2; ++k) dst[n][k] = *(const PG8_LAS bf16x8*)(lds + PG8_SB(b, h) + boff + n * 2048 + k * 1024); } } while (0)
#define PG8_MMA(ai, bj, At, Bt) do { __builtin_amdgcn_s_setprio(1); _Pragma("unroll") for (int m = 0; m < 4; ++m) _Pragma("unroll") for (int n = 0; n < 2; ++n) { \
        if constexpr (MODE == 2) { asm volatile("v_mfma_scale_f32_16x16x128_f8f6f4 %0, %1, %2, %0, %3, %3 op_sel_hi:[0,0,0]" : "+v"(acc[ai][bj][m][n]) : "v"(Bt##8[n]), "v"(At##8[m]), "v"(sc127_)); } \
        else { _Pragma("unroll") for (int k = 0; k < 2; ++k) { \
          if constexpr (MODE == 1) acc[ai][bj][m][n] = __builtin_bit_cast(AccT, __builtin_amdgcn_mfma_i32_16x16x64_i8(__builtin_bit_cast(i32x4, Bt[n][k]), __builtin_bit_cast(i32x4, At[m][k]), __builtin_bit_cast(i32x4, acc[ai][bj][m][n]), 0, 0, 0)); \
          else acc[ai][bj][m][n] = __builtin_bit_cast(AccT, __builtin_amdgcn_mfma_f32_16x16x32_bf16(Bt[n][k], At[m][k], __builtin_bit_cast(f32x4, acc[ai][bj][m][n]), 0, 0, 0)); } } } __builtin_amdgcn_s_setprio(0); } while (0)
#define PG8_WAIT_V(n) asm volatile("s_waitcnt vmcnt(" #n ")" ::: "memory")
#define PG8_WAIT_L(n) asm volatile("s_waitcnt lgkmcnt(" #n ")" ::: "memory")
#define PG8_BAR __builtin_amdgcn_s_barrier()
#define PG8_SCHED __builtin_amdgcn_sched_barrier(0)
#define PG8_LOAD_VA(dst, u) do { _Pragma("unroll") for (int _h = 0; _h < 2; ++_h) _Pragma("unroll") for (int _i = 0; _i < 2; ++_i) \
        dst[_h][_i] = GATHER ? ((unsigned)rowmap[(u).pm * BM + _h * HALF + Rr[_i]] * (unsigned)(K * 2) + (unsigned)Cc[_i] * 2u) : ((unsigned)((_h * HALF + Rr[_i]) * K + Cc[_i]) * 2u); } while (0)
    Unit cur, nxt; int ui = 0;
    if (!S.next(0, cur)) return;
    AccT acc[2][2][4][2];
#pragma unroll
    for (int a = 0; a < 2; ++a)
#pragma unroll
        for (int b = 0; b < 2; ++b)
#pragma unroll
            for (int m = 0; m < 4; ++m)
#pragma unroll
                for (int n = 0; n < 2; ++n) acc[a][b][m][n] = __builtin_bit_cast(AccT, (f32x4){0.f, 0.f, 0.f, 0.f});
    PG8_LAS float* const sclb = (PG8_LAS float*)(lds + STAGE_BYTES + 4096);
#define PG8_SCALE_DMA(U, PAR) do { if constexpr (MODE == 1) { const float* src_ = (tid < 256) ? E.row_scales(U) + tid : E.col_scales(U) + (tid - 256); \
        __builtin_amdgcn_global_load_lds((const unsigned*)src_, (PG8_LAS unsigned*)(sclb + (PAR) * 512 + wid * 64), 4, 0, 0); } } while (0)
    int sc127_ = 0x7f7f7f7f; asm volatile("" : "+v"(sc127_));
    bf16x8 At[4][2], B0[2][2], B1[2][2]; i32x8 At8[4], B08[2], B18[2];
    unsigned vAc[2][2], vAn[2][2];
    PG8_LOAD_VA(vAc, cur);
    const char* cA = GATHER ? (const char*)g.A : (const char*)g.A + (size_t)cur.pm * tstep; const char* cB = (const char*)g.Bt + (size_t)cur.pn * tstep;
    PG8_SCALE_DMA(cur, 0);
    PG8_STAGE(PG8_SB(0, 0), cB, voffB); PG8_STAGE(PG8_SB(0, 1), cB + hstep, voffB); PG8_STAGE(PG8_SA(0, 0), cA, vAc[0]); PG8_STAGE(PG8_SA(0, 1), cA, vAc[1]);
    if (wr == 1) PG8_BAR;
    PG8_WAIT_V(2); PG8_BAR;
    PG8_STAGE(PG8_SB(1, 0), cB + kstep, voffB); PG8_STAGE(PG8_SA(1, 0), cA + kstep, vAc[0]); PG8_STAGE(PG8_SB(1, 1), cB + hstep + kstep, voffB);
    PG8_WAIT_V(6); PG8_BAR;
    for (;;) {
        const bool has_next = S.next(ui + 1, nxt);
        if constexpr (GATHER) { if (has_next && nxt.pm != cur.pm) { PG8_LOAD_VA(vAn, nxt); } else {
#pragma unroll
            for (int _h = 0; _h < 2; ++_h)
#pragma unroll
                for (int _i = 0; _i < 2; ++_i) vAn[_h][_i] = vAc[_h][_i]; } }
        const char* nA = GATHER ? (const char*)g.A : (has_next ? (const char*)g.A + (size_t)nxt.pm * tstep : cA); const char* nB = has_next ? (const char*)g.Bt + (size_t)nxt.pn * tstep : cB;
        for (int t = 0; t < nt; t += 2) {
            const bool last = (t == nt - 2);
            const char* a1 = cA + (size_t)(t + 1) * kstep;
            const char* a2 = last ? nA : cA + (size_t)(t + 2) * kstep; const char* b2 = last ? nB : cB + (size_t)(t + 2) * kstep;
            const char* a3 = a2 + kstep; const char* b3 = b2 + kstep;
            unsigned o2[2][2];
#pragma unroll
            for (int _h = 0; _h < 2; ++_h)
#pragma unroll
                for (int _i = 0; _i < 2; ++_i) o2[_h][_i] = (GATHER && last) ? vAn[_h][_i] : vAc[_h][_i];
            PG8_LDB(B0, 0, 0); PG8_LDB(B1, 0, 1); PG8_SCHED; PG8_LDA(At, 0, 0); PG8_STAGE(PG8_SA(1, 1), a1, vAc[1]);
            PG8_WAIT_V(8); PG8_WAIT_L(0); PG8_BAR; PG8_MMA(0, 0, At, B0); PG8_MMA(0, 1, At, B1); PG8_BAR; PG8_SCHED;
            PG8_LDA(At, 0, 1); PG8_STAGE(PG8_SB(0, 0), b2, voffB); PG8_STAGE(PG8_SB(0, 1), b2 + hstep, voffB); PG8_STAGE(PG8_SA(0, 0), a2, o2[0]);
            PG8_WAIT_V(8); PG8_WAIT_L(0); PG8_BAR; PG8_MMA(1, 0, At, B0); PG8_MMA(1, 1, At, B1); PG8_BAR; PG8_SCHED;
            PG8_LDB(B0, 1, 0); PG8_LDB(B1, 1, 1); PG8_SCHED; PG8_LDA(At, 1, 0); PG8_STAGE(PG8_SA(0, 1), a2, o2[1]);
            PG8_WAIT_V(8); PG8_WAIT_L(0); PG8_BAR; PG8_MMA(0, 0, At, B0); PG8_MMA(0, 1, At, B1); PG8_BAR; PG8_SCHED;
            PG8_LDA(At, 1, 1); PG8_STAGE(PG8_SB(1, 0), b3, voffB); PG8_STAGE(PG8_SB(1, 1), b3 + hstep, voffB); PG8_STAGE(PG8_SA(1, 0), a3, o2[0]);
            PG8_WAIT_V(8); PG8_WAIT_L(0); PG8_BAR; PG8_MMA(1, 0, At, B0); PG8_MMA(1, 1, At, B1); PG8_BAR; PG8_SCHED;
        }
        if constexpr (ALIGN_EPI) { if (wr == 0) PG8_BAR; }
        if constexpr (MODE == 2) asm volatile("s_nop 15\n\ts_nop 15" ::: "memory");
        { Unit ue = cur; int fr_e = fr, fq_e = fq; asm volatile("" : "+s"(ue.pm), "+s"(ue.pn), "+s"(ue.aux), "+v"(fr_e), "+v"(fq_e));
          if constexpr (MODE == 1) E(acc, ue, wr, wc, fr_e, fq_e, sclb + (ui & 1) * 512); else E(acc, ue, wr, wc, fr_e, fq_e); }
        if (!has_next) break;
#pragma unroll
        for (int a = 0; a < 2; ++a)
#pragma unroll
            for (int b = 0; b < 2; ++b)
#pragma unroll
                for (int m = 0; m < 4; ++m)
#pragma unroll
                    for (int n = 0; n < 2; ++n) { typedef double f64x2 __attribute__((ext_vector_type(2))); double z0, z1;
                        asm("v_mov_b64 %0, 0" : "=v"(z0)); asm("v_mov_b64 %0, 0" : "=v"(z1)); acc[a][b][m][n] = __builtin_bit_cast(AccT, (f64x2){z0, z1}); }
        cur = nxt; cA = nA; cB = nB; ++ui;
        PG8_SCALE_DMA(cur, ui & 1);
        if constexpr (GATHER) {
#pragma unroll
        for (int _h = 0; _h < 2; ++_h)
#pragma unroll
            for (int _i = 0; _i < 2; ++_i) vAc[_h][_i] = vAn[_h][_i]; }
        if constexpr (ALIGN_EPI) { if (wr == 1) PG8_BAR; }
    }
    PG8_WAIT_V(0);
    if constexpr (!ALIGN_EPI) { if (wr == 0) PG8_BAR; }
    PG8_BAR;
#undef PG8_SA
#undef PG8_SB
#undef PG8_STAGE
#undef PG8_LDA
#undef PG8_LDB
#undef PG8_MMA
#undef PG8_WAIT_V
#undef PG8_WAIT_L
#undef PG8_BAR
#undef PG8_SCHED
#undef PG8_LOAD_VA
#undef PG8_SCALE_DMA
}
}

constexpr int NWAVES = 8, NTHR = NWAVES * 64;
constexpr int BATCH = 32, SEQ = 2048, D = 1024, M = BATCH * SEQ;
constexpr int NAB = 3072, IN_AB = 3080, HD = 64, NH = 8;
constexpr int DFF = 2816, NGU = 2 * DFF;
constexpr int NC = 4096, HK = 128;
constexpr int NEXP = 8, DFFE = 3584, NGUE = 2 * DFFE;
constexpr float EPS = 1e-6f;
constexpr float LOG2E = 1.4426950408889634f;
constexpr float QSCALE_AB = 0.125f * LOG2E;
constexpr float QSCALE_C = 0.08838834764831845f;
constexpr int PCHUNK = 128, NPMAX = 520, NMCH = 4;
constexpr int NPHASE = 13 + 2 * NMCH + 1;

constexpr size_t MiB = 1u << 20;
constexpr size_t WS_CTL = 0, CTL_ZERO_BYTES = 64 * 1024;
constexpr size_t WS_ROPE = 1 * MiB;
constexpr size_t WS_LOGF = 5 * MiB;
constexpr size_t WS_CUM = 7 * MiB;
constexpr size_t WS_TOPI = 9 * MiB;
constexpr size_t WS_TOPG = 9 * MiB + 256 * 1024;
constexpr size_t WS_RANK = 9 * MiB + 768 * 1024;
constexpr size_t WS_POS = 10 * MiB + 256 * 1024;
constexpr size_t WS_ROWMAP = 10 * MiB + 768 * 1024;
constexpr size_t WS_CNT = 11 * MiB + 512 * 1024;
constexpr size_t WS_META = 11 * MiB + 768 * 1024;
constexpr size_t WS_SA = 12 * MiB;
constexpr size_t WS_SAS = 12 * MiB + 512 * 1024;
constexpr size_t WS_SBD = 13 * MiB + 256 * 1024;
constexpr size_t WS_SBM = 13 * MiB + 512 * 1024;
constexpr size_t WS_SBAB = 13 * MiB + 768 * 1024;
constexpr size_t WS_SBC = 13 * MiB + 832 * 1024;
constexpr size_t WS_WINAB = 16 * MiB, WS_WOUTAB = 22 * MiB, WS_WGU = 24 * MiB, WS_WDOWN = 35 * MiB, WS_WINC = 41 * MiB, WS_WOUTC = 49 * MiB, WS_WGUM = 51 * MiB, WS_WDOWNM = 163 * MiB;
constexpr size_t WS_XN = 224 * MiB;
constexpr size_t WS_BIG = 352 * MiB;
constexpr size_t WS_Y = 580 * MiB;
constexpr size_t WS_END = 1024 * MiB;
static_assert(WS_WDOWNM + (size_t)NEXP * D * DFFE * 2 <= WS_XN && WS_BIG + (size_t)M * NC * 2 <= WS_END && WS_BIG + (size_t)(PCHUNK + 8) * 256 * DFFE <= WS_Y && WS_Y + (size_t)NPMAX * 256 * D * 2 <= WS_END, "ws map");
constexpr int CW_TMO = 0, CW_BAR = 4096, CW_WMAX = 8192;

constexpr int RING_OFF = 0, RING_BYTES = 131072;
constexpr int LDSCTL_OFF = RING_BYTES, MISC_OFF = LDSCTL_OFF + 320;
constexpr int LDS_BYTES = 147456;

#define GAS __attribute__((address_space(1)))
#define LAS __attribute__((address_space(3)))
typedef unsigned short bf16;
typedef unsigned v4u __attribute__((ext_vector_type(4)));
typedef unsigned v2u __attribute__((ext_vector_type(2)));
typedef float f32x4 __attribute__((ext_vector_type(4)));
typedef GAS unsigned gu32;
#define RLX_AGENT __ATOMIC_RELAXED, __HIP_MEMORY_SCOPE_AGENT
#define LDS_WAIT() asm volatile("s_waitcnt lgkmcnt(0)" ::: "memory")
#define VM_WAIT() asm volatile("s_waitcnt vmcnt(0)" ::: "memory")
__device__ __forceinline__ unsigned f2bf(float f) { unsigned u = __builtin_bit_cast(unsigned, f); return (u + 0x7fffu + ((u >> 16) & 1u)) >> 16; }
__device__ __forceinline__ unsigned pk2(float lo, float hi) { return f2bf(lo) | (f2bf(hi) << 16); }
__device__ __forceinline__ float bflo(unsigned u) { return __uint_as_float(u << 16); }
__device__ __forceinline__ float bfhi(unsigned u) { return __uint_as_float(u & 0xffff0000u); }
__device__ __forceinline__ float bf1(bf16 h) { return __uint_as_float((unsigned)h << 16); }

#define XB_TMO      128
#define XB_XCNT(j)  (256  + 64 * (j))
#define XB_XSUB(j)  (1280 + 64 * (j))
#define XB_XGEN(j)  (2304 + 64 * (j))
#define XB_TOP      3328
#define XB_TOPGEN   3392
#define XCD_BAR_WORDS 3456
#define XB_SPIN_CAP (1u << 22)
__device__ __forceinline__ unsigned xb_ld(unsigned* p)              { return __hip_atomic_load(p, __ATOMIC_RELAXED, __HIP_MEMORY_SCOPE_AGENT); }
__device__ __forceinline__ unsigned xb_add(unsigned* p, unsigned v) { return __hip_atomic_fetch_add(p, v, __ATOMIC_RELAXED, __HIP_MEMORY_SCOPE_AGENT); }
__device__ __forceinline__ unsigned xb_xcc_id() { return (unsigned)__builtin_amdgcn_s_getreg((3 << 11) | 20) & 0xFu; }
#define XB_SPIN(cond, bar) do { unsigned _sp = 0; while (cond) { __builtin_amdgcn_s_sleep(1); \
    if ((++_sp & 255u) == 0u) { if (xb_ld(&(bar)[XB_TMO])) break; if (_sp > XB_SPIN_CAP) { atomicAdd(&(bar)[XB_TMO], 1u); break; } } } } while (0)
struct XcdBarrier { unsigned* bar; unsigned x; volatile LAS unsigned* st; };
__device__ __forceinline__ XcdBarrier xcd_barrier_post(unsigned* bar, volatile LAS unsigned* st, bool t0) {
    XcdBarrier b; b.bar = bar; b.x = xb_xcc_id(); b.st = st;
    if (t0) (void)xb_add(&bar[XB_XCNT(b.x)], 1u);
    return b;
}
__device__ __forceinline__ void xcd_barrier_complete(unsigned* bar, unsigned x, unsigned& nloc, unsigned& nx) {
    const unsigned G = gridDim.x * gridDim.y * gridDim.z;
    unsigned sum, cnt, mine, sp = 0u;
    for (;;) {
        sum = 0u; cnt = 0u; mine = 0u;
#pragma unroll
        for (unsigned j = 0; j < 16; ++j) { const unsigned c = xb_ld(&bar[XB_XCNT(j)]); sum += c; cnt += (c > 0u) ? 1u : 0u; mine = (j == x) ? c : mine; }
        if (sum == G) break;
        __builtin_amdgcn_s_sleep(1);
        if ((++sp & 255u) == 0u) { if (xb_ld(&bar[XB_TMO])) break; if (sp > XB_SPIN_CAP) { atomicAdd(&bar[XB_TMO], 1u); break; } }
    }
    nloc = mine > 0u ? mine : 1u; nx = cnt > 0u ? cnt : 1u;
}
__device__ __forceinline__ void xcd_barrier(const XcdBarrier& b, bool t0) {
    asm volatile("s_waitcnt vmcnt(0)" ::: "memory");
    __syncthreads();
    if (t0) {
        unsigned* bar = b.bar;
        __builtin_amdgcn_s_waitcnt(0);
        unsigned nloc = b.st[0], nx = b.st[1];
        if (nloc == 0u) { xcd_barrier_complete(bar, b.x, nloc, nx); b.st[0] = nloc; b.st[1] = nx; }
        const unsigned old = xb_add(&bar[XB_XSUB(b.x)], 1u);
        const unsigned gen = old / nloc;
        if (old + 1u == (gen + 1u) * nloc) {
            __builtin_amdgcn_fence(__ATOMIC_RELEASE, "agent");
            asm volatile("s_waitcnt vmcnt(0)" ::: "memory");
            const unsigned og = xb_add(&bar[XB_TOP], 1u);
            const unsigned tg = og / nx;
            if (og + 1u == (tg + 1u) * nx) xb_add(&bar[XB_TOPGEN], 1u);
            else XB_SPIN(xb_ld(&bar[XB_TOPGEN]) == tg, bar);
            __builtin_amdgcn_fence(__ATOMIC_ACQUIRE, "agent");
            xb_add(&bar[XB_XGEN(b.x)], 1u);
            asm volatile("s_waitcnt vmcnt(0)" ::: "memory");
        } else {
            XB_SPIN(xb_ld(&bar[XB_XGEN(b.x)]) == gen, bar);
            __builtin_amdgcn_fence(__ATOMIC_ACQUIRE, "agent");
            asm volatile("s_waitcnt vmcnt(0)" ::: "memory");
        }
    }
    __syncthreads();
}

__device__ __forceinline__ int lane_id() { int l; asm volatile("v_mbcnt_lo_u32_b32 %0, -1, 0\n\tv_mbcnt_hi_u32_b32 %0, -1, %0" : "=v"(l)); return l; }
template <int CTRL> __device__ __forceinline__ float dpp_f(float v) { return __int_as_float(__builtin_amdgcn_update_dpp(0, __float_as_int(v), CTRL, 0xf, 0xf, true)); }
__device__ __forceinline__ float wave_sum(float v) {
    v += dpp_f<0xB1>(v); v += dpp_f<0x4E>(v); v += dpp_f<0x141>(v); v += dpp_f<0x140>(v);
    { auto r = __builtin_amdgcn_permlane16_swap(__float_as_uint(v), __float_as_uint(v), false, false); v = __uint_as_float(r[0]) + __uint_as_float(r[1]); }
    { auto r = __builtin_amdgcn_permlane32_swap(__float_as_uint(v), __float_as_uint(v), false, false); v = __uint_as_float(r[0]) + __uint_as_float(r[1]); }
    return v;
}
__device__ __forceinline__ float wave_max(float v) {
    v = fmaxf(v, dpp_f<0xB1>(v)); v = fmaxf(v, dpp_f<0x4E>(v)); v = fmaxf(v, dpp_f<0x141>(v)); v = fmaxf(v, dpp_f<0x140>(v));
    { auto r = __builtin_amdgcn_permlane16_swap(__float_as_uint(v), __float_as_uint(v), false, false); v = fmaxf(__uint_as_float(r[0]), __uint_as_float(r[1])); }
    { auto r = __builtin_amdgcn_permlane32_swap(__float_as_uint(v), __float_as_uint(v), false, false); v = fmaxf(__uint_as_float(r[0]), __uint_as_float(r[1])); }
    return v;
}
__device__ __forceinline__ float sigmoidf_(float z) { return 1.f / (1.f + __expf(-z)); }
__device__ __forceinline__ float sigm_fast(float z) { return __builtin_amdgcn_rcpf(1.f + __builtin_amdgcn_exp2f(-1.4426950408889634f * z)); }

__device__ __forceinline__ void transpose_item(const float* W, int ldw, int K, bf16* WT, int k0, int n0, int dst_row0, LAS float* scr, int lane) {
#pragma unroll 16
    for (int i = 0; i < 32; ++i) { const int kk = 2 * i + (lane >> 5); scr[kk * 33 + (lane & 31)] = W[(size_t)(k0 + kk) * ldw + n0 + (lane & 31)]; }
    LDS_WAIT(); asm volatile("" ::: "memory");
    const int c = lane & 7;
#pragma unroll
    for (int j = 0; j < 4; ++j) { const int n = (lane >> 3) + 8 * j; const LAS float* s = scr + (8 * c) * 33 + n;
        v4u o; o.x = pk2(s[0 * 33], s[1 * 33]); o.y = pk2(s[2 * 33], s[3 * 33]); o.z = pk2(s[4 * 33], s[5 * 33]); o.w = pk2(s[6 * 33], s[7 * 33]);
        *(GAS v4u*)(WT + (size_t)(dst_row0 + n) * K + k0 + 8 * c) = o; }
    LDS_WAIT(); asm volatile("" ::: "memory");
}


typedef float f32x16 __attribute__((ext_vector_type(16)));
typedef short s16x4 __attribute__((ext_vector_type(4)));
typedef short v4i16_t __attribute__((ext_vector_type(4)));
typedef short bf16x8v __attribute__((ext_vector_type(8)));
typedef float f32x2_t __attribute__((ext_vector_type(2))); typedef __bf16 bf16x2_t __attribute__((ext_vector_type(2)));
__device__ __forceinline__ unsigned cvtpk_s(float lo, float hi) { f32x2_t v = {lo, hi}; bf16x2_t b = __builtin_convertvector(v, bf16x2_t); return __builtin_bit_cast(unsigned, b); }
__device__ __forceinline__ s16x4 vtr(const LAS unsigned char* p) { return __builtin_bit_cast(s16x4, __builtin_amdgcn_ds_read_tr16_b64_v4i16((LAS v4i16_t*)p)); }
__device__ __forceinline__ float max3f(float a, float b, float c) { float r; asm("v_max3_f32 %0, %1, %2, %3" : "=v"(r) : "v"(a), "v"(b), "v"(c)); return r; }
__device__ __forceinline__ float max2f(float a, float b) { float r; asm("v_max_f32_e32 %0, %1, %2" : "=v"(r) : "v"(a), "v"(b)); return r; }
typedef float f32x16r __attribute__((ext_vector_type(16)));
__device__ __forceinline__ float rowmax16(f32x16r& s) {
    asm volatile("s_nop 15\n\ts_nop 7" : "+v"(s));
    float a = max3f(s[0], s[1], s[2]), b = max3f(s[3], s[4], s[5]);
    a = max3f(a, s[6], s[7]); b = max3f(b, s[8], s[9]); a = max3f(a, s[10], s[11]); b = max3f(b, s[12], s[13]); a = max3f(a, s[14], s[15]);
    float m = max2f(a, b);
    auto rr = __builtin_amdgcn_permlane32_swap(__float_as_uint(m), __float_as_uint(m), false, false);
    return max2f(__uint_as_float(rr[0]), __uint_as_float(rr[1]));
}
__device__ __forceinline__ float halfmax(float m) { auto rr = __builtin_amdgcn_permlane32_swap(__float_as_uint(m), __float_as_uint(m), false, false); return fmaxf(__uint_as_float(rr[0]), __uint_as_float(rr[1])); }
__device__ __forceinline__ float halfsum(float m) { auto rr = __builtin_amdgcn_permlane32_swap(__float_as_uint(m), __float_as_uint(m), false, false); return __uint_as_float(rr[0]) + __uint_as_float(rr[1]); }
struct FlashSt { float m, l; f32x16 o0, o1; };
template <bool HAS_BIAS>
__device__ __forceinline__ void flash_tiles(FlashSt& st, const bf16x8v (&qf)[4], const bf16* Kb, const bf16* Vb, int tok0, int stride, int ntiles, int tstep, int LQ, int LK0, int W,
                                            const LAS float* cumL, LAS unsigned char* vbuf, int lane) {
    const int r32 = lane & 31, hi = lane >> 5, vj = lane >> 3, vc = lane & 7;
    LAS unsigned char* const vw = vbuf + (vc >> 2) * 2048 + vj * 64 + (vc & 3) * 16;
    const LAS unsigned char* const vr = vbuf + ((lane >> 4) & 1) * 32 + (lane & 3) * 8 + (4 * hi + ((lane & 15) >> 2)) * 64;
    bf16x8v kf[4]; v4u vch[4];
#define FL_LOAD(KT, KF, VCH) do { const int t0_ = tok0 + (KT) * tstep; int tk_ = t0_ + stride * r32; tk_ = tk_ < 0 ? 0 : tk_; const bf16* kp_ = Kb + (size_t)tk_ * NAB + 8 * hi; \
        _Pragma("unroll") for (int d0 = 0; d0 < 4; ++d0) KF[d0] = *(const bf16x8v*)(kp_ + 16 * d0); \
        _Pragma("unroll") for (int i = 0; i < 4; ++i) { int tv_ = t0_ + stride * (vj + 8 * i); tv_ = tv_ < 0 ? 0 : tv_; VCH[i] = *(const v4u*)(Vb + (size_t)tv_ * NAB + 8 * vc); } } while (0)
    FL_LOAD(0, kf, vch);
    for (int kt = 0; kt < ntiles; ++kt) {
        bf16x8v kfn[4]; v4u vchn[4];
        { const int ktn = (kt + 1 < ntiles) ? kt + 1 : kt; FL_LOAD(ktn, kfn, vchn); }
#pragma unroll
        for (int i = 0; i < 4; ++i) *(LAS v4u*)(vw + i * 512) = vch[i];
        asm volatile("s_waitcnt lgkmcnt(0)" ::: "memory");
        f32x16 s; const int LKt = LK0 + 32 * kt;
        if (HAS_BIAS) { const LAS float* cp = cumL + tok0 + kt * tstep + 4 * hi;
#pragma unroll
            for (int g = 0; g < 4; ++g) { const f32x4 c4 = *(const LAS f32x4*)(cp + 8 * g);
#pragma unroll
                for (int c = 0; c < 4; ++c) s[4 * g + c] = -c4[c]; } }
        else {
#pragma unroll
            for (int r = 0; r < 16; ++r) s[r] = 0.f; }
        { const int e = LQ - LKt - 4 * hi; int lo = e - W; const int lo3 = -LKt - 4 * hi; lo = lo > lo3 ? lo : lo3;
          if (!__all(lo <= 0 && e >= 27)) {
#pragma unroll
              for (int r = 0; r < 16; ++r) { const int jr = (r & 3) + 8 * (r >> 2); if (jr < lo || jr > e) s[r] = -INFINITY; } } }
        asm volatile("" : "+v"(s));
#pragma unroll
        for (int d0 = 0; d0 < 4; ++d0) s = __builtin_amdgcn_mfma_f32_32x32x16_bf16(kf[d0], qf[d0], s, 0, 0, 0);
        const float mloc = rowmax16(s);
        const float mnew = fmaxf(st.m, mloc); const float alpha = __builtin_amdgcn_exp2f(st.m - mnew); st.m = mnew;
        float lsum = 0.f;
#pragma unroll
        for (int r = 0; r < 16; ++r) { s[r] = __builtin_amdgcn_exp2f(s[r] - mnew); lsum += s[r]; }
        st.l = st.l * alpha + lsum;
        if (__any(alpha != 1.f)) { st.o0 = st.o0 * alpha; st.o1 = st.o1 * alpha; }
        v4u pw0, pw1;
        pw0.x = cvtpk_s(s[0], s[1]); pw0.y = cvtpk_s(s[2], s[3]); pw0.z = cvtpk_s(s[4], s[5]); pw0.w = cvtpk_s(s[6], s[7]);
        pw1.x = cvtpk_s(s[8], s[9]); pw1.y = cvtpk_s(s[10], s[11]); pw1.z = cvtpk_s(s[12], s[13]); pw1.w = cvtpk_s(s[14], s[15]);
        const bf16x8v pf0 = __builtin_bit_cast(bf16x8v, pw0), pf1 = __builtin_bit_cast(bf16x8v, pw1);
#define FL_VF(D0, KS) ({ const s16x4 lo_ = vtr(vr + (D0) * 2048 + (KS) * 1024), hi_ = vtr(vr + (D0) * 2048 + (KS) * 1024 + 512); (bf16x8v){lo_[0], lo_[1], lo_[2], lo_[3], hi_[0], hi_[1], hi_[2], hi_[3]}; })
        { const bf16x8v a00 = FL_VF(0, 0), a01 = FL_VF(0, 1), a10 = FL_VF(1, 0), a11 = FL_VF(1, 1);
          st.o0 = __builtin_amdgcn_mfma_f32_32x32x16_bf16(a00, pf0, st.o0, 0, 0, 0); st.o0 = __builtin_amdgcn_mfma_f32_32x32x16_bf16(a01, pf1, st.o0, 0, 0, 0);
          st.o1 = __builtin_amdgcn_mfma_f32_32x32x16_bf16(a10, pf0, st.o1, 0, 0, 0); st.o1 = __builtin_amdgcn_mfma_f32_32x32x16_bf16(a11, pf1, st.o1, 0, 0, 0); }
#undef FL_VF
        asm volatile("s_waitcnt lgkmcnt(0)" ::: "memory");
#pragma unroll
        for (int d0 = 0; d0 < 4; ++d0) kf[d0] = kfn[d0];
#pragma unroll
        for (int i = 0; i < 4; ++i) vch[i] = vchn[i];
    }
#undef FL_LOAD
}
__device__ __forceinline__ void flash_tiles2(FlashSt (&st)[2], const bf16x8v (&qf)[2][4], const bf16* Kb, const bf16* Vb, int tok0, int stride, int ntiles, int tstep, const int (&LQ)[2], const int (&LQb)[2], int LK0, int W,
                                             LAS unsigned char* vbuf, int lane) {
    const int r32 = lane & 31, hi = lane >> 5, vj = lane >> 3, vc = lane & 7;
    LAS unsigned char* const vw = vbuf + (vc >> 2) * 2048 + vj * 64 + (vc & 3) * 16;
    const LAS unsigned char* const vr = vbuf + ((lane >> 4) & 1) * 32 + (lane & 3) * 8 + (4 * hi + ((lane & 15) >> 2)) * 64;
    bf16x8v kf[4]; v4u vch[4];
#define FL_LOAD(KT, KF, VCH) do { const int t0_ = tok0 + (KT) * tstep; int tk_ = t0_ + stride * r32; tk_ = tk_ < 0 ? 0 : tk_; const bf16* kp_ = Kb + (size_t)tk_ * NAB + 8 * hi; \
        _Pragma("unroll") for (int d0 = 0; d0 < 4; ++d0) KF[d0] = *(const bf16x8v*)(kp_ + 16 * d0); \
        _Pragma("unroll") for (int i = 0; i < 4; ++i) { int tv_ = t0_ + stride * (vj + 8 * i); tv_ = tv_ < 0 ? 0 : tv_; VCH[i] = *(const v4u*)(Vb + (size_t)tv_ * NAB + 8 * vc); } } while (0)
    FL_LOAD(0, kf, vch);
    for (int kt = 0; kt < ntiles; ++kt) {
        bf16x8v kfn[4]; v4u vchn[4];
        { const int ktn = (kt + 1 < ntiles) ? kt + 1 : kt; FL_LOAD(ktn, kfn, vchn); }
#pragma unroll
        for (int i = 0; i < 4; ++i) *(LAS v4u*)(vw + i * 512) = vch[i];
        asm volatile("s_waitcnt lgkmcnt(0)" ::: "memory");
        const int LKt = LK0 + 32 * kt;
#define FL_VF(D0, KS) ({ const s16x4 lo_ = vtr(vr + (D0) * 2048 + (KS) * 1024), hi_ = vtr(vr + (D0) * 2048 + (KS) * 1024 + 512); (bf16x8v){lo_[0], lo_[1], lo_[2], lo_[3], hi_[0], hi_[1], hi_[2], hi_[3]}; })
        const bf16x8v a00 = FL_VF(0, 0), a01 = FL_VF(0, 1), a10 = FL_VF(1, 0), a11 = FL_VF(1, 1);
#undef FL_VF
#pragma unroll
        for (int q = 0; q < 2; ++q) if (LKt <= LQb[q] + 31 && LKt + 31 >= LQb[q] - W && LKt + 31 >= 0) {
            f32x16 s;
#pragma unroll
            for (int r = 0; r < 16; ++r) s[r] = 0.f;
            { const int e = LQ[q] - LKt - 4 * hi; int lo = e - W; const int lo3 = -LKt - 4 * hi; lo = lo > lo3 ? lo : lo3;
              if (!__all(lo <= 0 && e >= 27)) {
#pragma unroll
                  for (int r = 0; r < 16; ++r) { const int jr = (r & 3) + 8 * (r >> 2); if (jr < lo || jr > e) s[r] = -INFINITY; } } }
            asm volatile("" : "+v"(s));
#pragma unroll
            for (int d0 = 0; d0 < 4; ++d0) s = __builtin_amdgcn_mfma_f32_32x32x16_bf16(kf[d0], qf[q][d0], s, 0, 0, 0);
            const float mloc = rowmax16(s);
            const float mnew = fmaxf(st[q].m, mloc); const float alpha = __builtin_amdgcn_exp2f(st[q].m - mnew); st[q].m = mnew;
            float lsum = 0.f;
#pragma unroll
            for (int r = 0; r < 16; ++r) { s[r] = __builtin_amdgcn_exp2f(s[r] - mnew); lsum += s[r]; }
            st[q].l = st[q].l * alpha + lsum;
            if (__any(alpha != 1.f)) { st[q].o0 = st[q].o0 * alpha; st[q].o1 = st[q].o1 * alpha; }
            v4u pw0, pw1;
            pw0.x = cvtpk_s(s[0], s[1]); pw0.y = cvtpk_s(s[2], s[3]); pw0.z = cvtpk_s(s[4], s[5]); pw0.w = cvtpk_s(s[6], s[7]);
            pw1.x = cvtpk_s(s[8], s[9]); pw1.y = cvtpk_s(s[10], s[11]); pw1.z = cvtpk_s(s[12], s[13]); pw1.w = cvtpk_s(s[14], s[15]);
            const bf16x8v pf0 = __builtin_bit_cast(bf16x8v, pw0), pf1 = __builtin_bit_cast(bf16x8v, pw1);
            st[q].o0 = __builtin_amdgcn_mfma_f32_32x32x16_bf16(a00, pf0, st[q].o0, 0, 0, 0); st[q].o0 = __builtin_amdgcn_mfma_f32_32x32x16_bf16(a01, pf1, st[q].o0, 0, 0, 0);
            st[q].o1 = __builtin_amdgcn_mfma_f32_32x32x16_bf16(a10, pf0, st[q].o1, 0, 0, 0); st[q].o1 = __builtin_amdgcn_mfma_f32_32x32x16_bf16(a11, pf1, st[q].o1, 0, 0, 0);
        }
        asm volatile("s_waitcnt lgkmcnt(0)" ::: "memory");
#pragma unroll
        for (int d0 = 0; d0 < 4; ++d0) kf[d0] = kfn[d0];
#pragma unroll
        for (int i = 0; i < 4; ++i) vch[i] = vchn[i];
    }
#undef FL_LOAD
}
__device__ __forceinline__ void flash_init(FlashSt& st) { st.m = -1e30f; st.l = 0.f;
#pragma unroll
    for (int r = 0; r < 16; ++r) { st.o0[r] = 0.f; st.o1[r] = 0.f; } }
__device__ __forceinline__ void flash_store(const FlashSt& st, bf16* orow, int lane) {
    const int hi = lane >> 5; const float inv = 1.f / halfsum(st.l);
    bf16* const dst = orow + 8 * hi;
#pragma unroll
    for (int kk = 0; kk < 4; ++kk) {
        const int g0 = (2 * kk) & 3, g1 = (2 * kk + 1) & 3;
        unsigned ax, ay, bx, by;
        if (kk < 2) { ax = cvtpk_s(st.o0[4 * g0] * inv, st.o0[4 * g0 + 1] * inv); ay = cvtpk_s(st.o0[4 * g0 + 2] * inv, st.o0[4 * g0 + 3] * inv);
                      bx = cvtpk_s(st.o0[4 * g1] * inv, st.o0[4 * g1 + 1] * inv); by = cvtpk_s(st.o0[4 * g1 + 2] * inv, st.o0[4 * g1 + 3] * inv); }
        else        { ax = cvtpk_s(st.o1[4 * g0] * inv, st.o1[4 * g0 + 1] * inv); ay = cvtpk_s(st.o1[4 * g0 + 2] * inv, st.o1[4 * g0 + 3] * inv);
                      bx = cvtpk_s(st.o1[4 * g1] * inv, st.o1[4 * g1 + 1] * inv); by = cvtpk_s(st.o1[4 * g1 + 2] * inv, st.o1[4 * g1 + 3] * inv); }
        { auto r = __builtin_amdgcn_permlane32_swap(ax, bx, false, false); ax = r[0]; bx = r[1]; }
        { auto r = __builtin_amdgcn_permlane32_swap(ay, by, false, false); ay = r[0]; by = r[1]; }
        v4u w; w.x = ax; w.y = ay; w.z = bx; w.w = by;
        *(v4u*)(dst + 16 * kk) = w; }
}

__device__ __forceinline__ void quant_item(const float* W, int ldw, int K, signed char* WQ, float* sb, int n0, int dst_row0, LAS float* scr, int lane) {
    float cmax = 0.f;
#pragma nounroll
    for (int k0 = 0; k0 < K; k0 += 64) {
#pragma unroll
        for (int i = 0; i < 32; ++i) { const int kk = 2 * i + (lane >> 5); cmax = fmaxf(cmax, fabsf(W[(size_t)(k0 + kk) * ldw + n0 + (lane & 31)])); } }
    cmax = halfmax(cmax);
    const float sc = cmax > 0.f ? cmax * (1.f / 127.f) : 1.f;
    LAS float* scl = scr + 64 * 33;
    if (lane < 32) { scl[lane] = 1.f / sc; sb[dst_row0 + lane] = sc; }
    LDS_WAIT(); asm volatile("" ::: "memory");
    const int c = lane & 7;
#pragma nounroll
    for (int k0 = 0; k0 < K; k0 += 64) {
        LAS float* scr_ = scr; asm volatile("" : "+v"(scr_));
#pragma unroll 16
        for (int i = 0; i < 32; ++i) { const int kk = 2 * i + (lane >> 5); scr_[kk * 33 + (lane & 31)] = W[(size_t)(k0 + kk) * ldw + n0 + (lane & 31)]; }
        LDS_WAIT(); asm volatile("" ::: "memory");
#pragma unroll
        for (int j = 0; j < 4; ++j) { const int n = (lane >> 3) + 8 * j; const LAS float* sp = scr_ + (8 * c) * 33 + n; const float is = scl[n];
            int q[8];
#pragma unroll
            for (int e = 0; e < 8; ++e) q[e] = (int)rintf(sp[e * 33] * is) & 0xff;
            v2u o; o.x = (unsigned)q[0] | ((unsigned)q[1] << 8) | ((unsigned)q[2] << 16) | ((unsigned)q[3] << 24); o.y = (unsigned)q[4] | ((unsigned)q[5] << 8) | ((unsigned)q[6] << 16) | ((unsigned)q[7] << 24);
            *(GAS v2u*)(WQ + (size_t)(dst_row0 + n) * K + k0 + 8 * c) = o; }
        LDS_WAIT(); asm volatile("" ::: "memory");
    }
}


__device__ __forceinline__ void st_save(const FlashSt& st, LAS float* row) {
    *(LAS f32x2_t*)row = (f32x2_t){st.m, st.l};
#pragma unroll
    for (int g = 0; g < 4; ++g) { *(LAS f32x4*)(row + 4 + 4 * g) = (f32x4){st.o0[4 * g], st.o0[4 * g + 1], st.o0[4 * g + 2], st.o0[4 * g + 3]};
        *(LAS f32x4*)(row + 20 + 4 * g) = (f32x4){st.o1[4 * g], st.o1[4 * g + 1], st.o1[4 * g + 2], st.o1[4 * g + 3]}; }
}
__device__ __forceinline__ void st_load(FlashSt& st, const LAS float* row) {
    const f32x2_t ml = *(const LAS f32x2_t*)row; st.m = ml.x; st.l = ml.y;
#pragma unroll
    for (int g = 0; g < 4; ++g) { const f32x4 a = *(const LAS f32x4*)(row + 4 + 4 * g), b = *(const LAS f32x4*)(row + 20 + 4 * g);
#pragma unroll
        for (int c = 0; c < 4; ++c) { st.o0[4 * g + c] = a[c]; st.o1[4 * g + c] = b[c]; } }
}
__device__ __forceinline__ void st_save16(const FlashSt& st, LAS unsigned char* row) {
#pragma unroll
    for (int g = 0; g < 2; ++g) { v4u a, b;
        a.x = cvtpk_s(st.o0[8 * g], st.o0[8 * g + 1]); a.y = cvtpk_s(st.o0[8 * g + 2], st.o0[8 * g + 3]); a.z = cvtpk_s(st.o0[8 * g + 4], st.o0[8 * g + 5]); a.w = cvtpk_s(st.o0[8 * g + 6], st.o0[8 * g + 7]);
        b.x = cvtpk_s(st.o1[8 * g], st.o1[8 * g + 1]); b.y = cvtpk_s(st.o1[8 * g + 2], st.o1[8 * g + 3]); b.z = cvtpk_s(st.o1[8 * g + 4], st.o1[8 * g + 5]); b.w = cvtpk_s(st.o1[8 * g + 6], st.o1[8 * g + 7]);
        *(LAS v4u*)(row + 16 * g) = a; *(LAS v4u*)(row + 32 + 16 * g) = b; }
    *(LAS f32x2_t*)(row + 64) = (f32x2_t){st.m, st.l};
}
__device__ __forceinline__ void st_load16(FlashSt& st, const LAS unsigned char* row) {
#pragma unroll
    for (int g = 0; g < 2; ++g) { const v4u a = *(const LAS v4u*)(row + 16 * g), b = *(const LAS v4u*)(row + 32 + 16 * g);
        st.o0[8 * g] = bflo(a.x); st.o0[8 * g + 1] = bfhi(a.x); st.o0[8 * g + 2] = bflo(a.y); st.o0[8 * g + 3] = bfhi(a.y); st.o0[8 * g + 4] = bflo(a.z); st.o0[8 * g + 5] = bfhi(a.z); st.o0[8 * g + 6] = bflo(a.w); st.o0[8 * g + 7] = bfhi(a.w);
        st.o1[8 * g] = bflo(b.x); st.o1[8 * g + 1] = bfhi(b.x); st.o1[8 * g + 2] = bflo(b.y); st.o1[8 * g + 3] = bfhi(b.y); st.o1[8 * g + 4] = bflo(b.z); st.o1[8 * g + 5] = bfhi(b.z); st.o1[8 * g + 6] = bflo(b.w); st.o1[8 * g + 7] = bfhi(b.w); }
    const f32x2_t ml = *(const LAS f32x2_t*)(row + 64); st.m = ml.x; st.l = ml.y;
}
template <bool HAS_BIAS, int NQ, int SUB = 1>
__device__ __forceinline__ void coop_block(FlashSt (&st)[NQ], const bf16x8v (&qf)[NQ][4], const bf16* Kb, const bf16* Vb, int T0, int NT, const int (&LQ)[NQ], int W, const int (&qlast)[NQ], const int (&kmin)[NQ], const LAS float* cumL, LAS unsigned char* stage, int wave, int lane) {
    const int r32 = lane & 31, h5 = lane >> 5;
    const int drow = 8 * wave + (lane >> 3);
    const bf16* const ksrc = Kb + 8 * ((lane & 7) ^ (lane >> 3));
    const bf16* const vsrc = Vb + 8 * ((lane & 7) ^ (((lane >> 4) & 1) << 2));
    const LAS unsigned char* const kr = stage + r32 * 128;
    const int trq_ = (lane & 15) >> 2;
    const LAS unsigned char* const vr = stage + 8192 + (4 * h5 + trq_) * 128 + ((lane >> 4) & 1) * 32 + (lane & 3) * 8;
#define CB_DMA(T, B) do { _Pragma("unroll") for (int sb_ = 0; sb_ < SUB; ++sb_) { int rk_ = T0 + 64 * SUB * (T) + 64 * sb_ + drow; rk_ = rk_ < 0 ? 0 : rk_; \
        __builtin_amdgcn_global_load_lds((const unsigned*)(ksrc + (size_t)rk_ * NAB), (LAS unsigned*)(stage + ((B) * SUB + sb_) * 16384 + wave * 1024), 16, 0, 0); \
        __builtin_amdgcn_global_load_lds((const unsigned*)(vsrc + (size_t)rk_ * NAB), (LAS unsigned*)(stage + ((B) * SUB + sb_) * 16384 + 8192 + wave * 1024), 16, 0, 0); } } while (0)
    CB_DMA(NT - 1, 0);
    for (int tt = 0; tt < NT; ++tt) { const int t = NT - 1 - tt;
        asm volatile("s_waitcnt vmcnt(0)" ::: "memory"); __builtin_amdgcn_s_barrier(); asm volatile("" ::: "memory");
        if (tt + 1 < NT) CB_DMA(t - 1, (tt + 1) & 1);
        const int bo0 = (tt & 1) * SUB * 16384;
#pragma unroll
        for (int kq = 0; kq < 2 * SUB; ++kq) { const int kh2 = 2 * SUB - 1 - kq, kh = kh2 & 1, bo = bo0 + (kh2 >> 1) * 16384; const int k0 = T0 + 64 * SUB * t + 32 * kh2;
            bool need[NQ]; bool any = false;
#pragma unroll
            for (int q = 0; q < NQ; ++q) { need[q] = (k0 <= qlast[q]) && (k0 + 31 >= kmin[q]); any = any || need[q]; }
            if (any) {
                bf16x8v kf[4];
#pragma unroll
                for (int d0 = 0; d0 < 4; ++d0) kf[d0] = *(const LAS bf16x8v*)(kr + bo + kh * 4096 + (((2 * d0 + h5) ^ (r32 & 7)) << 4));
                f32x4 cb[4];
                if (HAS_BIAS) { const LAS float* cp = cumL + k0 + 4 * h5;
#pragma unroll
                    for (int g = 0; g < 4; ++g) cb[g] = *(const LAS f32x4*)(cp + 8 * g); }
                const LAS unsigned char* vb = vr + bo + kh * 4096;
#define FX_VF(DH, KS) ({ const s16x4 lo_ = vtr(vb + (((DH) ^ (trq_ >> 1)) * 64) + (KS) * 2048), hi_ = vtr(vb + (((DH) ^ (trq_ >> 1)) * 64) + (KS) * 2048 + 1024); (bf16x8v){lo_[0], lo_[1], lo_[2], lo_[3], hi_[0], hi_[1], hi_[2], hi_[3]}; })
                const bf16x8v a00 = FX_VF(0, 0), a01 = FX_VF(0, 1), a10 = FX_VF(1, 0), a11 = FX_VF(1, 1);
#undef FX_VF
#pragma unroll
                for (int q = 0; q < NQ; ++q) if (need[q]) {
                    f32x16 s;
                    if (HAS_BIAS) {
#pragma unroll
                        for (int g = 0; g < 4; ++g)
#pragma unroll
                            for (int c = 0; c < 4; ++c) s[4 * g + c] = cb[g][c]; }
                    else {
#pragma unroll
                        for (int r = 0; r < 16; ++r) s[r] = 0.f; }
                    { const int e = LQ[q] - k0 - 4 * h5; int lo = e - W; const int lo3 = -k0 - 4 * h5; lo = lo > lo3 ? lo : lo3;
                      if (!__all(lo <= 0 && e >= 27)) {
#pragma unroll
                          for (int r = 0; r < 16; ++r) { const int jr = (r & 3) + 8 * (r >> 2); if (jr < lo || jr > e) s[r] = -INFINITY; } } }
                    asm volatile("" : "+v"(s));
#pragma unroll
                    for (int d0 = 0; d0 < 4; ++d0) s = __builtin_amdgcn_mfma_f32_32x32x16_bf16(kf[d0], qf[q][d0], s, 0, 0, 0);
                    const float mloc = rowmax16(s);
                    const float mnew = fmaxf(st[q].m, mloc); const float alpha = __builtin_amdgcn_exp2f(st[q].m - mnew); st[q].m = mnew;
                    f32x2_t ls2 = {0.f, 0.f}; const f32x2_t mn2 = {mnew, mnew};
#pragma unroll
                    for (int r = 0; r < 16; r += 2) { f32x2_t d2 = (f32x2_t){s[r], s[r + 1]} - mn2; d2.x = __builtin_amdgcn_exp2f(d2.x); d2.y = __builtin_amdgcn_exp2f(d2.y); ls2 += d2; s[r] = d2.x; s[r + 1] = d2.y; }
                    st[q].l = st[q].l * alpha + (ls2.x + ls2.y);
                    if (__any(alpha != 1.f)) { st[q].o0 = st[q].o0 * alpha; st[q].o1 = st[q].o1 * alpha; }
                    v4u pw0, pw1;
                    pw0.x = cvtpk_s(s[0], s[1]); pw0.y = cvtpk_s(s[2], s[3]); pw0.z = cvtpk_s(s[4], s[5]); pw0.w = cvtpk_s(s[6], s[7]);
                    pw1.x = cvtpk_s(s[8], s[9]); pw1.y = cvtpk_s(s[10], s[11]); pw1.z = cvtpk_s(s[12], s[13]); pw1.w = cvtpk_s(s[14], s[15]);
                    const bf16x8v pf0 = __builtin_bit_cast(bf16x8v, pw0), pf1 = __builtin_bit_cast(bf16x8v, pw1);
                    st[q].o0 = __builtin_amdgcn_mfma_f32_32x32x16_bf16(a00, pf0, st[q].o0, 0, 0, 0); st[q].o0 = __builtin_amdgcn_mfma_f32_32x32x16_bf16(a01, pf1, st[q].o0, 0, 0, 0);
                    st[q].o1 = __builtin_amdgcn_mfma_f32_32x32x16_bf16(a10, pf0, st[q].o1, 0, 0, 0); st[q].o1 = __builtin_amdgcn_mfma_f32_32x32x16_bf16(a11, pf1, st[q].o1, 0, 0, 0);
                }
            }
        }
        asm volatile("s_waitcnt lgkmcnt(0)" ::: "memory");
    }
    __builtin_amdgcn_s_barrier(); asm volatile("" ::: "memory");
#undef CB_DMA
}

__device__ __forceinline__ void absmax_item(const float* W, int ldw, int k0, int n0, unsigned* wm, int lane) {
    float mx = 0.f;
#pragma unroll
    for (int i = 0; i < 32; ++i) { const int kk = 2 * i + (lane >> 5); mx = fmaxf(mx, fabsf(W[(size_t)(k0 + kk) * ldw + n0 + (lane & 31)])); }
    mx = wave_max(mx);
    if (lane == 0) atomicMax(wm, __float_as_uint(mx));
}
__device__ __forceinline__ void transpose_item_f8(const float* W, int ldw, int K, unsigned char* WT, int k0, int n0, int dst_row0, float sc, LAS float* scr, int lane) {
#pragma unroll 16
    for (int i = 0; i < 32; ++i) { const int kk = 2 * i + (lane >> 5); scr[kk * 33 + (lane & 31)] = W[(size_t)(k0 + kk) * ldw + n0 + (lane & 31)]; }
    LDS_WAIT(); asm volatile("" ::: "memory");
    const int c = lane & 7;
#pragma unroll
    for (int j = 0; j < 4; ++j) { const int n = (lane >> 3) + 8 * j; const LAS float* sp = scr + (8 * c) * 33 + n; float v[8];
#pragma unroll
        for (int e = 0; e < 8; ++e) v[e] = __builtin_amdgcn_fmed3f(sp[e * 33] * sc, -448.f, 448.f);
        int w0 = 0, w1 = 0;
        w0 = __builtin_amdgcn_cvt_pk_fp8_f32(v[0], v[1], w0, false); w0 = __builtin_amdgcn_cvt_pk_fp8_f32(v[2], v[3], w0, true);
        w1 = __builtin_amdgcn_cvt_pk_fp8_f32(v[4], v[5], w1, false); w1 = __builtin_amdgcn_cvt_pk_fp8_f32(v[6], v[7], w1, true);
        v2u o; o.x = (unsigned)w0; o.y = (unsigned)w1;
        *(GAS v2u*)(WT + (size_t)(dst_row0 + n) * K + k0 + 8 * c) = o; }
    LDS_WAIT(); asm volatile("" ::: "memory");
}

#define NORM_Q_ROW(v, rstd, gn, m) do { float am_ = 0.f; \
        _Pragma("unroll") for (int j = 0; j < 4; ++j) { v[j] = v[j] * rstd * gn[j]; am_ = fmaxf(am_, fmaxf(fmaxf(fabsf(v[j].x), fabsf(v[j].y)), fmaxf(fabsf(v[j].z), fabsf(v[j].w)))); } \
        am_ = wave_max(am_); \
        const float sc_ = am_ > 0.f ? am_ * (1.f / 127.f) : 1.f, is_ = 1.f / sc_; if (lane == 0) SA[m] = sc_; \
        GAS unsigned* q4_ = (GAS unsigned*)(XQ + (size_t)(m) * D) + lane; \
        _Pragma("unroll") for (int j = 0; j < 4; ++j) q4_[64 * j] = ((unsigned)((int)rintf(v[j].x * is_) & 0xff)) | ((unsigned)((int)rintf(v[j].y * is_) & 0xff) << 8) | ((unsigned)((int)rintf(v[j].z * is_) & 0xff) << 16) | ((unsigned)((int)rintf(v[j].w * is_) & 0xff) << 24); } while (0)
#define XROW4(MROW, J) ({ const v2u u_ = *(const GAS v2u*)(X + (size_t)(MROW) * D + 4 * lane + 256 * (J)); (f32x4){bflo(u_.x), bfhi(u_.x), bflo(u_.y), bfhi(u_.y)}; })
#define NORM_Q_PHASE(gain) do { f32x4 gn[4]; _Pragma("unroll") for (int j = 0; j < 4; ++j) gn[j] = *(const f32x4*)((gain) + 4 * lane + 256 * j); \
        for (int m = gw; m < M; m += 2 * NGW) { const int m2 = m + NGW; const bool has2 = m2 < M;       \
            f32x4 v[4], w[4]; float ss = 0.f, ss2 = 0.f; \
            _Pragma("unroll") for (int j = 0; j < 4; ++j) { v[j] = XROW4(m, j); w[j] = XROW4(has2 ? m2 : m, j); } \
            _Pragma("unroll") for (int j = 0; j < 4; ++j) { ss += (v[j].x * v[j].x + v[j].y * v[j].y) + (v[j].z * v[j].z + v[j].w * v[j].w); ss2 += (w[j].x * w[j].x + w[j].y * w[j].y) + (w[j].z * w[j].z + w[j].w * w[j].w); } \
            const float rstd = 1.f / sqrtf(wave_sum(ss) * (1.f / D) + EPS); NORM_Q_ROW(v, rstd, gn, m); \
            if (has2) { const float rstd2 = 1.f / sqrtf(wave_sum(ss2) * (1.f / D) + EPS); NORM_Q_ROW(w, rstd2, gn, m2); } } } while (0)

__device__ __forceinline__ void quant_block(const float* W, int ldw, signed char* WQ, float* sb, int n0, int dst_row0, LAS unsigned char* T, LAS float* red, int wave, int lane) {
    const int tid = wave * 64 + lane;
    { const float* src = W + (size_t)(8 * wave + (lane >> 3)) * ldw + n0 + 4 * (lane & 7);
#pragma unroll
      for (int i = 0; i < 16; ++i) __builtin_amdgcn_global_load_lds((const unsigned*)(src + (size_t)(64 * i) * ldw), (LAS unsigned*)(T + (8 * wave + 64 * i) * 128), 16, 0, 0); }
    asm volatile("s_waitcnt vmcnt(0)" ::: "memory"); __builtin_amdgcn_s_barrier(); asm volatile("" ::: "memory");
    const LAS float* Tf = (const LAS float*)T;
    { const int n = tid & 31, part = tid >> 5; float mx = 0.f;
#pragma unroll 16
      for (int k = 0; k < 64; ++k) mx = fmaxf(mx, fabsf(Tf[(64 * part + k) * 32 + n]));
      red[part * 32 + n] = mx; }
    asm volatile("s_waitcnt lgkmcnt(0)" ::: "memory"); __builtin_amdgcn_s_barrier(); asm volatile("" ::: "memory");
    if (tid < 32) { float m = red[tid];
#pragma unroll
        for (int p = 1; p < 16; ++p) m = fmaxf(m, red[p * 32 + tid]);
        const float sc = m > 0.f ? m * (1.f / 127.f) : 1.f; red[512 + tid] = 1.f / sc; sb[dst_row0 + tid] = sc; }
    asm volatile("s_waitcnt lgkmcnt(0)" ::: "memory"); __builtin_amdgcn_s_barrier(); asm volatile("" ::: "memory");
    { const int n = tid & 31; const float is = red[512 + n];
#pragma unroll 2
      for (int i = 0; i < 8; ++i) { const int c = (tid >> 5) + 16 * i; const LAS float* sp = Tf + (8 * c) * 32 + n; int q[8];
#pragma unroll
          for (int e = 0; e < 8; ++e) q[e] = (int)rintf(sp[e * 32] * is) & 0xff;
          v2u o; o.x = (unsigned)q[0] | ((unsigned)q[1] << 8) | ((unsigned)q[2] << 16) | ((unsigned)q[3] << 24); o.y = (unsigned)q[4] | ((unsigned)q[5] << 8) | ((unsigned)q[6] << 16) | ((unsigned)q[7] << 24);
          *(GAS v2u*)(WQ + (size_t)(dst_row0 + n) * 1024 + 8 * c) = o; } }
    asm volatile("s_waitcnt lgkmcnt(0)" ::: "memory"); __builtin_amdgcn_s_barrier(); asm volatile("" ::: "memory");
}

struct Args { const float* in[19]; float* out; unsigned char* ws; int ph_lo, ph_hi; };

__global__ void __launch_bounds__(NTHR, 2) fwd_kernel(Args args) {
    extern __shared__ __attribute__((aligned(16))) unsigned char lds[];
    LAS unsigned char* const L = (LAS unsigned char*)lds;
    volatile LAS unsigned* const MISC = (volatile LAS unsigned*)(L + MISC_OFF);
    const int wave = __builtin_amdgcn_readfirstlane((int)threadIdx.x >> 6);
    const int G = gridDim.x, bx = blockIdx.x;
    const int gw = bx * NWAVES + wave, NGW = G * NWAVES;
    unsigned char* const ws = args.ws;
    gu32* const ctl = (gu32*)(ws + WS_CTL);
    const float* const x_in = args.in[0]; const int* const positions = (const int*)args.in[1];
    const float* const norm_mix = args.in[2]; const float* const norm_ffn = args.in[3];
    const float* const w_in_ab = args.in[4]; const float* const fgate_bias = args.in[5]; const float* const w_out_ab = args.in[6];
    const float* const w_in_c = args.in[7]; const float* const lower_bounds = args.in[8]; const float* const gnorm_c = args.in[9]; const float* const w_out_c = args.in[10];
    const float* const w_gate_ffn = args.in[11]; const float* const w_up_ffn = args.in[12]; const float* const w_down_ffn = args.in[13];
    const float* const router = args.in[14]; const float* const w_gate_moe = args.in[15]; const float* const w_up_moe = args.in[16]; const float* const w_down_moe = args.in[17];
    const float* const norm_final = args.in[18];
    bf16* const X = (bf16*)(ws + 880 * MiB);
    float* const OUTF = args.out;
#define ROPE ((float*)(ws + WS_ROPE))
#define LOGF ((float*)(ws + WS_LOGF))
#define CUM ((float*)(ws + WS_CUM))
#define TOPI ((int*)(ws + WS_TOPI))
#define TOPG ((float*)(ws + WS_TOPG))
#define RANK ((int*)(ws + WS_RANK))
#define POS ((int*)(ws + WS_POS))
#define ROWMAP ((int*)(ws + WS_ROWMAP))
#define CNT ((int*)(ws + WS_CNT))
#define META ((int*)(ws + WS_META))
#define WinAB_t ((bf16*)(ws + WS_WINAB))
#define WoutAB_t ((bf16*)(ws + WS_WOUTAB))
#define Wgu_t ((bf16*)(ws + WS_WGU))
#define Wdown_t ((bf16*)(ws + WS_WDOWN))
#define WinC_t ((bf16*)(ws + WS_WINC))
#define WoutC_t ((bf16*)(ws + WS_WOUTC))
#define WguM_t ((bf16*)(ws + WS_WGUM))
#define WdownM_t ((bf16*)(ws + WS_WDOWNM))
#define XN ((bf16*)(ws + WS_XN))
#define PROJ ((bf16*)(ws + WS_BIG))
#define HID ((bf16*)(ws + WS_BIG))
#define PROJC ((bf16*)(ws + WS_BIG))
#define HIDM ((bf16*)(ws + WS_BIG))
#define YB ((bf16*)(ws + WS_Y))
#define ATT XN
#define XQ ((signed char*)(ws + WS_XN))
#define SA ((float*)(ws + WS_SA))
#define SAS ((float*)(ws + WS_SAS))
#define SBD ((float*)(ws + WS_SBD))
#define SBM ((float*)(ws + WS_SBM))
#define WguQ ((signed char*)(ws + WS_WGU))
#define WinABQ ((signed char*)(ws + WS_WINAB))
#define WinCQ ((signed char*)(ws + WS_WINC))
#define SBAB ((float*)(ws + WS_SBAB))
#define SBC ((float*)(ws + WS_SBC))
#define WguMQ ((signed char*)(ws + WS_WGUM))

    { const int tid = wave * 64 + lane_id(); for (int u = tid; u < (LDS_BYTES - LDSCTL_OFF) / 4; u += NTHR) ((LAS unsigned*)(L + LDSCTL_OFF))[u] = 0u; }
    __syncthreads();
    if (!PER_PHASE_LAUNCH) (void)xcd_barrier_post((unsigned*)(ctl + CW_BAR), MISC + 8, wave == 0 && lane_id() == 0);
#define GRID_BAR() do { if (!PER_PHASE_LAUNCH) { XcdBarrier b_; b_.bar = (unsigned*)((gu32*)(args.ws + WS_CTL) + CW_BAR); b_.x = xb_xcc_id(); b_.st = (volatile LAS unsigned*)(L + MISC_OFF) + 8; xcd_barrier(b_, wave == 0 && lane_id() == 0); } } while (0)
    const int PH_LO = args.ph_lo, PH_HI = args.ph_hi;
#define IN(k) (PH_LO <= (k) && (k) < PH_HI)
#define BOTH(k) (IN(k) && IN((k) + 1))

    if (IN(0)) { const int lane = lane_id(), tid = wave * 64 + lane; (void)tid; (void)lane;
        { constexpr int NB_D = DFF / 32, NB_E = DFFE / 32, NB_AB = NAB / 32, NB_C = NC / 32;
          constexpr int NQ = NB_AB + NB_C + 2 * NB_D + NEXP * 2 * NB_E;
          LAS float* const red = (LAS float*)(L + LDSCTL_OFF + 1024);
          for (int q0_ = bx; q0_ < NQ; q0_ += G) {
              const float* src; int ldw, up = 0, nb, dst0; signed char* dq; float* sbq; int q = q0_;
              if (q < NB_AB + NB_C) { const bool isc = q >= NB_AB; nb = isc ? q - NB_AB : q; src = isc ? w_in_c : w_in_ab; ldw = isc ? NC : IN_AB; dq = isc ? WinCQ : WinABQ; sbq = isc ? SBC : SBAB; dst0 = 32 * nb; }
              else { q -= NB_AB + NB_C;
                  if (q < 2 * NB_D) { up = q >= NB_D; nb = up ? q - NB_D : q; src = up ? w_up_ffn : w_gate_ffn; ldw = DFF; dq = WguQ; sbq = SBD; }
                  else { const int r = q - 2 * NB_D, e = r / (2 * NB_E), rr = r - e * (2 * NB_E); up = rr >= NB_E; nb = up ? rr - NB_E : rr;
                      src = (up ? w_up_moe : w_gate_moe) + (size_t)e * D * DFFE; ldw = DFFE; dq = WguMQ + (size_t)e * NGUE * D; sbq = SBM + (size_t)e * NGUE; }
                  const int n0 = 32 * nb; dst0 = (n0 >> 7) * 256 + up * 128 + (n0 & 127); }
              quant_block(src, ldw, dq, sbq, 32 * nb, dst0, L + RING_OFF, red, wave, lane); } }
        LAS float* scr = (LAS float*)(L + RING_OFF + wave * 16384);
        {
          constexpr int I0 = (D / 64) * (NAB / 32), I1 = (D / 64) * (D / 32), I2 = (DFF / 64) * (D / 32), I3 = (D / 64) * (NC / 32), I4 = I1, I5E = (DFFE / 64) * (D / 32);
          constexpr int NIT = I1 + I2 + I4 + NEXP * I5E; (void)I0; (void)I3;
          for (int it = gw; it < NIT; it += NGW) {
              int r = it; const float* src; int ldw, Kd, nblk; bf16* dst;
              if (false) { src = nullptr; ldw = 0; Kd = 0; nblk = 1; dst = nullptr; }
              else if (r < I1) { src = w_out_ab; ldw = D; Kd = D; nblk = D / 32; dst = WoutAB_t; }
              else if ((r -= I1) < I2) { src = w_down_ffn; ldw = D; Kd = DFF; nblk = D / 32; dst = Wdown_t; }
              else if ((r -= I2) < I4) { src = w_out_c; ldw = D; Kd = D; nblk = D / 32; dst = WoutC_t; }
              else { r -= I4; const int e = r / I5E; r -= e * I5E; const int kb = r / (D / 32), nb = r - kb * (D / 32);
                  absmax_item(w_down_moe + (size_t)e * DFFE * D, D, 64 * kb, 32 * nb, (unsigned*)(ctl + CW_WMAX) + e, lane); continue; }
              const int kb = r / nblk, nb = r - kb * nblk;
              transpose_item(src, ldw, Kd, dst, 64 * kb, 32 * nb, 32 * nb, scr, lane); } }
        for (int idx = bx * NTHR + tid; idx < M * 8; idx += G * NTHR) { const int m = idx >> 3, i = idx & 7;
            const float invf = exp2f(-(float)i * (18.931568569324174f / 8.0f)); const float ang = (float)positions[m] * invf;
            ROPE[m * 16 + i] = cosf(ang); ROPE[m * 16 + 8 + i] = sinf(ang); }
        {
            float gw_[4][4][8]; f32x4 gn[4];
#pragma unroll
            for (int j = 0; j < 4; ++j) { gn[j] = *(const f32x4*)(norm_mix + 4 * lane + 256 * j);
#pragma unroll
                for (int c = 0; c < 4; ++c) { const int col = 4 * lane + 256 * j + c;
#pragma unroll
                    for (int h = 0; h < 8; ++h) gw_[j][c][h] = w_in_ab[(size_t)col * IN_AB + NAB + h] * gn[j][c]; } }
            float fb = (lane < 8) ? fgate_bias[lane] : 0.f;
            for (int m = gw; m < M; m += NGW) {
                const GAS f32x4* xr = (const GAS f32x4*)(x_in + (size_t)m * D) + lane;
                f32x4 v[4]; float ss = 0.f; float fl[8];
#pragma unroll
                for (int h = 0; h < 8; ++h) fl[h] = 0.f;
#pragma unroll
                for (int j = 0; j < 4; ++j) { v[j] = xr[64 * j]; ss += (v[j].x * v[j].x + v[j].y * v[j].y) + (v[j].z * v[j].z + v[j].w * v[j].w);
#pragma unroll
                    for (int c = 0; c < 4; ++c)
#pragma unroll
                        for (int h = 0; h < 8; ++h) fl[h] += v[j][c] * gw_[j][c][h]; }
                { GAS v2u* xo = (GAS v2u*)(X + (size_t)m * D) + lane;
#pragma unroll
                  for (int j = 0; j < 4; ++j) { v2u o; o.x = pk2(v[j].x, v[j].y); o.y = pk2(v[j].z, v[j].w); xo[64 * j] = o; } }
                const float rstd = 1.f / sqrtf(wave_sum(ss) * (1.f / D) + EPS);
                float mine = 0.f;
#pragma unroll
                for (int h = 0; h < 8; ++h) { const float t = wave_sum(fl[h]); if (lane == h) mine = t; }
                if (lane < 8) { const float z = mine * rstd + fb; LOGF[(size_t)m * 8 + lane] = fminf(z, 0.f) - log1pf(__expf(-fabsf(z))); }
                NORM_Q_ROW(v, rstd, gn, m);
            }
        }
        if (BOTH(0)) GRID_BAR();
    }

    if (IN(1)) { const int lane = lane_id(), tid = wave * 64 + lane; (void)tid; (void)lane;
        if (wave == 0) for (int bh = bx; bh < BATCH * NH; bh += G) { const int b = bh >> 3, h = bh & 7;
            float loc[32]; float s = 0.f;
#pragma unroll
            for (int i = 0; i < 32; ++i) { s += LOGF[((size_t)(b * SEQ + lane * 32 + i)) * 8 + h]; loc[i] = s; }
            float incl = s;
#pragma unroll
            for (int o = 1; o < 64; o <<= 1) { const float t = __shfl_up(incl, o); if (lane >= o) incl += t; }
            const float excl = incl - s;
#pragma unroll
            for (int i = 0; i < 32; ++i) CUM[(size_t)bh * SEQ + lane * 32 + i] = (excl + loc[i]) * LOG2E; }
        { LAS float* scr = (LAS float*)(L + RING_OFF + wave * 16384);
          constexpr int I5E = (DFFE / 64) * (D / 32);
          for (int it = gw; it < NEXP * I5E; it += NGW) { const int e = it / I5E, r = it - e * I5E, kb = r / (D / 32), nb = r - kb * (D / 32);
              const float am = __uint_as_float(((const unsigned*)(ctl + CW_WMAX))[e]); const float sc = am > 0.f ? 256.f / am : 1.f;
              transpose_item_f8(w_down_moe + (size_t)e * DFFE * D, D, DFFE, (unsigned char*)WdownM_t + (size_t)e * D * DFFE, 64 * kb, 32 * nb, 32 * nb, sc, scr, lane); }
          __syncthreads(); }
        pg8::Gemm g{(const bf16*)XQ, (const bf16*)WinABQ, M, NAB, D}; pg8::StaticOrder S; S.init(M, NAB, G, bx);
        pg8::EpiProjAB E{PROJ, NAB, ROPE, QSCALE_AB, SA, SBAB};
        pg8::gemm_phase<pg8::EpiProjAB, pg8::StaticOrder, true, false, 1>(L + RING_OFF, g, S, E, nullptr, wave);
        if (BOTH(1)) GRID_BAR();
    }

    if (IN(2)) { const int lane = lane_id(), tid = wave * 64 + lane; (void)tid; (void)lane;
        LAS unsigned char* const vbuf = L + wave * 4096;
        LAS float* const cumL = (LAS float*)(L + 32768);
        const int r32 = lane & 31, hi = lane >> 5;
        for (int bh = bx; bh < BATCH * NH; bh += G) { const int b = bh >> 3, h = bh & 7;
            const bf16* const Pb = PROJ + (size_t)b * SEQ * NAB;
            { const bf16* const Qb = Pb + h * HD; const bf16* const Kb = Pb + 512 + h * HD; const bf16* const Vb = Pb + 1024 + h * HD;
              LAS unsigned char* const STL = L + 40960;
              for (int qb2 = 0; qb2 < SEQ / 512; ++qb2) { const int q0 = 512 * qb2;
                { bf16x8v qfa[2][4]; FlashSt sta[2]; int lqa[2], qla[2], kma[2];
#pragma unroll
                  for (int q = 0; q < 2; ++q) { const int tq = q0 + 256 * q + 32 * wave + r32; lqa[q] = tq; qla[q] = q0 + 256 * q + 32 * wave + 31; kma[q] = q0 + 256 * q + 32 * wave - 128; flash_init(sta[q]);
#pragma unroll
                      for (int d0 = 0; d0 < 4; ++d0) qfa[q][d0] = *(const bf16x8v*)(Qb + (size_t)tq * NAB + 16 * d0 + 8 * hi); }
                  coop_block<false, 2>(sta, qfa, Kb, Vb, q0 - 128, 10, lqa, 128, qla, kma, cumL, L, wave, lane);
#pragma unroll
                  for (int q = 0; q < 2; ++q) st_save16(sta[q], STL + ((lqa[q] - q0) * 2 + hi) * 80); }
                __syncthreads();
                { const int c4 = wave & 3, hf = wave >> 2, l4b = (q0 >> 2) + 64 * hf;
                  bf16x8v qf2[2][4]; FlashSt st2[2]; int lq2[2], lqb2[2];
#pragma unroll
                  for (int q = 0; q < 2; ++q) { lqb2[q] = l4b + 32 * q; lq2[q] = lqb2[q] + r32; const int tq = 4 * lq2[q] + c4;
#pragma unroll
                      for (int d0 = 0; d0 < 4; ++d0) qf2[q][d0] = *(const bf16x8v*)(Qb + (size_t)tq * NAB + 16 * d0 + 8 * hi);
                      st_load16(st2[q], STL + ((tq - q0) * 2 + hi) * 80); }
                  flash_tiles2(st2, qf2, Kb, Vb, 4 * (l4b - 128) + c4, 4, 6, 128, lq2, lqb2, l4b - 128, 128, vbuf, lane);
#pragma unroll
                  for (int q = 0; q < 2; ++q) { const int tq = 4 * lq2[q] + c4; st_save16(st2[q], STL + ((tq - q0) * 2 + hi) * 80); } }
                __syncthreads();
                for (int cc = 0; cc < 2; ++cc) { const int cls = 2 * wave + cc, l16q = (q0 >> 4) + r32, tq = 16 * l16q + cls; bf16x8v qf[4];
#pragma unroll
                  for (int d0 = 0; d0 < 4; ++d0) qf[d0] = *(const bf16x8v*)(Qb + (size_t)tq * NAB + 16 * d0 + 8 * hi);
                  FlashSt st; st_load16(st, STL + ((tq - q0) * 2 + hi) * 80);
                  const int nt = ((q0 >> 4) + 32 + 31) >> 5;
                  flash_tiles<false>(st, qf, Kb, Vb, cls, 16, nt, 512, l16q, 0, 1 << 20, cumL, vbuf, lane);
                  flash_store(st, ATT + (size_t)(b * SEQ + tq) * D + h * HD, lane); }
                __syncthreads(); } }
            __syncthreads();
            LAS float* const cumF = (LAS float*)(L + 65536);
            for (int i = tid; i < SEQ; i += NTHR) cumF[i] = -CUM[(size_t)bh * SEQ + i];
            __syncthreads();
            { const bf16* const Qb = Pb + 1536 + h * HD; const bf16* const Kb = Pb + 2048 + h * HD; const bf16* const Vb = Pb + 2560 + h * HD;
              for (int qb = 0; qb < SEQ / 512; ++qb) { const int tq = 512 * qb + 32 * wave + r32;
                bf16x8v qf2[2][4];
#pragma unroll
                for (int q = 0; q < 2; ++q)
#pragma unroll
                    for (int d0 = 0; d0 < 4; ++d0) qf2[q][d0] = *(const bf16x8v*)(Qb + (size_t)(tq + 256 * q) * NAB + 16 * d0 + 8 * hi);
                FlashSt st2[2]; flash_init(st2[0]); flash_init(st2[1]);
                { const int lq2[2] = {tq, tq + 256}, ql2[2] = {512 * qb + 32 * wave + 31, 512 * qb + 256 + 32 * wave + 31}, km2[2] = {-(1 << 30), -(1 << 30)};
                  coop_block<true, 2, 2>(st2, qf2, Kb, Vb, 0, (512 * qb + 512) >> 7, lq2, 4096, ql2, km2, cumF, L, wave, lane); }
#pragma unroll
                for (int q = 0; q < 2; ++q) flash_store(st2[q], ATT + (size_t)(b * SEQ + tq + 256 * q) * D + 512 + h * HD, lane); } }
        }
        __syncthreads();
        if (BOTH(2)) GRID_BAR();
    }

    if (IN(3)) { const int lane = lane_id(), tid = wave * 64 + lane; (void)tid; (void)lane;
        pg8::Gemm g{ATT, WoutAB_t, M, D, D}; pg8::StaticOrder S; S.init(M, D, G, bx);
        pg8::EpiResidualB<false> E{X, X};
        pg8::gemm_phase<pg8::EpiResidualB<false>, pg8::StaticOrder, true, false>(L + RING_OFF, g, S, E, nullptr, wave);
        if (BOTH(3)) GRID_BAR();
    }

#define NORM_PHASE(gain) do { f32x4 gn[4]; _Pragma("unroll") for (int j = 0; j < 4; ++j) gn[j] = *(const f32x4*)((gain) + 4 * lane + 256 * j); \
        for (int m = gw; m < M; m += NGW) { f32x4 v[4]; float ss = 0.f; \
            _Pragma("unroll") for (int j = 0; j < 4; ++j) { v[j] = XROW4(m, j); ss += (v[j].x * v[j].x + v[j].y * v[j].y) + (v[j].z * v[j].z + v[j].w * v[j].w); } \
            const float rstd = 1.f / sqrtf(wave_sum(ss) * (1.f / D) + EPS); \
            GAS unsigned long long* o8 = (GAS unsigned long long*)(XN + (size_t)m * D) + lane; \
            _Pragma("unroll") for (int j = 0; j < 4; ++j) { const f32x4 y = v[j] * rstd * gn[j]; o8[64 * j] = (unsigned long long)pk2(y.x, y.y) | ((unsigned long long)pk2(y.z, y.w) << 32); } } } while (0)

    if (IN(4)) { const int lane = lane_id(), tid = wave * 64 + lane; (void)tid; (void)lane; NORM_Q_PHASE(norm_ffn); if (BOTH(4)) GRID_BAR(); }

    if (IN(5)) { const int lane = lane_id(), tid = wave * 64 + lane; (void)tid; (void)lane;
        pg8::Gemm g{(const bf16*)XQ, (const bf16*)WguQ, M, NGU, D}; pg8::StaticOrder S; S.init(M, NGU, G, bx);
        pg8::EpiSwiGLUI8 E{HID, DFF, 0, SA, SBD};
        pg8::gemm_phase<pg8::EpiSwiGLUI8, pg8::StaticOrder, true, false, 1>(L + RING_OFF, g, S, E, nullptr, wave);
        if (BOTH(5)) GRID_BAR();
    }
    if (IN(6)) { const int lane = lane_id(), tid = wave * 64 + lane; (void)tid; (void)lane;
        pg8::Gemm g{HID, Wdown_t, M, D, DFF}; pg8::StaticOrder S; S.init(M, D, G, bx);
        pg8::EpiResidualB<false> E{X, X};
        pg8::gemm_phase<pg8::EpiResidualB<false>, pg8::StaticOrder, true, false>(L + RING_OFF, g, S, E, nullptr, wave);
        if (BOTH(6)) GRID_BAR();
    }
    if (IN(7)) { const int lane = lane_id(), tid = wave * 64 + lane; (void)tid; (void)lane; NORM_Q_PHASE(norm_mix + D); if (BOTH(7)) GRID_BAR(); }
    if (IN(8)) { const int lane = lane_id(), tid = wave * 64 + lane; (void)tid; (void)lane;
        pg8::Gemm g{(const bf16*)XQ, (const bf16*)WinCQ, M, NC, D}; pg8::StaticOrder S; S.init(M, NC, G, bx);
        pg8::EpiBf16S E{PROJC, NC, 4, QSCALE_C, SA, SBC};
        pg8::gemm_phase<pg8::EpiBf16S, pg8::StaticOrder, true, false, 1>(L + RING_OFF, g, S, E, nullptr, wave);
        if (BOTH(8)) GRID_BAR();
    }
    if (IN(9)) { const int lane = lane_id(), tid = wave * 64 + lane; (void)tid; (void)lane;
#define HG_BAR() do { asm volatile("s_waitcnt lgkmcnt(0)" ::: "memory"); __builtin_amdgcn_s_barrier(); asm volatile("" ::: "memory"); } while (0)
        constexpr int PQ = 272, PV = 320;
        LAS unsigned char* const QT = L;
        LAS unsigned char* const KT = L + 17408;
        LAS unsigned char* const KH = L + 34816;
        LAS unsigned char* const VT = L + 55296;
        LAS float* const OL = (LAS float*)(L + 75776);
        LAS float* const EBL = (LAS float*)(L + 108544);
        LAS float* const GT = (LAS float*)(L + 109056);
        const int r32 = lane & 31, h5 = lane >> 5, tb = wave >> 2, eb = wave & 3, dp = lane, grp = wave;
        const int trq = (lane & 15) >> 2, trp = lane & 3, trc = (lane >> 4) & 1;
        for (int bh = bx; bh < BATCH * NH; bh += G) { const int b = bh >> 3, h = bh & 7;
            const float lbv0 = sigm_fast(lower_bounds[D + h * HK + 2 * dp] - lower_bounds[h * HK + 2 * dp]), lbv1 = sigm_fast(lower_bounds[D + h * HK + 2 * dp + 1] - lower_bounds[h * HK + 2 * dp + 1]);
            const float gn0 = gnorm_c[2 * lane], gn1 = gnorm_c[2 * lane + 1];
            f32x16 S[4];
#pragma unroll
            for (int i = 0; i < 4; ++i)
#pragma unroll
                for (int r = 0; r < 16; ++r) S[i][r] = 0.f;
            unsigned fraw[8], qraw[8]; v4u vraw[2]; unsigned graw[8];
#define HG_PRELOAD(CH) do { const int m0_ = b * SEQ + (CH) * 64; \
                _Pragma("unroll") for (int j = 0; j < 8; ++j) { const bf16* pr = PROJC + (size_t)(m0_ + 8 * grp + j) * NC + h * HK + 2 * dp; fraw[j] = *(const unsigned*)(pr + D); qraw[j] = *(const unsigned*)pr; } \
                _Pragma("unroll") for (int i = 0; i < 2; ++i) { const int c = tid + 512 * i, row = c >> 4, c16 = c & 15; vraw[i] = *(const v4u*)(PROJC + (size_t)(m0_ + row) * NC + 2 * D + h * HK + 8 * c16); } } while (0)
#define HG_GLOAD(CH) do { const int m0_ = b * SEQ + (CH) * 64; \
                _Pragma("unroll") for (int tt = 0; tt < 8; ++tt) graw[tt] = *(const unsigned*)(PROJC + (size_t)(m0_ + wave * 8 + tt) * NC + 3 * D + h * HK + 2 * lane); } while (0)
            HG_PRELOAD(0);
            for (int ch = 0; ch < SEQ / 64; ++ch) { const int m0 = b * SEQ + ch * 64;
                float bl0[8], bl1[8], k0[8], k1[8], q0[8], q1[8]; float run0 = 1.f, run1 = 1.f;
#pragma unroll
                for (int j = 0; j < 8; ++j) { const float f0 = lbv0 + (1.f - lbv0) * sigm_fast(bflo(fraw[j])), f1 = lbv1 + (1.f - lbv1) * sigm_fast(bfhi(fraw[j]));
                    run0 *= f0; run1 *= f1; bl0[j] = run0; bl1[j] = run1; k0[j] = 1.f - f0; k1[j] = 1.f - f1; q0[j] = bflo(qraw[j]); q1[j] = bfhi(qraw[j]); }
                *(LAS f32x2_t*)(GT + grp * 128 + 2 * dp) = (f32x2_t){run0, run1};
#pragma unroll
                for (int i = 0; i < 2; ++i) { const int c = tid + 512 * i, row = c >> 4, c16 = c & 15; *(LAS v4u*)(VT + row * PV + c16 * 16) = vraw[i]; }
                HG_BAR();
                { float off0 = 1.f, off1 = 1.f, tot0 = 1.f, tot1 = 1.f;
#pragma unroll
                  for (int g2 = 0; g2 < 8; ++g2) { const f32x2_t v = *(const LAS f32x2_t*)(GT + g2 * 128 + 2 * dp); tot0 *= v.x; tot1 *= v.y; if (g2 < grp) { off0 *= v.x; off1 *= v.y; } }
                  const float et0 = tot0, et1 = tot1;
#pragma unroll
                  for (int j = 0; j < 8; ++j) { const int t = 8 * grp + j;
                      const float e0 = off0 * bl0[j], e1 = off1 * bl1[j]; const float kt0 = k0[j] * __builtin_amdgcn_rcpf(e0), kt1 = k1[j] * __builtin_amdgcn_rcpf(e1);
                      *(LAS unsigned*)(QT + t * PQ + dp * 4) = cvtpk_s(q0[j] * e0, q1[j] * e1);
                      *(LAS unsigned*)(KT + t * PQ + dp * 4) = cvtpk_s(kt0, kt1);
                      *(LAS unsigned*)(KH + t * PV + dp * 4) = cvtpk_s(kt0 * et0, kt1 * et1); }
                  if (grp == 0) *(LAS f32x2_t*)(EBL + 2 * dp) = (f32x2_t){et0, et1}; }
                HG_GLOAD(ch); if (ch + 1 < SEQ / 64) HG_PRELOAD(ch + 1);
                HG_BAR();
                {
                    f32x16 o, sc;
#pragma unroll
                    for (int r = 0; r < 16; ++r) { o[r] = 0.f; sc[r] = 0.f; }
                    asm volatile("" : "+v"(o), "+v"(sc));
                    bf16x8v qb[8];
#pragma unroll
                    for (int ks = 0; ks < 8; ++ks) qb[ks] = *(const LAS bf16x8v*)(QT + (32 * tb + r32) * PQ + (16 * ks + 8 * h5) * 2);
#pragma unroll
                    for (int ks = 0; ks < 8; ++ks) { const int db = ks >> 1, k2 = ks & 1;
                        v4u bw; bw.x = cvtpk_s(S[db][8 * k2], S[db][8 * k2 + 1]); bw.y = cvtpk_s(S[db][8 * k2 + 2], S[db][8 * k2 + 3]); bw.z = cvtpk_s(S[db][8 * k2 + 4], S[db][8 * k2 + 5]); bw.w = cvtpk_s(S[db][8 * k2 + 6], S[db][8 * k2 + 7]);
                        const LAS unsigned char* qa = QT + (32 * tb + r32) * PQ + (32 * db + 16 * k2 + 4 * h5) * 2;
                        const v2u a0 = *(const LAS v2u*)qa, a1 = *(const LAS v2u*)(qa + 16);
                        v4u aw; aw.x = a0.x; aw.y = a0.y; aw.z = a1.x; aw.w = a1.y;
                        const bf16x8v ka = *(const LAS bf16x8v*)(KT + r32 * PQ + (16 * ks + 8 * h5) * 2);
                        o = __builtin_amdgcn_mfma_f32_32x32x16_bf16(__builtin_bit_cast(bf16x8v, aw), __builtin_bit_cast(bf16x8v, bw), o, 0, 0, 0);
                        sc = __builtin_amdgcn_mfma_f32_32x32x16_bf16(ka, qb[ks], sc, 0, 0, 0); }
                    for (int sb = 0; sb <= tb; ++sb) {
                        if (sb == 1) {
#pragma unroll
                            for (int r = 0; r < 16; ++r) sc[r] = 0.f;
                            asm volatile("" : "+v"(sc));
#pragma unroll
                            for (int ks = 0; ks < 8; ++ks) { const bf16x8v ka = *(const LAS bf16x8v*)(KT + (32 + r32) * PQ + (16 * ks + 8 * h5) * 2);
                                sc = __builtin_amdgcn_mfma_f32_32x32x16_bf16(ka, qb[ks], sc, 0, 0, 0); } }
                        if (sb == tb) {
#pragma unroll
                            for (int r = 0; r < 16; ++r) { const int sl = (r & 3) + 8 * (r >> 2) + 4 * h5; if (sl > r32) sc[r] = 0.f; } }
                        v4u p0, p1;
                        p0.x = cvtpk_s(sc[0], sc[1]); p0.y = cvtpk_s(sc[2], sc[3]); p0.z = cvtpk_s(sc[4], sc[5]); p0.w = cvtpk_s(sc[6], sc[7]);
                        p1.x = cvtpk_s(sc[8], sc[9]); p1.y = cvtpk_s(sc[10], sc[11]); p1.z = cvtpk_s(sc[12], sc[13]); p1.w = cvtpk_s(sc[14], sc[15]);
                        const LAS unsigned char* vb = VT + (32 * sb + 4 * h5 + trq) * PV + (32 * eb + 16 * trc + 4 * trp) * 2;
                        { const s16x4 l0 = vtr(vb), u0 = vtr(vb + 8 * PV), l1 = vtr(vb + 16 * PV), u1 = vtr(vb + 24 * PV);
                          const bf16x8v v0 = (bf16x8v){l0[0], l0[1], l0[2], l0[3], u0[0], u0[1], u0[2], u0[3]}, v1 = (bf16x8v){l1[0], l1[1], l1[2], l1[3], u1[0], u1[1], u1[2], u1[3]};
                          o = __builtin_amdgcn_mfma_f32_32x32x16_bf16(__builtin_bit_cast(bf16x8v, p0), v0, o, 0, 0, 0);
                          o = __builtin_amdgcn_mfma_f32_32x32x16_bf16(__builtin_bit_cast(bf16x8v, p1), v1, o, 0, 0, 0); }
                    }
#pragma unroll
                    for (int r = 0; r < 16; ++r) OL[(32 * tb + (r & 3) + 8 * (r >> 2) + 4 * h5) * 128 + 32 * eb + r32] = o[r];
                    const LAS unsigned char* kb_ = KH + (8 * h5 + trq) * PV + (16 * trc + 4 * trp) * 2;
                    const LAS unsigned char* vb_ = VT + (8 * h5 + trq) * PV + (32 * eb + 16 * trc + 4 * trp) * 2;
                    bf16x8v vf[4];
#pragma unroll
                    for (int ks = 0; ks < 4; ++ks) { const s16x4 l = vtr(vb_ + 16 * ks * PV), u = vtr(vb_ + (16 * ks + 4) * PV); vf[ks] = (bf16x8v){l[0], l[1], l[2], l[3], u[0], u[1], u[2], u[3]}; }
#pragma unroll
                    for (int db = 0; db < 4; ++db)
#pragma unroll
                        for (int g2 = 0; g2 < 4; ++g2) { const f32x4 e4 = *(const LAS f32x4*)(EBL + 32 * db + 8 * g2 + 4 * h5);
#pragma unroll
                            for (int c = 0; c < 4; ++c) S[db][4 * g2 + c] *= e4[c]; }
#pragma unroll
                    for (int ks = 0; ks < 4; ++ks)
#pragma unroll
                        for (int db = 0; db < 4; ++db) { const s16x4 l = vtr(kb_ + 16 * ks * PV + 64 * db), u = vtr(kb_ + (16 * ks + 4) * PV + 64 * db);
                            const bf16x8v kf_ = (bf16x8v){l[0], l[1], l[2], l[3], u[0], u[1], u[2], u[3]};
                            S[db] = __builtin_amdgcn_mfma_f32_32x32x16_bf16(kf_, vf[ks], S[db], 0, 0, 0); }
                }
                HG_BAR();
#pragma unroll
                for (int tt = 0; tt < 8; ++tt) { const int t = wave * 8 + tt; const int m = m0 + t;
                    const f32x2_t ov = *(const LAS f32x2_t*)(OL + t * 128 + 2 * lane); const float o0 = ov.x, o1 = ov.y;
                    const float rstd = __builtin_amdgcn_rsqf(wave_sum(o0 * o0 + o1 * o1) * (1.f / 128.f) + EPS);
                    const float g0 = bflo(graw[tt]), g1 = bfhi(graw[tt]);
                    *(unsigned*)(XN + (size_t)m * D + h * HK + 2 * lane) = cvtpk_s(o0 * rstd * gn0 * g0 * sigm_fast(g0), o1 * rstd * gn1 * g1 * sigm_fast(g1)); }
            }
#undef HG_PRELOAD
#undef HG_GLOAD
            __syncthreads();
        }
        __syncthreads();
        if (BOTH(9)) GRID_BAR();
    }
    if (IN(10)) { const int lane = lane_id(), tid = wave * 64 + lane; (void)tid; (void)lane;
        pg8::Gemm g{XN, WoutC_t, M, D, D}; pg8::StaticOrder S; S.init(M, D, G, bx);
        pg8::EpiResidualB<false> E{X, X};
        pg8::gemm_phase<pg8::EpiResidualB<false>, pg8::StaticOrder, true, false>(L + RING_OFF, g, S, E, nullptr, wave);
        if (BOTH(10)) GRID_BAR();
    }
    if (IN(11)) { const int lane = lane_id(), tid = wave * 64 + lane; (void)tid; (void)lane;
        LAS int* const cnt = (LAS int*)(L);
        float rw[4][4][8]; f32x4 gn[4];
#pragma unroll
        for (int j = 0; j < 4; ++j) { gn[j] = *(const f32x4*)(norm_ffn + D + 4 * lane + 256 * j);
#pragma unroll
            for (int c = 0; c < 4; ++c) { const int col = 4 * lane + 256 * j + c;
#pragma unroll
                for (int e = 0; e < 8; ++e) rw[j][c][e] = router[(size_t)col * NEXP + e] * gn[j][c]; } }
        for (int chunk = bx; chunk < M / 256; chunk += G) {
            __syncthreads();
            if (tid < 8) cnt[tid] = 0;
            __syncthreads();
            for (int r = 0; r < 32; ++r) { const int m = chunk * 256 + wave * 32 + r;
                f32x4 v[4]; float ss = 0.f; float lg[8];
#pragma unroll
                for (int e = 0; e < 8; ++e) lg[e] = 0.f;
#pragma unroll
                for (int j = 0; j < 4; ++j) { v[j] = XROW4(m, j); ss += (v[j].x * v[j].x + v[j].y * v[j].y) + (v[j].z * v[j].z + v[j].w * v[j].w);
#pragma unroll
                    for (int c = 0; c < 4; ++c)
#pragma unroll
                        for (int e = 0; e < 8; ++e) lg[e] += v[j][c] * rw[j][c][e]; }
                const float rstd = 1.f / sqrtf(wave_sum(ss) * (1.f / D) + EPS);
#pragma unroll
                for (int e = 0; e < 8; ++e) lg[e] = wave_sum(lg[e]) * rstd;
                NORM_Q_ROW(v, rstd, gn, m);
                if (lane == 0) {
                    int e0 = 0; float v0 = lg[0];
#pragma unroll
                    for (int e = 1; e < 8; ++e) if (lg[e] > v0) { v0 = lg[e]; e0 = e; }
                    int e1 = -1; float v1 = -INFINITY;
#pragma unroll
                    for (int e = 0; e < 8; ++e) if (e != e0 && lg[e] > v1) { v1 = lg[e]; e1 = e; }
                    const float g1 = 1.f / (1.f + __expf(v0 - v1)), g0 = 1.f - g1;
                    const int r0 = atomicAdd((int*)(cnt + e0), 1), r1 = atomicAdd((int*)(cnt + e1), 1);
                    TOPI[m] = e0 | (e1 << 8); TOPG[2 * m] = g0; TOPG[2 * m + 1] = g1; RANK[2 * m] = r0; RANK[2 * m + 1] = r1;
                }
            }
            __syncthreads();
            if (tid < 8) CNT[chunk * 8 + tid] = cnt[tid];
        }
        __syncthreads();
        if (BOTH(11)) GRID_BAR();
    }
    if (IN(12)) { const int lane = lane_id(), tid = wave * 64 + lane; (void)tid; (void)lane;
        LAS int* const lc = (LAS int*)(L);
        LAS int* const tot = lc + 2048;
        LAS int* const base = tot + 8;
        LAS int* const off = base + 16;
        __syncthreads();
        for (int i = tid; i < 2048; i += NTHR) lc[i] = CNT[i];
        __syncthreads();
        if (tid < 8) { int s = 0; for (int c = 0; c < 256; ++c) s += lc[c * 8 + tid]; tot[tid] = s; }
        __syncthreads();
        if (tid == 0) { int b = 0; for (int e = 0; e < 8; ++e) { base[e] = b; b += (tot[e] + 255) & ~255; } base[8] = b; }
        __syncthreads();
        for (int chunk = bx; chunk < M / 256; chunk += G) {
            __syncthreads();
            if (tid < 8) { int s = base[tid]; for (int c = 0; c < chunk; ++c) s += lc[c * 8 + tid]; off[tid] = s; }
            __syncthreads();
            { const int m = chunk * 256 + (tid >> 1), slot = tid & 1; const int ti = TOPI[m]; const int e = slot ? (ti >> 8) : (ti & 0xff);
              const int pos = off[e] + RANK[2 * m + slot]; ROWMAP[pos] = m; POS[2 * m + slot] = pos; SAS[pos] = SA[m]; }
        }
        if (bx == 0) {
            for (int e = 0; e < 8; ++e) for (int p = base[e] + tot[e] + tid; p < base[e + 1]; p += NTHR) { ROWMAP[p] = 0; SAS[p] = 0.f; }
            if (tid == 0) META[0] = base[8] >> 8;
            for (int p = tid; p < NPMAX; p += NTHR) { int e = 0; for (int k = 1; k < 8; ++k) if (p * 256 >= base[k]) e = k; META[64 + p] = e; }
        }
        __syncthreads();
        if (BOTH(12)) GRID_BAR();
    }
    for (int c = 0; c < NMCH; ++c) {
        if (IN(13 + 2 * c)) { const int lane = lane_id(), tid = wave * 64 + lane; (void)tid; (void)lane;
            const int ptot = __builtin_amdgcn_readfirstlane(META[0]); const int p_lo = c * PCHUNK; int p_n = ptot - p_lo; p_n = p_n < 0 ? 0 : (p_n > PCHUNK ? PCHUNK : p_n);
            int p_tail = (c == NMCH - 1) ? ptot - p_lo - p_n : 0; p_tail = p_tail < 0 ? 0 : p_tail;
            pg8::Gemm g{(const bf16*)XQ, (const bf16*)WguMQ, M, NGUE, D}; pg8::MoeOrder S{p_lo, p_n, p_tail, NGUE / 256, G, bx, 0, META + 64}; S.init();
            pg8::EpiSwiGLUI8F8 E{HIDM, DFFE, p_lo, SAS, SBM};
            pg8::gemm_phase<pg8::EpiSwiGLUI8F8, pg8::MoeOrder, true, true, 1>(L + RING_OFF, g, S, E, ROWMAP, wave);
            if (BOTH(13 + 2 * c)) GRID_BAR();
        }
        if (IN(14 + 2 * c)) { const int lane = lane_id(), tid = wave * 64 + lane; (void)tid; (void)lane;
            const int ptot = __builtin_amdgcn_readfirstlane(META[0]); const int p_lo = c * PCHUNK; int p_n = ptot - p_lo; p_n = p_n < 0 ? 0 : (p_n > PCHUNK ? PCHUNK : p_n);
            int p_tail = (c == NMCH - 1) ? ptot - p_lo - p_n : 0; p_tail = p_tail < 0 ? 0 : p_tail;
            pg8::Gemm g{HIDM, WdownM_t, (PCHUNK + 8) * 256, D, DFFE}; pg8::MoeOrder S{p_lo, p_n, p_tail, D / 256, G, bx, 1, META + 64}; S.init();
            pg8::EpiBf16RowsF8 E{YB, D, p_lo * 256, (const unsigned*)(ctl + CW_WMAX)};
            pg8::gemm_phase<pg8::EpiBf16RowsF8, pg8::MoeOrder, true, false, 2>(L + RING_OFF, g, S, E, nullptr, wave);
            if (BOTH(14 + 2 * c)) GRID_BAR();
        }
    }
    if (IN(13 + 2 * NMCH)) { const int lane = lane_id(), tid = wave * 64 + lane; (void)tid; (void)lane;
        f32x4 gn[4];
#pragma unroll
        for (int j = 0; j < 4; ++j) gn[j] = *(const f32x4*)(norm_final + 4 * lane + 256 * j);
        int pn0 = POS[2 * gw], pn1 = POS[2 * gw + 1]; float gq0 = TOPG[2 * gw], gq1 = TOPG[2 * gw + 1];
        for (int m = gw; m < M; m += NGW) {
            const int p0 = pn0, p1 = pn1; const float g0 = gq0, g1 = gq1;
            const GAS v2u* y0 = (const GAS v2u*)(YB + (size_t)p0 * D) + lane; const GAS v2u* y1 = (const GAS v2u*)(YB + (size_t)p1 * D) + lane;
            f32x4 v[4]; v2u ya[4], yb[4]; float ss = 0.f;
#pragma unroll
            for (int j = 0; j < 4; ++j) { v[j] = XROW4(m, j); ya[j] = __builtin_nontemporal_load(y0 + 64 * j); yb[j] = __builtin_nontemporal_load(y1 + 64 * j); }
            { const int mn = (m + NGW < M) ? m + NGW : m; pn0 = POS[2 * mn]; pn1 = POS[2 * mn + 1]; gq0 = TOPG[2 * mn]; gq1 = TOPG[2 * mn + 1]; }
#pragma unroll
            for (int j = 0; j < 4; ++j) { const v2u a = ya[j], bq = yb[j];
                v[j].x += g0 * bflo(a.x) + g1 * bflo(bq.x); v[j].y += g0 * bfhi(a.x) + g1 * bfhi(bq.x); v[j].z += g0 * bflo(a.y) + g1 * bflo(bq.y); v[j].w += g0 * bfhi(a.y) + g1 * bfhi(bq.y);
                ss += (v[j].x * v[j].x + v[j].y * v[j].y) + (v[j].z * v[j].z + v[j].w * v[j].w); }
            const float rstd = 1.f / sqrtf(wave_sum(ss) * (1.f / D) + EPS);
            GAS f32x4* orow = (GAS f32x4*)(OUTF + (size_t)m * D) + lane;
#pragma unroll
            for (int j = 0; j < 4; ++j) __builtin_nontemporal_store(v[j] * rstd * gn[j], orow + 64 * j);
        }
    }
#undef IN
#undef BOTH
}

extern "C" void kernel_launch(void* const* d_in, const int* in_sizes, int n_in, void* d_out, int out_size, void* d_ws, size_t ws_size, hipStream_t stream) {
    static int grid = 0;
    if (grid == 0) {
        if (n_in != 19 || in_sizes[0] != M * D || out_size != M * D || ws_size < WS_END) { fprintf(stderr, "kernel_launch: unexpected shapes (n_in %d, in0 %d, out %d, ws %zu)\n", n_in, n_in > 0 ? in_sizes[0] : -1, out_size, ws_size); grid = -1; return; }
        int dev = 0, cus = 0, per_cu = 0;
        if (hipGetDevice(&dev) != hipSuccess || hipDeviceGetAttribute(&cus, hipDeviceAttributeMultiprocessorCount, dev) != hipSuccess) { grid = -1; return; }
        if (hipFuncSetAttribute((const void*)fwd_kernel, hipFuncAttributeMaxDynamicSharedMemorySize, LDS_BYTES) != hipSuccess) { fprintf(stderr, "kernel_launch: hipFuncSetAttribute failed\n"); grid = -1; return; }
        if (hipOccupancyMaxActiveBlocksPerMultiprocessor(&per_cu, (const void*)fwd_kernel, NTHR, LDS_BYTES) != hipSuccess || per_cu < 1) fprintf(stderr, "kernel_launch: occupancy query reports %d\n", per_cu);
        (void)hipGetLastError();
        grid = cus;
    }
    if (grid < 0) return;
    if (hipMemsetAsync((char*)d_ws + WS_CTL, 0, CTL_ZERO_BYTES, stream) != hipSuccess) return;
    Args a{};
    for (int i = 0; i < 19; ++i) a.in[i] = (const float*)d_in[i];
    a.out = (float*)d_out; a.ws = (unsigned char*)d_ws;
#if PER_PHASE_LAUNCH
    for (int p = 0; p < NPHASE; ++p) { a.ph_lo = p; a.ph_hi = p + 1; hipLaunchKernelGGL(fwd_kernel, dim3(grid), dim3(NTHR), LDS_BYTES, stream, a); }
#else
    a.ph_lo = 0; a.ph_hi = NPHASE; hipLaunchKernelGGL(fwd_kernel, dim3(grid), dim3(NTHR), LDS_BYTES, stream, a);
#endif
}
```

```cpp
#include <hip/hip_runtime.h>
#include <cstdio>
#include <cstdint>

#ifndef DIL_MFMA
#define DIL_MFMA 1
#endif
#ifndef FOX_MFMA
#define FOX_MFMA 1
#endif
#ifndef PER_PHASE_LAUNCH
#define PER_PHASE_LAUNCH 0
#endif

namespace pg8 {
#define PG8_LAS __attribute__((address_space(3)))
typedef unsigned short bf16_t;
typedef short bf16x8 __attribute__((ext_vector_type(8)));
typedef float f32x4 __attribute__((ext_vector_type(4)));
typedef unsigned u32x4 __attribute__((ext_vector_type(4)));
typedef int i32x4 __attribute__((ext_vector_type(4)));
typedef int i32x8 __attribute__((ext_vector_type(8)));
template <int MODE> struct AccSel { typedef f32x4 T; };
template <> struct AccSel<1> { typedef i32x4 T; };
constexpr int BM = 256, BK = 64, HALF = 128, HTB = HALF * BK * 2  , STAGE_BYTES = 8 * HTB, NXCD = 8, WGM = 8;

__host__ __device__ __forceinline__ int lds_byte(int r, int c) { const int st = (r >> 4) * 2 + (c >> 5), rr = r & 15, cc = c & 31, ob = rr * 64 + cc * 2; return st * 1024 + (ob ^ (((ob >> 9) & 1) << 5)); }
__host__ __device__ __forceinline__ void stage_rc(int b, int& R, int& C) { const int st = b / 1024, sb = b % 1024, swz = sb ^ (((sb >> 9) & 1) << 5); R = (st >> 1) * 16 + swz / 64; C = (st & 1) * 32 + (swz % 64) / 2; }
__host__ __device__ __forceinline__ int perm32(int rho) { const int n = rho >> 4, i = rho & 15; return 8 * (i >> 2) + 4 * n + (i & 3); }

struct Unit { int pm, pn, aux; };
struct Gemm { const bf16_t* A; const bf16_t* Bt; int M, N, K; };

struct StaticOrder {
    int nM, nN, nwg, G, c;
    __host__ __device__ void init(int M, int N, int G_, int c_) { nM = M / BM; nN = N / BM; nwg = nM * nN; G = G_; c = c_; }
    __host__ __device__ bool next(int i, Unit& u) const {
        const long L = (long)i * G + c; if (L >= nwg) return false;
        int wgid = (int)L; { const int q = nwg / NXCD, r = nwg % NXCD, xcd = wgid % NXCD, off = wgid / NXCD; wgid = (xcd < r ? xcd * (q + 1) : r * (q + 1) + (xcd - r) * q) + off; }
        const int nig = WGM * nN, gid = wgid / nig, fm = gid * WGM, gsz = (nM - fm) < WGM ? (nM - fm) : WGM;
        u.pm = fm + ((wgid % nig) % gsz); u.pn = (wgid % nig) / gsz; u.aux = u.pn; return true;
    }
};
struct MoeOrder {
    int p_lo, p_n, p_tail, nN, G, c, a_local; const int* pexp;
    unsigned nreg, R, ntail; int uni, fast, cm, cd, gd, e_fast; int xd, xpl, xpn, e_x0, e_x1;
    __device__ __forceinline__ void init() {
#define PG8_U(x) ((unsigned)__builtin_amdgcn_readfirstlane((int)(x)))
        nreg = (unsigned)p_n * (unsigned)nN; ntail = (unsigned)p_tail * (unsigned)nN; const unsigned qr = PG8_U(nreg / (unsigned)G), rr = PG8_U(nreg % (unsigned)G); R = qr + (rr != 0u);
        uni = (p_tail > 0 && rr != 0u); fast = (p_n > 0) && (PG8_U((unsigned)G % (unsigned)(p_n > 0 ? p_n : 1)) == 0u);
        cm = fast ? (int)PG8_U((unsigned)c % (unsigned)p_n) : 0; cd = fast ? (int)PG8_U((unsigned)c / (unsigned)p_n) : 0; gd = fast ? (int)PG8_U((unsigned)G / (unsigned)p_n) : 0;
        xd = (!uni && G == 256 && p_n == 128 && nN == 4 && a_local == 1);
        xpl = 8 * (c & 7) + (c >> 5); xpn = (c >> 3) & 3;
        e_x0 = xd ? __builtin_amdgcn_readfirstlane(pexp[p_lo + xpl]) : 0; e_x1 = xd ? __builtin_amdgcn_readfirstlane(pexp[p_lo + xpl + 64]) : 0;
        e_fast = fast ? __builtin_amdgcn_readfirstlane(pexp[p_lo + cm]) : 0;
    }
    __device__ __forceinline__ bool next(int i, Unit& u) const {
        int pl, pn; bool known = false; int ek = 0;
        if (xd && i < 2) { pl = xpl + 64 * i; pn = xpn; known = true; ek = i ? e_x1 : e_x0; }
        else if (uni) { const unsigned P = (unsigned)(p_n + p_tail); const unsigned L = (unsigned)i * (unsigned)G + (unsigned)c; if (L >= P * (unsigned)nN) return false; pl = (int)PG8_U(L % P); pn = (int)PG8_U(L / P); }
        else if ((unsigned)i < R) { const unsigned L = (unsigned)i * (unsigned)G + (unsigned)c; if (L >= nreg) return false;
            if (fast) { pl = cm; pn = i * gd + cd; known = true; ek = e_fast; } else { pl = (int)PG8_U(L % (unsigned)p_n); pn = (int)PG8_U(L / (unsigned)p_n); } }
        else { const unsigned L = ((unsigned)i - R) * (unsigned)G + (unsigned)c; if (L >= ntail) return false; pl = p_n + (int)PG8_U(L % (unsigned)p_tail); pn = (int)PG8_U(L / (unsigned)p_tail); }
        const int panel = p_lo + pl;
        int e; if (known) e = ek; else e = __builtin_amdgcn_readfirstlane(pexp[panel]);
        u.pm = __builtin_amdgcn_readfirstlane(a_local ? pl : panel); u.pn = __builtin_amdgcn_readfirstlane(e * nN + pn); u.aux = __builtin_amdgcn_readfirstlane(pn); return true;
    }
};

__device__ __forceinline__ unsigned cvt_pk_bf16(float lo, float hi) { unsigned r; asm volatile("v_cvt_pk_bf16_f32 %0, %1, %2" : "=v"(r) : "v"(lo), "v"(hi)); return r; }


struct EpiBf16S {
    static constexpr bool PERM = true, AFTER_DRAIN = false;
    bf16_t* O; int ldc; int nsc; float sc; const float* sa; const float* sb;
    static constexpr bool LDS_SCALES = true;
    __device__ __forceinline__ const float* row_scales(const Unit& u) const { return sa + (size_t)u.pm * BM; }
    __device__ __forceinline__ const float* col_scales(const Unit& u) const { return sb + (size_t)u.pn * BM; }
    __device__ __forceinline__ void operator()(const i32x4 (&acc)[2][2][4][2], const Unit& u, int wr, int wc, int fr, int fq, const PG8_LAS float* scl) const {
        const int row0 = u.pm * BM + wr * 64 + fr; const int col0 = u.aux * BM + wc * 32 + 8 * fq; const float s = (u.aux < nsc) ? sc : 1.f;
        float srv[2][4];
#pragma unroll
        for (int ai = 0; ai < 2; ++ai)
#pragma unroll
            for (int m = 0; m < 4; ++m) srv[ai][m] = scl[wr * 64 + fr + ai * HALF + m * 16];
#pragma unroll
        for (int bj = 0; bj < 2; ++bj) { const f32x4 sb0 = *(const PG8_LAS f32x4*)(scl + 256 + wc * 32 + 8 * fq + bj * HALF) * s, sb1 = *(const PG8_LAS f32x4*)(scl + 256 + wc * 32 + 8 * fq + bj * HALF + 4) * s;
#pragma unroll
            for (int ai = 0; ai < 2; ++ai)
#pragma unroll
                for (int m = 0; m < 4; ++m) { const int row = row0 + ai * HALF + m * 16; const float sr = srv[ai][m];
                    const f32x4 v0 = __builtin_convertvector(acc[ai][bj][m][0], f32x4) * sb0 * sr, v1 = __builtin_convertvector(acc[ai][bj][m][1], f32x4) * sb1 * sr;
                    u32x4 w; w.x = cvt_pk_bf16(v0[0], v0[1]); w.y = cvt_pk_bf16(v0[2], v0[3]); w.z = cvt_pk_bf16(v1[0], v1[1]); w.w = cvt_pk_bf16(v1[2], v1[3]);
                    *(u32x4*)(O + (size_t)row * ldc + col0 + bj * HALF) = w; } }
    }
};
__device__ __forceinline__ float xor16(float v, int fq) { auto r = __builtin_amdgcn_permlane16_swap(__builtin_bit_cast(unsigned, v), __builtin_bit_cast(unsigned, v), false, false); return __builtin_bit_cast(float, (fq & 1) ? r[0] : r[1]); }
struct EpiProjAB {
    static constexpr bool PERM = true, AFTER_DRAIN = false;
    bf16_t* O; int ldc; const float* rope; float qscale; const float* sa; const float* sb;
    static constexpr bool LDS_SCALES = true;
    __device__ __forceinline__ const float* row_scales(const Unit& u) const { return sa + (size_t)u.pm * BM; }
    __device__ __forceinline__ const float* col_scales(const Unit& u) const { return sb + (size_t)u.pn * BM; }
    __device__ __forceinline__ void operator()(const i32x4 (&acc)[2][2][4][2], const Unit& u, int wr, int wc, int fr, int fq, const PG8_LAS float* scl) const {
        const int row0 = u.pm * BM + wr * 64 + fr; const int col0 = u.aux * BM + wc * 32 + 8 * fq;
        const int tt = u.aux >> 1; const bool do_rope = tt < 2; const float s = (tt == 0 || tt == 3) ? qscale : 1.f;
        const bool rl = ((wc & 1) == 0) && (fq < 2);
        float srv[2][4];
#pragma unroll
        for (int ai = 0; ai < 2; ++ai)
#pragma unroll
            for (int m = 0; m < 4; ++m) srv[ai][m] = scl[wr * 64 + fr + ai * HALF + m * 16];
        f32x4 sbv[2][2];
#pragma unroll
        for (int bj = 0; bj < 2; ++bj) { sbv[bj][0] = *(const PG8_LAS f32x4*)(scl + 256 + wc * 32 + 8 * fq + bj * HALF) * s; sbv[bj][1] = *(const PG8_LAS f32x4*)(scl + 256 + wc * 32 + 8 * fq + bj * HALF + 4) * s; }
        if (!do_rope) {
#pragma unroll
            for (int bj = 0; bj < 2; ++bj)
#pragma unroll
                for (int ai = 0; ai < 2; ++ai)
#pragma unroll
                    for (int m = 0; m < 4; ++m) { const int row = row0 + ai * HALF + m * 16; const float sr = srv[ai][m];
                        const f32x4 v0 = __builtin_convertvector(acc[ai][bj][m][0], f32x4) * sbv[bj][0] * sr, v1 = __builtin_convertvector(acc[ai][bj][m][1], f32x4) * sbv[bj][1] * sr;
                        u32x4 w; w.x = cvt_pk_bf16(v0[0], v0[1]); w.y = cvt_pk_bf16(v0[2], v0[3]); w.z = cvt_pk_bf16(v1[0], v1[1]); w.w = cvt_pk_bf16(v1[2], v1[3]);
                        *(u32x4*)(O + (size_t)row * ldc + col0 + bj * HALF) = w; }
        } else {
            const float sg = (fq == 0) ? -1.f : 1.f;
            f32x4 rc[4];
            { const f32x4* rp = (const f32x4*)(rope + (size_t)row0 * 16); rc[0] = rp[0]; rc[1] = rp[1]; rc[2] = rp[2]; rc[3] = rp[3]; }
#pragma unroll
            for (int idx = 0; idx < 8; ++idx) { const int ai = idx >> 2, m = idx & 3; const int row = row0 + ai * HALF + m * 16; const float sr = srv[ai][m];
                f32x4 rn[4];
                if (idx + 1 < 8) { const int rown = row0 + ((idx + 1) >> 2) * HALF + ((idx + 1) & 3) * 16; const f32x4* rp = (const f32x4*)(rope + (size_t)rown * 16); rn[0] = rp[0]; rn[1] = rp[1]; rn[2] = rp[2]; rn[3] = rp[3]; }
                const f32x4 s0 = rc[2] * sg, s1 = rc[3] * sg;
#pragma unroll
                for (int bj = 0; bj < 2; ++bj) {
                    f32x4 v0 = __builtin_convertvector(acc[ai][bj][m][0], f32x4) * sbv[bj][0] * sr, v1 = __builtin_convertvector(acc[ai][bj][m][1], f32x4) * sbv[bj][1] * sr;
                    f32x4 p0, p1;
#pragma unroll
                    for (int c = 0; c < 4; ++c) { p0[c] = xor16(v0[c], fq); p1[c] = xor16(v1[c], fq); }
                    const f32x4 r0 = v0 * rc[0] + p0 * s0, r1 = v1 * rc[1] + p1 * s1;
#pragma unroll
                    for (int c = 0; c < 4; ++c) { v0[c] = rl ? r0[c] : v0[c]; v1[c] = rl ? r1[c] : v1[c]; }
                    u32x4 w; w.x = cvt_pk_bf16(v0[0], v0[1]); w.y = cvt_pk_bf16(v0[2], v0[3]); w.z = cvt_pk_bf16(v1[0], v1[1]); w.w = cvt_pk_bf16(v1[2], v1[3]);
                    *(u32x4*)(O + (size_t)row * ldc + col0 + bj * HALF) = w; }
                if (idx + 1 < 8) { rc[0] = rn[0]; rc[1] = rn[1]; rc[2] = rn[2]; rc[3] = rn[3]; } }
        }
    }
};
struct EpiSwiGLU {
    static constexpr bool PERM = true, AFTER_DRAIN = false;
    bf16_t* O; int ldc;
    __device__ __forceinline__ void operator()(const f32x4 (&acc)[2][2][4][2], const Unit& u, int wr, int wc, int fr, int fq) const {
        const int row0 = u.pm * BM + wr * 64 + fr; const int col0 = u.aux * HALF + wc * 32 + 8 * fq;
#pragma unroll
        for (int ai = 0; ai < 2; ++ai)
#pragma unroll
            for (int m = 0; m < 4; ++m) { bf16_t* rowp = O + (size_t)(row0 + ai * HALF + m * 16) * ldc + col0;
                float h[8];
#pragma unroll
                for (int n = 0; n < 2; ++n)
#pragma unroll
                    for (int c = 0; c < 4; ++c) { const float g = acc[ai][0][m][n][c], up = acc[ai][1][m][n][c];
                        h[4 * n + c] = g * up * __builtin_amdgcn_rcpf(1.f + __builtin_amdgcn_exp2f(-1.4426950408889634f * g)); }
                u32x4 w; w.x = cvt_pk_bf16(h[0], h[1]); w.y = cvt_pk_bf16(h[2], h[3]); w.z = cvt_pk_bf16(h[4], h[5]); w.w = cvt_pk_bf16(h[6], h[7]);
                *(u32x4*)rowp = w; }
    }
};
struct EpiSwiGLURows {
    static constexpr bool PERM = true, AFTER_DRAIN = false;
    bf16_t* O; int ldc; int p_lo;
    __device__ __forceinline__ void operator()(const f32x4 (&acc)[2][2][4][2], const Unit& u, int wr, int wc, int fr, int fq) const {
        Unit v = u; v.pm = u.pm - p_lo; EpiSwiGLU E{O, ldc}; E(acc, v, wr, wc, fr, fq); }
};
typedef float f32x2v __attribute__((ext_vector_type(2)));
__device__ __forceinline__ f32x2v pkmul(f32x2v a, f32x2v b) { f32x2v d; asm("v_pk_mul_f32 %0, %1, %2" : "=v"(d) : "v"(a), "v"(b)); return d; }
template <bool OUT_F8> struct EpiSwiGLUI8T {
    static constexpr bool PERM = true, AFTER_DRAIN = false;
    bf16_t* O; int ldc; int p_lo; const float* sa; const float* sb;
    static constexpr bool LDS_SCALES = true;
    __device__ __forceinline__ const float* row_scales(const Unit& u) const { return sa + (size_t)u.pm * BM; }
    __device__ __forceinline__ const float* col_scales(const Unit& u) const { return sb + (size_t)u.pn * BM; }
    __device__ __forceinline__ void operator()(const i32x4 (&acc)[2][2][4][2], const Unit& u, int wr, int wc, int fr, int fq, const PG8_LAS float* scl) const {
        const int rl = wr * 64 + fr; const int row0 = (u.pm - p_lo) * BM + rl; const int col0 = u.aux * HALF + wc * 32 + 8 * fq;
        const PG8_LAS float* sbp = scl + 256 + wc * 32 + 8 * fq; const PG8_LAS float* sap = scl + rl;
        f32x4 sg[2], su[2]; float sr[2][4];
#pragma unroll
        for (int n = 0; n < 2; ++n) { sg[n] = *(const PG8_LAS f32x4*)(sbp + 4 * n); su[n] = *(const PG8_LAS f32x4*)(sbp + HALF + 4 * n); }
        f32x2v sgE[2][2], cP[2][2];
#pragma unroll
        for (int n = 0; n < 2; ++n)
#pragma unroll
            for (int hh = 0; hh < 2; ++hh) { sgE[n][hh] = (f32x2v){sg[n][2 * hh], sg[n][2 * hh + 1]} * -1.4426950408889634f; cP[n][hh] = (f32x2v){sg[n][2 * hh] * su[n][2 * hh], sg[n][2 * hh + 1] * su[n][2 * hh + 1]} * (OUT_F8 ? 16.f : 1.f); }
#pragma unroll
        for (int ai = 0; ai < 2; ++ai)
#pragma unroll
            for (int m = 0; m < 4; ++m) sr[ai][m] = sap[ai * HALF + m * 16];
#pragma unroll
        for (int ai = 0; ai < 2; ++ai)
#pragma unroll
            for (int m = 0; m < 4; ++m) { const float r1 = sr[ai][m], rq = r1 * r1; const f32x2v r1p = {r1, r1}, rqp = {rq, rq}; float h[8];
#pragma unroll
                for (int n = 0; n < 2; ++n)
#pragma unroll
                    for (int hh = 0; hh < 2; ++hh) { const f32x2v ag = {(float)acc[ai][0][m][n][2 * hh], (float)acc[ai][0][m][n][2 * hh + 1]}, au = {(float)acc[ai][1][m][n][2 * hh], (float)acc[ai][1][m][n][2 * hh + 1]};
                        const f32x2v e2 = pkmul(ag, pkmul(sgE[n][hh], r1p)), num = pkmul(pkmul(ag, au), pkmul(cP[n][hh], rqp));
                        const f32x2v d2 = (f32x2v){__builtin_amdgcn_exp2f(e2.x), __builtin_amdgcn_exp2f(e2.y)} + 1.f;
                        const f32x2v hv = num * (f32x2v){__builtin_amdgcn_rcpf(d2.x), __builtin_amdgcn_rcpf(d2.y)};
                        h[4 * n + 2 * hh] = hv.x; h[4 * n + 2 * hh + 1] = hv.y; }
                if constexpr (OUT_F8) {
#pragma unroll
                    for (int c = 0; c < 8; ++c) h[c] = __builtin_amdgcn_fmed3f(h[c], -448.f, 448.f);
                    int w0 = 0, w1 = 0; w0 = __builtin_amdgcn_cvt_pk_fp8_f32(h[0], h[1], w0, false); w0 = __builtin_amdgcn_cvt_pk_fp8_f32(h[2], h[3], w0, true);
                    w1 = __builtin_amdgcn_cvt_pk_fp8_f32(h[4], h[5], w1, false); w1 = __builtin_amdgcn_cvt_pk_fp8_f32(h[6], h[7], w1, true);
                    typedef int i32x2 __attribute__((ext_vector_type(2)));
                    *(i32x2*)((unsigned char*)O + (size_t)(row0 + ai * HALF + m * 16) * ldc + col0) = (i32x2){w0, w1};
                } else {
                    u32x4 w; w.x = cvt_pk_bf16(h[0], h[1]); w.y = cvt_pk_bf16(h[2], h[3]); w.z = cvt_pk_bf16(h[4], h[5]); w.w = cvt_pk_bf16(h[6], h[7]);
                    *(u32x4*)(O + (size_t)(row0 + ai * HALF + m * 16) * ldc + col0) = w; } }
    }
};
typedef EpiSwiGLUI8T<false> EpiSwiGLUI8;
typedef EpiSwiGLUI8T<true> EpiSwiGLUI8F8;
struct EpiBf16RowsF8 {
    static constexpr bool PERM = true, AFTER_DRAIN = false;
    bf16_t* O; int ldc; int row_off; const unsigned* wmax;
    __device__ __forceinline__ void operator()(const f32x4 (&acc)[2][2][4][2], const Unit& u, int wr, int wc, int fr, int fq) const {
        const int row0 = row_off + u.pm * BM + wr * 64 + fr; const int col0 = u.aux * BM + wc * 32 + 8 * fq;
        const float sc = __uint_as_float(wmax[u.pn >> 2]) * (1.f / 4096.f);
#pragma unroll
        for (int ai = 0; ai < 2; ++ai)
#pragma unroll
            for (int m = 0; m < 4; ++m) { bf16_t* rowp = O + (size_t)(row0 + ai * HALF + m * 16) * ldc + col0;
#pragma unroll
                for (int bj = 0; bj < 2; ++bj) { const f32x4 v0 = acc[ai][bj][m][0] * sc, v1 = acc[ai][bj][m][1] * sc;
                    u32x4 w; w.x = cvt_pk_bf16(v0[0], v0[1]); w.y = cvt_pk_bf16(v0[2], v0[3]); w.z = cvt_pk_bf16(v1[0], v1[1]); w.w = cvt_pk_bf16(v1[2], v1[3]);
                    *(u32x4*)(rowp + bj * HALF) = w; } }
    }
};
struct EpiResidual {
    static constexpr bool PERM = false, AFTER_DRAIN = false;
    const float* base; float* out; int ldc;
    __device__ __forceinline__ void operator()(const f32x4 (&acc)[2][2][4][2], const Unit& u, int wr, int wc, int fr, int fq) const {
        const int row0 = u.pm * BM + wr * 64 + fr; const int col0 = u.aux * BM + wc * 32 + 4 * fq;
#pragma unroll
        for (int ai = 0; ai < 2; ++ai) {
            f32x4 bb[4][2][2];
#pragma unroll
            for (int m = 0; m < 4; ++m) { const size_t off = (size_t)(row0 + ai * HALF + m * 16) * ldc + col0;
#pragma unroll
                for (int bj = 0; bj < 2; ++bj)
#pragma unroll
                    for (int n = 0; n < 2; ++n) bb[m][bj][n] = *(const f32x4*)(base + off + bj * HALF + n * 16); }
#pragma unroll
            for (int m = 0; m < 4; ++m) { const size_t off = (size_t)(row0 + ai * HALF + m * 16) * ldc + col0;
#pragma unroll
                for (int bj = 0; bj < 2; ++bj)
#pragma unroll
                    for (int n = 0; n < 2; ++n) *(f32x4*)(out + off + bj * HALF + n * 16) = bb[m][bj][n] + acc[ai][bj][m][n]; }
        }
    }
};
template <bool BASE_F32> struct EpiResidualB {
    static constexpr bool PERM = true, AFTER_DRAIN = false;
    const void* base; bf16_t* out;
    __device__ __forceinline__ void operator()(const f32x4 (&acc)[2][2][4][2], const Unit& u, int wr, int wc, int fr, int fq) const {
        const int row0 = u.pm * BM + wr * 64 + fr; const int col0 = u.aux * BM + wc * 32 + 8 * fq;
        static_assert(!BASE_F32, "the stream is bf16 from the first phase on");
        u32x4 raw[2][4][2];
#pragma unroll
        for (int ai = 0; ai < 2; ++ai)
#pragma unroll
            for (int m = 0; m < 4; ++m) { const size_t off = (size_t)(row0 + ai * HALF + m * 16) * 1024 + col0;
#pragma unroll
                for (int bj = 0; bj < 2; ++bj) raw[ai][m][bj] = *(const u32x4*)((const bf16_t*)base + off + bj * HALF); }
#pragma unroll
        for (int ai = 0; ai < 2; ++ai)
#pragma unroll
            for (int m = 0; m < 4; ++m) { const size_t off = (size_t)(row0 + ai * HALF + m * 16) * 1024 + col0;
#pragma unroll
                for (int bj = 0; bj < 2; ++bj) { const u32x4 r = raw[ai][m][bj];
                    const f32x4 v0 = (f32x4){__uint_as_float(r.x << 16), __uint_as_float(r.x & 0xffff0000u), __uint_as_float(r.y << 16), __uint_as_float(r.y & 0xffff0000u)} + acc[ai][bj][m][0];
                    const f32x4 v1 = (f32x4){__uint_as_float(r.z << 16), __uint_as_float(r.z & 0xffff0000u), __uint_as_float(r.w << 16), __uint_as_float(r.w & 0xffff0000u)} + acc[ai][bj][m][1];
                    u32x4 w; w.x = cvt_pk_bf16(v0[0], v0[1]); w.y = cvt_pk_bf16(v0[2], v0[3]); w.z = cvt_pk_bf16(v1[0], v1[1]); w.w = cvt_pk_bf16(v1[2], v1[3]);
                    *(u32x4*)(out + off + bj * HALF) = w; } }
    }
};
struct EpiBf16Rows {
    static constexpr bool PERM = true, AFTER_DRAIN = false;
    bf16_t* O; int ldc; int row_off;
    __device__ __forceinline__ void operator()(const f32x4 (&acc)[2][2][4][2], const Unit& u, int wr, int wc, int fr, int fq) const {
        const int row0 = row_off + u.pm * BM + wr * 64 + fr; const int col0 = u.aux * BM + wc * 32 + 8 * fq;
#pragma unroll
        for (int ai = 0; ai < 2; ++ai)
#pragma unroll
            for (int m = 0; m < 4; ++m) { bf16_t* rowp = O + (size_t)(row0 + ai * HALF + m * 16) * ldc + col0;
#pragma unroll
                for (int bj = 0; bj < 2; ++bj) { const f32x4 v0 = acc[ai][bj][m][0], v1 = acc[ai][bj][m][1];
                    u32x4 w; w.x = cvt_pk_bf16(v0[0], v0[1]); w.y = cvt_pk_bf16(v0[2], v0[3]); w.z = cvt_pk_bf16(v1[0], v1[1]); w.w = cvt_pk_bf16(v1[2], v1[3]);
                    *(u32x4*)(rowp + bj * HALF) = w; } }
    }
};

template <class Epi, class Sched, bool ALIGN_EPI, bool GATHER, int MODE = 0>
__device__ __forceinline__ void gemm_phase(PG8_LAS unsigned char* lds, const Gemm g, const Sched& S, const Epi& E, const int* rowmap, int wave_) {
    int lane; asm volatile("v_mbcnt_lo_u32_b32 %0, -1, 0\n\tv_mbcnt_hi_u32_b32 %0, -1, %0" : "=v"(lane));
    const int wid = wave_, tid = wid * 64 + lane, wr = wid >> 2, wc = wid & 3, fr = lane & 15, fq = lane >> 4;
    typedef typename AccSel<MODE>::T AccT;
    const int K = MODE ? g.K / 2 : g.K, nt = K / BK;
    unsigned voffB[2]; int Rr[2], Cc[2];
#pragma unroll
    for (int i = 0; i < 2; ++i) { int R, C; stage_rc(tid * 16 + i * 8192, R, C); Rr[i] = R; Cc[i] = C; const int Rb = Epi::PERM ? ((R & ~31) + perm32(R & 31)) : R;
        voffB[i] = (unsigned)(Rb * K + C) * 2u; }
    const size_t kstep = (size_t)(BK * 2);
    const size_t hstep = (size_t)HALF * K * 2;
    const size_t tstep = 2 * hstep;
    const unsigned ldsw = (unsigned)wid * 1024u;
    const int aoff = lds_byte(wr * 64 + fr, fq * 8), boff = lds_byte(wc * 32 + fr, fq * 8);
#define PG8_SA(b, h) (((b) * 2 + (h)) * HTB)
#define PG8_SB(b, h) ((4 + (b) * 2 + (h)) * HTB)
#define PG8_STAGE(bufoff, gbase, voff) do { _Pragma("unroll") for (int _i = 0; _i < 2; ++_i) \
        __builtin_amdgcn_global_load_lds((const unsigned*)((const char*)(gbase) + (voff)[_i]), (PG8_LAS unsigned*)(lds + (bufoff) + ldsw + _i * 8192), 16, 0, 0); } while (0)
#define PG8_LD16(off) (*(const PG8_LAS i32x4*)(lds + (off)))
#define PG8_LDA(dst, b, h) do { if constexpr (MODE == 2) { _Pragma("unroll") for (int m = 0; m < 4; ++m) dst##8[m] = __builtin_shufflevector(PG8_LD16(PG8_SA(b, h) + aoff + m * 2048), PG8_LD16(PG8_SA(b, h) + aoff + m * 2048 + 1024), 0, 1, 2, 3, 4, 5, 6, 7); } \
        else { _Pragma("unroll") for (int m = 0; m < 4; ++m) _Pragma("unroll") for (int k = 0; k < 2; ++k) dst[m][k] = *(const PG8_LAS bf16x8*)(lds + PG8_SA(b, h) + aoff + m * 2048 + k * 1024); } } while (0)
#define PG8_LDB(dst, b, h) do { if constexpr (MODE == 2) { _Pragma("unroll") for (int n = 0; n < 2; ++n) dst##8[n] = __builtin_shufflevector(PG8_LD16(PG8_SB(b, h) + boff + n * 2048), PG8_LD16(PG8_SB(b, h) + boff + n * 2048 + 1024), 0, 1, 2, 3, 4, 5, 6, 7); } \
        else { _Pragma("unroll") for (int n = 0; n < 2; ++n) _Pragma("unroll") for (int k = 0; k < 2; ++k) dst[n][k] = *(const PG8_LAS bf16x8*)(lds + PG8_SB(b, h) + boff + n * 2048 + k * 1024); } } while (0)
#define PG8_MMA(ai, bj, At, Bt) do { __builtin_amdgcn_s_setprio(1); _Pragma("unroll") for (int m = 0; m < 4; ++m) _Pragma("unroll") for (int n = 0; n < 2; ++n) { \
        if constexpr (MODE == 2) { asm volatile("v_mfma_scale_f32_16x16x128_f8f6f4 %0, %1, %2, %0, %3, %3 op_sel_hi:[0,0,0]" : "+v"(acc[ai][bj][m][n]) : "v"(Bt##8[n]), "v"(At##8[m]), "v"(sc127_)); } \
        else { _Pragma("unroll") for (int k = 0; k < 2; ++k) { \
          if constexpr (MODE == 1) acc[ai][bj][m][n] = __builtin_bit_cast(AccT, __builtin_amdgcn_mfma_i32_16x16x64_i8(__builtin_bit_cast(i32x4, Bt[n][k]), __builtin_bit_cast(i32x4, At[m][k]), __builtin_bit_cast(i32x4, acc[ai][bj][m][n]), 0, 0, 0)); \
          else acc[ai][bj][m][n] = __builtin_bit_cast(AccT, __builtin_amdgcn_mfma_f32_16x16x32_bf16(Bt[n][k], At[m][k], __builtin_bit_cast(f32x4, acc[ai][bj][m][n]), 0, 0, 0)); } } } __builtin_amdgcn_s_setprio(0); } while (0)
#define PG8_WAIT_V(n) asm volatile("s_waitcnt vmcnt(" #n ")" ::: "memory")
#define PG8_WAIT_L(n) asm volatile("s_waitcnt lgkmcnt(" #n ")" ::: "memory")
#define PG8_BAR __builtin_amdgcn_s_barrier()
#define PG8_SCHED __builtin_amdgcn_sched_barrier(0)
#define PG8_LOAD_VA(dst, u) do { _Pragma("unroll") for (int _h = 0; _h < 2; ++_h) _Pragma("unroll") for (int _i = 0; _i < 2; ++_i) \
        dst[_h][_i] = GATHER ? ((unsigned)rowmap[(u).pm * BM + _h * HALF + Rr[_i]] * (unsigned)(K * 2) + (unsigned)Cc[_i] * 2u) : ((unsigned)((_h * HALF + Rr[_i]) * K + Cc[_i]) * 2u); } while (0)
    Unit cur, nxt; int ui = 0;
    if (!S.next(0, cur)) return;
    AccT acc[2][2][4][2];
#pragma unroll
    for (int a = 0; a < 2; ++a)
#pragma unroll
        for (int b = 0; b < 2; ++b)
#pragma unroll
            for (int m = 0; m < 4; ++m)
#pragma unroll
                for (int n = 0; n < 2; ++n) acc[a][b][m][n] = __builtin_bit_cast(AccT, (f32x4){0.f, 0.f, 0.f, 0.f});
    PG8_LAS float* const sclb = (PG8_LAS float*)(lds + STAGE_BYTES + 4096);
#define PG8_SCALE_DMA(U, PAR) do { if constexpr (MODE == 1) { const float* src_ = (tid < 256) ? E.row_scales(U) + tid : E.col_scales(U) + (tid - 256); \
        __builtin_amdgcn_global_load_lds((const unsigned*)src_, (PG8_LAS unsigned*)(sclb + (PAR) * 512 + wid * 64), 4, 0, 0); } } while (0)
    int sc127_ = 0x7f7f7f7f; asm volatile("" : "+v"(sc127_));
    bf16x8 At[4][2], B0[2][2], B1[2][2]; i32x8 At8[4], B08[2], B18[2];
    unsigned vAc[2][2], vAn[2][2];
    PG8_LOAD_VA(vAc, cur);
    const char* cA = GATHER ? (const char*)g.A : (const char*)g.A + (size_t)cur.pm * tstep; const char* cB = (const char*)g.Bt + (size_t)cur.pn * tstep;
    PG8_SCALE_DMA(cur, 0);
    PG8_STAGE(PG8_SB(0, 0), cB, voffB); PG8_STAGE(PG8_SB(0, 1), cB + hstep, voffB); PG8_STAGE(PG8_SA(0, 0), cA, vAc[0]); PG8_STAGE(PG8_SA(0, 1), cA, vAc[1]);
    if (wr == 1) PG8_BAR;
    PG8_WAIT_V(2); PG8_BAR;
    PG8_STAGE(PG8_SB(1, 0), cB + kstep, voffB); PG8_STAGE(PG8_SA(1, 0), cA + kstep, vAc[0]); PG8_STAGE(PG8_SB(1, 1), cB + hstep + kstep, voffB);
    PG8_WAIT_V(6); PG8_BAR;
    for (;;) {
        const bool has_next = S.next(ui + 1, nxt);
        if constexpr (GATHER) { if (has_next && nxt.pm != cur.pm) { PG8_LOAD_VA(vAn, nxt); } else {
#pragma unroll
            for (int _h = 0; _h < 2; ++_h)
#pragma unroll
                for (int _i = 0; _i < 2; ++_i) vAn[_h][_i] = vAc[_h][_i]; } }
        const char* nA = GATHER ? (const char*)g.A : (has_next ? (const char*)g.A + (size_t)nxt.pm * tstep : cA); const char* nB = has_next ? (const char*)g.Bt + (size_t)nxt.pn * tstep : cB;
        for (int t = 0; t < nt; t += 2) {
            const bool last = (t == nt - 2);
            const char* a1 = cA + (size_t)(t + 1) * kstep;
            const char* a2 = last ? nA : cA + (size_t)(t + 2) * kstep; const char* b2 = last ? nB : cB + (size_t)(t + 2) * kstep;
            const char* a3 = a2 + kstep; const char* b3 = b2 + kstep;
            unsigned o2[2][2];
#pragma unroll
            for (int _h = 0; _h < 2; ++_h)
#pragma unroll
                for (int _i = 0; _i < 2; ++_i) o2[_h][_i] = (GATHER && last) ? vAn[_h][_i] : vAc[_h][_i];
            PG8_LDB(B0, 0, 0); PG8_LDB(B1, 0, 1); PG8_SCHED; PG8_LDA(At, 0, 0); PG8_STAGE(PG8_SA(1, 1), a1, vAc[1]);
            PG8_WAIT_V(8); PG8_WAIT_L(0); PG8_BAR; PG8_MMA(0, 0, At, B0); PG8_MMA(0, 1, At, B1); PG8_BAR; PG8_SCHED;
            PG8_LDA(At, 0, 1); PG8_STAGE(PG8_SB(0, 0), b2, voffB); PG8_STAGE(PG8_SB(0, 1), b2 + hstep, voffB); PG8_STAGE(PG8_SA(0, 0), a2, o2[0]);
            PG8_WAIT_V(8); PG8_WAIT_L(0); PG8_BAR; PG8_MMA(1, 0, At, B0); PG8_MMA(1, 1, At, B1); PG8_BAR; PG8_SCHED;
            PG8_LDB(B0, 1, 0); PG8_LDB(B1, 1, 1); PG8_SCHED; PG8_LDA(At, 1, 0); PG8_STAGE(PG8_SA(0, 1), a2, o2[1]);
            PG8_WAIT_V(8); PG8_WAIT_L(0); PG8_BAR; PG8_MMA(0, 0, At, B0); PG8_MMA(0, 1, At, B1); PG8_BAR; PG8_SCHED;
            PG8_LDA(At, 1, 1); PG8_STAGE(PG8_SB(1, 0), b3, voffB); PG8_STAGE(PG8_SB(1, 1), b3 + hstep, voffB); PG8_STAGE(PG8_SA(1, 0), a3, o2[0]);
            PG8_WAIT_V(8); PG8_WAIT_L(0); PG8_BAR; PG8_MMA(1, 0, At, B0); PG8_MMA(1, 1, At, B1); PG8_BAR; PG8_SCHED;
        }
        if constexpr (ALIGN_EPI) { if (wr == 0) PG8_BAR; }
        if constexpr (MODE == 2) asm volatile("s_nop 15\n\ts_nop 15" ::: "memory");
        { Unit ue = cur; int fr_e = fr, fq_e = fq; asm volatile("" : "+s"(ue.pm), "+s"(ue.pn), "+s"(ue.aux), "+v"(fr_e), "+v"(fq_e));
          if constexpr (MODE == 1) E(acc, ue, wr, wc, fr_e, fq_e, sclb + (ui & 1) * 512); else E(acc, ue, wr, wc, fr_e, fq_e); }
        if (!has_next) break;
#pragma unroll
        for (int a = 0; a < 2; ++a)
#pragma unroll
            for (int b = 0; b < 2; ++b)
#pragma unroll
                for (int m = 0; m < 4; ++m)
#pragma unroll
                    for (int n = 0; n < 2; ++n) { typedef double f64x2 __attribute__((ext_vector_type(2))); double z0, z1;
                        asm("v_mov_b64 %0, 0" : "=v"(z0)); asm("v_mov_b64 %0, 0" : "=v"(z1)); acc[a][b][m][n] = __builtin_bit_cast(AccT, (f64x2){z0, z1}); }
        cur = nxt; cA = nA; cB = nB; ++ui;
        PG8_SCALE_DMA(cur, ui & 1);
        if constexpr (GATHER) {
#pragma unroll
        for (int _h = 0; _h < 2; ++_h)
#pragma unroll
            for (int _i = 0; _i < 2; ++_i) vAc[_h][_i] = vAn[_h][_i]; }
        if constexpr (ALIGN_EPI) { if (wr == 1) PG8_BAR; }
    }
    PG8_WAIT_V(0);
    if constexpr (!ALIGN_EPI) { if (wr == 0) PG8_BAR; }
    PG8_BAR;
#undef PG8_SA
#undef PG8_SB
#undef PG8_STAGE
#undef PG8_LDA
#undef PG8_LDB
#undef PG8_MMA
#undef PG8_WAIT_V
#undef PG8_WAIT_L
#undef PG8_BAR
#undef PG8_SCHED
#undef PG8_LOAD_VA
#undef PG8_SCALE_DMA
}
}

constexpr int NWAVES = 8, NTHR = NWAVES * 64;
constexpr int BATCH = 32, SEQ = 2048, D = 1024, M = BATCH * SEQ;
constexpr int NAB = 3072, IN_AB = 3080, HD = 64, NH = 8;
constexpr int DFF = 2816, NGU = 2 * DFF;
constexpr int NC = 4096, HK = 128;
constexpr int NEXP = 8, DFFE = 3584, NGUE = 2 * DFFE;
constexpr float EPS = 1e-6f;
constexpr float LOG2E = 1.4426950408889634f;
constexpr float QSCALE_AB = 0.125f * LOG2E;
constexpr float QSCALE_C = 0.08838834764831845f;
constexpr int PCHUNK = 128, NPMAX = 520, NMCH = 4;
constexpr int NPHASE = 13 + 2 * NMCH + 1;

constexpr size_t MiB = 1u << 20;
constexpr size_t WS_CTL = 0, CTL_ZERO_BYTES = 64 * 1024;
constexpr size_t WS_ROPE = 1 * MiB;
constexpr size_t WS_LOGF = 5 * MiB;
constexpr size_t WS_CUM = 7 * MiB;
constexpr size_t WS_TOPI = 9 * MiB;
constexpr size_t WS_TOPG = 9 * MiB + 256 * 1024;
constexpr size_t WS_RANK = 9 * MiB + 768 * 1024;
constexpr size_t WS_POS = 10 * MiB + 256 * 1024;
constexpr size_t WS_ROWMAP = 10 * MiB + 768 * 1024;
constexpr size_t WS_CNT = 11 * MiB + 512 * 1024;
constexpr size_t WS_META = 11 * MiB + 768 * 1024;
constexpr size_t WS_SA = 12 * MiB;
constexpr size_t WS_SAS = 12 * MiB + 512 * 1024;
constexpr size_t WS_SBD = 13 * MiB + 256 * 1024;
constexpr size_t WS_SBM = 13 * MiB + 512 * 1024;
constexpr size_t WS_SBAB = 13 * MiB + 768 * 1024;
constexpr size_t WS_SBC = 13 * MiB + 832 * 1024;
constexpr size_t WS_WINAB = 16 * MiB, WS_WOUTAB = 22 * MiB, WS_WGU = 24 * MiB, WS_WDOWN = 35 * MiB, WS_WINC = 41 * MiB, WS_WOUTC = 49 * MiB, WS_WGUM = 51 * MiB, WS_WDOWNM = 163 * MiB;
constexpr size_t WS_XN = 224 * MiB;
constexpr size_t WS_BIG = 352 * MiB;
constexpr size_t WS_Y = 580 * MiB;
constexpr size_t WS_END = 1024 * MiB;
static_assert(WS_WDOWNM + (size_t)NEXP * D * DFFE * 2 <= WS_XN && WS_BIG + (size_t)M * NC * 2 <= WS_END && WS_BIG + (size_t)(PCHUNK + 8) * 256 * DFFE <= WS_Y && WS_Y + (size_t)NPMAX * 256 * D * 2 <= WS_END, "ws map");
constexpr int CW_TMO = 0, CW_BAR = 4096, CW_WMAX = 8192;

constexpr int RING_OFF = 0, RING_BYTES = 131072;
constexpr int LDSCTL_OFF = RING_BYTES, MISC_OFF = LDSCTL_OFF + 320;
constexpr int LDS_BYTES = 147456;

#define GAS __attribute__((address_space(1)))
#define LAS __attribute__((address_space(3)))
typedef unsigned short bf16;
typedef unsigned v4u __attribute__((ext_vector_type(4)));
typedef unsigned v2u __attribute__((ext_vector_type(2)));
typedef float f32x4 __attribute__((ext_vector_type(4)));
typedef GAS unsigned gu32;
#define RLX_AGENT __ATOMIC_RELAXED, __HIP_MEMORY_SCOPE_AGENT
#define LDS_WAIT() asm volatile("s_waitcnt lgkmcnt(0)" ::: "memory")
#define VM_WAIT() asm volatile("s_waitcnt vmcnt(0)" ::: "memory")
__device__ __forceinline__ unsigned f2bf(float f) { unsigned u = __builtin_bit_cast(unsigned, f); return (u + 0x7fffu + ((u >> 16) & 1u)) >> 16; }
__device__ __forceinline__ unsigned pk2(float lo, float hi) { return f2bf(lo) | (f2bf(hi) << 16); }
__device__ __forceinline__ float bflo(unsigned u) { return __uint_as_float(u << 16); }
__device__ __forceinline__ float bfhi(unsigned u) { return __uint_as_float(u & 0xffff0000u); }
__device__ __forceinline__ float bf1(bf16 h) { return __uint_as_float((unsigned)h << 16); }

#define XB_TMO      128
#define XB_XCNT(j)  (256  + 64 * (j))
#define XB_XSUB(j)  (1280 + 64 * (j))
#define XB_XGEN(j)  (2304 + 64 * (j))
#define XB_TOP      3328
#define XB_TOPGEN   3392
#define XCD_BAR_WORDS 3456
#define XB_SPIN_CAP (1u << 22)
__device__ __forceinline__ unsigned xb_ld(unsigned* p)              { return __hip_atomic_load(p, __ATOMIC_RELAXED, __HIP_MEMORY_SCOPE_AGENT); }
__device__ __forceinline__ unsigned xb_add(unsigned* p, unsigned v) { return __hip_atomic_fetch_add(p, v, __ATOMIC_RELAXED, __HIP_MEMORY_SCOPE_AGENT); }
__device__ __forceinline__ unsigned xb_xcc_id() { return (unsigned)__builtin_amdgcn_s_getreg((3 << 11) | 20) & 0xFu; }
#define XB_SPIN(cond, bar) do { unsigned _sp = 0; while (cond) { __builtin_amdgcn_s_sleep(1); \
    if ((++_sp & 255u) == 0u) { if (xb_ld(&(bar)[XB_TMO])) break; if (_sp > XB_SPIN_CAP) { atomicAdd(&(bar)[XB_TMO], 1u); break; } } } } while (0)
struct XcdBarrier { unsigned* bar; unsigned x; volatile LAS unsigned* st; };
__device__ __forceinline__ XcdBarrier xcd_barrier_post(unsigned* bar, volatile LAS unsigned* st, bool t0) {
    XcdBarrier b; b.bar = bar; b.x = xb_xcc_id(); b.st = st;
    if (t0) (void)xb_add(&bar[XB_XCNT(b.x)], 1u);
    return b;
}
__device__ __forceinline__ void xcd_barrier_complete(unsigned* bar, unsigned x, unsigned& nloc, unsigned& nx) {
    const unsigned G = gridDim.x * gridDim.y * gridDim.z;
    unsigned sum, cnt, mine, sp = 0u;
    for (;;) {
        sum = 0u; cnt = 0u; mine = 0u;
#pragma unroll
        for (unsigned j = 0; j < 16; ++j) { const unsigned c = xb_ld(&bar[XB_XCNT(j)]); sum += c; cnt += (c > 0u) ? 1u : 0u; mine = (j == x) ? c : mine; }
        if (sum == G) break;
        __builtin_amdgcn_s_sleep(1);
        if ((++sp & 255u) == 0u) { if (xb_ld(&bar[XB_TMO])) break; if (sp > XB_SPIN_CAP) { atomicAdd(&bar[XB_TMO], 1u); break; } }
    }
    nloc = mine > 0u ? mine : 1u; nx = cnt > 0u ? cnt : 1u;
}
__device__ __forceinline__ void xcd_barrier(const XcdBarrier& b, bool t0) {
    asm volatile("s_waitcnt vmcnt(0)" ::: "memory");
    __syncthreads();
    if (t0) {
        unsigned* bar = b.bar;
        __builtin_amdgcn_s_waitcnt(0);
        unsigned nloc = b.st[0], nx = b.st[1];
        if (nloc == 0u) { xcd_barrier_complete(bar, b.x, nloc, nx); b.st[0] = nloc; b.st[1] = nx; }
        const unsigned old = xb_add(&bar[XB_XSUB(b.x)], 1u);
        const unsigned gen = old / nloc;
        if (old + 1u == (gen + 1u) * nloc) {
            __builtin_amdgcn_fence(__ATOMIC_RELEASE, "agent");
            asm volatile("s_waitcnt vmcnt(0)" ::: "memory");
            const unsigned og = xb_add(&bar[XB_TOP], 1u);
            const unsigned tg = og / nx;
            if (og + 1u == (tg + 1u) * nx) xb_add(&bar[XB_TOPGEN], 1u);
            else XB_SPIN(xb_ld(&bar[XB_TOPGEN]) == tg, bar);
            __builtin_amdgcn_fence(__ATOMIC_ACQUIRE, "agent");
            xb_add(&bar[XB_XGEN(b.x)], 1u);
            asm volatile("s_waitcnt vmcnt(0)" ::: "memory");
        } else {
            XB_SPIN(xb_ld(&bar[XB_XGEN(b.x)]) == gen, bar);
            __builtin_amdgcn_fence(__ATOMIC_ACQUIRE, "agent");
            asm volatile("s_waitcnt vmcnt(0)" ::: "memory");
        }
    }
    __syncthreads();
}

__device__ __forceinline__ int lane_id() { int l; asm volatile("v_mbcnt_lo_u32_b32 %0, -1, 0\n\tv_mbcnt_hi_u32_b32 %0, -1, %0" : "=v"(l)); return l; }
template <int CTRL> __device__ __forceinline__ float dpp_f(float v) { return __int_as_float(__builtin_amdgcn_update_dpp(0, __float_as_int(v), CTRL, 0xf, 0xf, true)); }
__device__ __forceinline__ float wave_sum(float v) {
    v += dpp_f<0xB1>(v); v += dpp_f<0x4E>(v); v += dpp_f<0x141>(v); v += dpp_f<0x140>(v);
    { auto r = __builtin_amdgcn_permlane16_swap(__float_as_uint(v), __float_as_uint(v), false, false); v = __uint_as_float(r[0]) + __uint_as_float(r[1]); }
    { auto r = __builtin_amdgcn_permlane32_swap(__float_as_uint(v), __float_as_uint(v), false, false); v = __uint_as_float(r[0]) + __uint_as_float(r[1]); }
    return v;
}
__device__ __forceinline__ float wave_max(float v) {
    v = fmaxf(v, dpp_f<0xB1>(v)); v = fmaxf(v, dpp_f<0x4E>(v)); v = fmaxf(v, dpp_f<0x141>(v)); v = fmaxf(v, dpp_f<0x140>(v));
    { auto r = __builtin_amdgcn_permlane16_swap(__float_as_uint(v), __float_as_uint(v), false, false); v = fmaxf(__uint_as_float(r[0]), __uint_as_float(r[1])); }
    { auto r = __builtin_amdgcn_permlane32_swap(__float_as_uint(v), __float_as_uint(v), false, false); v = fmaxf(__uint_as_float(r[0]), __uint_as_float(r[1])); }
    return v;
}
__device__ __forceinline__ float sigmoidf_(float z) { return 1.f / (1.f + __expf(-z)); }
__device__ __forceinline__ float sigm_fast(float z) { return __builtin_amdgcn_rcpf(1.f + __builtin_amdgcn_exp2f(-1.4426950408889634f * z)); }

__device__ __forceinline__ void transpose_item(const float* W, int ldw, int K, bf16* WT, int k0, int n0, int dst_row0, LAS float* scr, int lane) {
#pragma unroll 16
    for (int i = 0; i < 32; ++i) { const int kk = 2 * i + (lane >> 5); scr[kk * 33 + (lane & 31)] = W[(size_t)(k0 + kk) * ldw + n0 + (lane & 31)]; }
    LDS_WAIT(); asm volatile("" ::: "memory");
    const int c = lane & 7;
#pragma unroll
    for (int j = 0; j < 4; ++j) { const int n = (lane >> 3) + 8 * j; const LAS float* s = scr + (8 * c) * 33 + n;
        v4u o; o.x = pk2(s[0 * 33], s[1 * 33]); o.y = pk2(s[2 * 33], s[3 * 33]); o.z = pk2(s[4 * 33], s[5 * 33]); o.w = pk2(s[6 * 33], s[7 * 33]);
        *(GAS v4u*)(WT + (size_t)(dst_row0 + n) * K + k0 + 8 * c) = o; }
    LDS_WAIT(); asm volatile("" ::: "memory");
}


typedef float f32x16 __attribute__((ext_vector_type(16)));
typedef short s16x4 __attribute__((ext_vector_type(4)));
typedef short v4i16_t __attribute__((ext_vector_type(4)));
typedef short bf16x8v __attribute__((ext_vector_type(8)));
typedef float f32x2_t __attribute__((ext_vector_type(2))); typedef __bf16 bf16x2_t __attribute__((ext_vector_type(2)));
__device__ __forceinline__ unsigned cvtpk_s(float lo, float hi) { f32x2_t v = {lo, hi}; bf16x2_t b = __builtin_convertvector(v, bf16x2_t); return __builtin_bit_cast(unsigned, b); }
__device__ __forceinline__ s16x4 vtr(const LAS unsigned char* p) { return __builtin_bit_cast(s16x4, __builtin_amdgcn_ds_read_tr16_b64_v4i16((LAS v4i16_t*)p)); }
__device__ __forceinline__ float max3f(float a, float b, float c) { float r; asm("v_max3_f32 %0, %1, %2, %3" : "=v"(r) : "v"(a), "v"(b), "v"(c)); return r; }
__device__ __forceinline__ float max2f(float a, float b) { float r; asm("v_max_f32_e32 %0, %1, %2" : "=v"(r) : "v"(a), "v"(b)); return r; }
typedef float f32x16r __attribute__((ext_vector_type(16)));
__device__ __forceinline__ float rowmax16(f32x16r& s) {
    asm volatile("s_nop 15\n\ts_nop 7" : "+v"(s));
    float a = max3f(s[0], s[1], s[2]), b = max3f(s[3], s[4], s[5]);
    a = max3f(a, s[6], s[7]); b = max3f(b, s[8], s[9]); a = max3f(a, s[10], s[11]); b = max3f(b, s[12], s[13]); a = max3f(a, s[14], s[15]);
    float m = max2f(a, b);
    auto rr = __builtin_amdgcn_permlane32_swap(__float_as_uint(m), __float_as_uint(m), false, false);
    return max2f(__uint_as_float(rr[0]), __uint_as_float(rr[1]));
}
__device__ __forceinline__ float halfmax(float m) { auto rr = __builtin_amdgcn_permlane32_swap(__float_as_uint(m), __float_as_uint(m), false, false); return fmaxf(__uint_as_float(rr[0]), __uint_as_float(rr[1])); }
__device__ __forceinline__ float halfsum(float m) { auto rr = __builtin_amdgcn_permlane32_swap(__float_as_uint(m), __float_as_uint(m), false, false); return __uint_as_float(rr[0]) + __uint_as_float(rr[1]); }
struct FlashSt { float m, l; f32x16 o0, o1; };
template <bool HAS_BIAS>
__device__ __forceinline__ void flash_tiles(FlashSt& st, const bf16x8v (&qf)[4], const bf16* Kb, const bf16* Vb, int tok0, int stride, int ntiles, int tstep, int LQ, int LK0, int W,
                                            const LAS float* cumL, LAS unsigned char* vbuf, int lane) {
    const int r32 = lane & 31, hi = lane >> 5, vj = lane >> 3, vc = lane & 7;
    LAS unsigned char* const vw = vbuf + (vc >> 2) * 2048 + vj * 64 + (vc & 3) * 16;
    const LAS unsigned char* const vr = vbuf + ((lane >> 4) & 1) * 32 + (lane & 3) * 8 + (4 * hi + ((lane & 15) >> 2)) * 64;
    bf16x8v kf[4]; v4u vch[4];
#define FL_LOAD(KT, KF, VCH) do { const int t0_ = tok0 + (KT) * tstep; int tk_ = t0_ + stride * r32; tk_ = tk_ < 0 ? 0 : tk_; const bf16* kp_ = Kb + (size_t)tk_ * NAB + 8 * hi; \
        _Pragma("unroll") for (int d0 = 0; d0 < 4; ++d0) KF[d0] = *(const bf16x8v*)(kp_ + 16 * d0); \
        _Pragma("unroll") for (int i = 0; i < 4; ++i) { int tv_ = t0_ + stride * (vj + 8 * i); tv_ = tv_ < 0 ? 0 : tv_; VCH[i] = *(const v4u*)(Vb + (size_t)tv_ * NAB + 8 * vc); } } while (0)
    FL_LOAD(0, kf, vch);
    for (int kt = 0; kt < ntiles; ++kt) {
        bf16x8v kfn[4]; v4u vchn[4];
        { const int ktn = (kt + 1 < ntiles) ? kt + 1 : kt; FL_LOAD(ktn, kfn, vchn); }
#pragma unroll
        for (int i = 0; i < 4; ++i) *(LAS v4u*)(vw + i * 512) = vch[i];
        asm volatile("s_waitcnt lgkmcnt(0)" ::: "memory");
        f32x16 s; const int LKt = LK0 + 32 * kt;
        if (HAS_BIAS) { const LAS float* cp = cumL + tok0 + kt * tstep + 4 * hi;
#pragma unroll
            for (int g = 0; g < 4; ++g) { const f32x4 c4 = *(const LAS f32x4*)(cp + 8 * g);
#pragma unroll
                for (int c = 0; c < 4; ++c) s[4 * g + c] = -c4[c]; } }
        else {
#pragma unroll
            for (int r = 0; r < 16; ++r) s[r] = 0.f; }
        { const int e = LQ - LKt - 4 * hi; int lo = e - W; const int lo3 = -LKt - 4 * hi; lo = lo > lo3 ? lo : lo3;
          if (!__all(lo <= 0 && e >= 27)) {
#pragma unroll
              for (int r = 0; r < 16; ++r) { const int jr = (r & 3) + 8 * (r >> 2); if (jr < lo || jr > e) s[r] = -INFINITY; } } }
        asm volatile("" : "+v"(s));
#pragma unroll
        for (int d0 = 0; d0 < 4; ++d0) s = __builtin_amdgcn_mfma_f32_32x32x16_bf16(kf[d0], qf[d0], s, 0, 0, 0);
        const float mloc = rowmax16(s);
        const float mnew = fmaxf(st.m, mloc); const float alpha = __builtin_amdgcn_exp2f(st.m - mnew); st.m = mnew;
        float lsum = 0.f;
#pragma unroll
        for (int r = 0; r < 16; ++r) { s[r] = __builtin_amdgcn_exp2f(s[r] - mnew); lsum += s[r]; }
        st.l = st.l * alpha + lsum;
        if (__any(alpha != 1.f)) { st.o0 = st.o0 * alpha; st.o1 = st.o1 * alpha; }
        v4u pw0, pw1;
        pw0.x = cvtpk_s(s[0], s[1]); pw0.y = cvtpk_s(s[2], s[3]); pw0.z = cvtpk_s(s[4], s[5]); pw0.w = cvtpk_s(s[6], s[7]);
        pw1.x = cvtpk_s(s[8], s[9]); pw1.y = cvtpk_s(s[10], s[11]); pw1.z = cvtpk_s(s[12], s[13]); pw1.w = cvtpk_s(s[14], s[15]);
        const bf16x8v pf0 = __builtin_bit_cast(bf16x8v, pw0), pf1 = __builtin_bit_cast(bf16x8v, pw1);
#define FL_VF(D0, KS) ({ const s16x4 lo_ = vtr(vr + (D0) * 2048 + (KS) * 1024), hi_ = vtr(vr + (D0) * 2048 + (KS) * 1024 + 512); (bf16x8v){lo_[0], lo_[1], lo_[2], lo_[3], hi_[0], hi_[1], hi_[2], hi_[3]}; })
        { const bf16x8v a00 = FL_VF(0, 0), a01 = FL_VF(0, 1), a10 = FL_VF(1, 0), a11 = FL_VF(1, 1);
          st.o0 = __builtin_amdgcn_mfma_f32_32x32x16_bf16(a00, pf0, st.o0, 0, 0, 0); st.o0 = __builtin_amdgcn_mfma_f32_32x32x16_bf16(a01, pf1, st.o0, 0, 0, 0);
          st.o1 = __builtin_amdgcn_mfma_f32_32x32x16_bf16(a10, pf0, st.o1, 0, 0, 0); st.o1 = __builtin_amdgcn_mfma_f32_32x32x16_bf16(a11, pf1, st.o1, 0, 0, 0); }
#undef FL_VF
        asm volatile("s_waitcnt lgkmcnt(0)" ::: "memory");
#pragma unroll
        for (int d0 = 0; d0 < 4; ++d0) kf[d0] = kfn[d0];
#pragma unroll
        for (int i = 0; i < 4; ++i) vch[i] = vchn[i];
    }
#undef FL_LOAD
}
__device__ __forceinline__ void flash_tiles2(FlashSt (&st)[2], const bf16x8v (&qf)[2][4], const bf16* Kb, const bf16* Vb, int tok0, int stride, int ntiles, int tstep, const int (&LQ)[2], const int (&LQb)[2], int LK0, int W,
                                             LAS unsigned char* vbuf, int lane) {
    const int r32 = lane & 31, hi = lane >> 5, vj = lane >> 3, vc = lane & 7;
    LAS unsigned char* const vw = vbuf + (vc >> 2) * 2048 + vj * 64 + (vc & 3) * 16;
    const LAS unsigned char* const vr = vbuf + ((lane >> 4) & 1) * 32 + (lane & 3) * 8 + (4 * hi + ((lane & 15) >> 2)) * 64;
    bf16x8v kf[4]; v4u vch[4];
#define FL_LOAD(KT, KF, VCH) do { const int t0_ = tok0 + (KT) * tstep; int tk_ = t0_ + stride * r32; tk_ = tk_ < 0 ? 0 : tk_; const bf16* kp_ = Kb + (size_t)tk_ * NAB + 8 * hi; \
        _Pragma("unroll") for (int d0 = 0; d0 < 4; ++d0) KF[d0] = *(const bf16x8v*)(kp_ + 16 * d0); \
        _Pragma("unroll") for (int i = 0; i < 4; ++i) { int tv_ = t0_ + stride * (vj + 8 * i); tv_ = tv_ < 0 ? 0 : tv_; VCH[i] = *(const v4u*)(Vb + (size_t)tv_ * NAB + 8 * vc); } } while (0)
    FL_LOAD(0, kf, vch);
    for (int kt = 0; kt < ntiles; ++kt) {
        bf16x8v kfn[4]; v4u vchn[4];
        { const int ktn = (kt + 1 < ntiles) ? kt + 1 : kt; FL_LOAD(ktn, kfn, vchn); }
#pragma unroll
        for (int i = 0; i < 4; ++i) *(LAS v4u*)(vw + i * 512) = vch[i];
        asm volatile("s_waitcnt lgkmcnt(0)" ::: "memory");
        const int LKt = LK0 + 32 * kt;
#define FL_VF(D0, KS) ({ const s16x4 lo_ = vtr(vr + (D0) * 2048 + (KS) * 1024), hi_ = vtr(vr + (D0) * 2048 + (KS) * 1024 + 512); (bf16x8v){lo_[0], lo_[1], lo_[2], lo_[3], hi_[0], hi_[1], hi_[2], hi_[3]}; })
        const bf16x8v a00 = FL_VF(0, 0), a01 = FL_VF(0, 1), a10 = FL_VF(1, 0), a11 = FL_VF(1, 1);
#undef FL_VF
#pragma unroll
        for (int q = 0; q < 2; ++q) if (LKt <= LQb[q] + 31 && LKt + 31 >= LQb[q] - W && LKt + 31 >= 0) {
            f32x16 s;
#pragma unroll
            for (int r = 0; r < 16; ++r) s[r] = 0.f;
            { const int e = LQ[q] - LKt - 4 * hi; int lo = e - W; const int lo3 = -LKt - 4 * hi; lo = lo > lo3 ? lo : lo3;
              if (!__all(lo <= 0 && e >= 27)) {
#pragma unroll
                  for (int r = 0; r < 16; ++r) { const int jr = (r & 3) + 8 * (r >> 2); if (jr < lo || jr > e) s[r] = -INFINITY; } } }
            asm volatile("" : "+v"(s));
#pragma unroll
            for (int d0 = 0; d0 < 4; ++d0) s = __builtin_amdgcn_mfma_f32_32x32x16_bf16(kf[d0], qf[q][d0], s, 0, 0, 0);
            const float mloc = rowmax16(s);
            const float mnew = fmaxf(st[q].m, mloc); const float alpha = __builtin_amdgcn_exp2f(st[q].m - mnew); st[q].m = mnew;
            float lsum = 0.f;
#pragma unroll
            for (int r = 0; r < 16; ++r) { s[r] = __builtin_amdgcn_exp2f(s[r] - mnew); lsum += s[r]; }
            st[q].l = st[q].l * alpha + lsum;
            if (__any(alpha != 1.f)) { st[q].o0 = st[q].o0 * alpha; st[q].o1 = st[q].o1 * alpha; }
            v4u pw0, pw1;
            pw0.x = cvtpk_s(s[0], s[1]); pw0.y = cvtpk_s(s[2], s[3]); pw0.z = cvtpk_s(s[4], s[5]); pw0.w = cvtpk_s(s[6], s[7]);
            pw1.x = cvtpk_s(s[8], s[9]); pw1.y = cvtpk_s(s[10], s[11]); pw1.z = cvtpk_s(s[12], s[13]); pw1.w = cvtpk_s(s[14], s[15]);
            const bf16x8v pf0 = __builtin_bit_cast(bf16x8v, pw0), pf1 = __builtin_bit_cast(bf16x8v, pw1);
            st[q].o0 = __builtin_amdgcn_mfma_f32_32x32x16_bf16(a00, pf0, st[q].o0, 0, 0, 0); st[q].o0 = __builtin_amdgcn_mfma_f32_32x32x16_bf16(a01, pf1, st[q].o0, 0, 0, 0);
            st[q].o1 = __builtin_amdgcn_mfma_f32_32x32x16_bf16(a10, pf0, st[q].o1, 0, 0, 0); st[q].o1 = __builtin_amdgcn_mfma_f32_32x32x16_bf16(a11, pf1, st[q].o1, 0, 0, 0);
        }
        asm volatile("s_waitcnt lgkmcnt(0)" ::: "memory");
#pragma unroll
        for (int d0 = 0; d0 < 4; ++d0) kf[d0] = kfn[d0];
#pragma unroll
        for (int i = 0; i < 4; ++i) vch[i] = vchn[i];
    }
#undef FL_LOAD
}
__device__ __forceinline__ void flash_init(FlashSt& st) { st.m = -1e30f; st.l = 0.f;
#pragma unroll
    for (int r = 0; r < 16; ++r) { st.o0[r] = 0.f; st.o1[r] = 0.f; } }
__device__ __forceinline__ void flash_store(const FlashSt& st, bf16* orow, int lane) {
    const int hi = lane >> 5; const float inv = 1.f / halfsum(st.l);
    bf16* const dst = orow + 8 * hi;
#pragma unroll
    for (int kk = 0; kk < 4; ++kk) {
        const int g0 = (2 * kk) & 3, g1 = (2 * kk + 1) & 3;
        unsigned ax, ay, bx, by;
        if (kk < 2) { ax = cvtpk_s(st.o0[4 * g0] * inv, st.o0[4 * g0 + 1] * inv); ay = cvtpk_s(st.o0[4 * g0 + 2] * inv, st.o0[4 * g0 + 3] * inv);
                      bx = cvtpk_s(st.o0[4 * g1] * inv, st.o0[4 * g1 + 1] * inv); by = cvtpk_s(st.o0[4 * g1 + 2] * inv, st.o0[4 * g1 + 3] * inv); }
        else        { ax = cvtpk_s(st.o1[4 * g0] * inv, st.o1[4 * g0 + 1] * inv); ay = cvtpk_s(st.o1[4 * g0 + 2] * inv, st.o1[4 * g0 + 3] * inv);
                      bx = cvtpk_s(st.o1[4 * g1] * inv, st.o1[4 * g1 + 1] * inv); by = cvtpk_s(st.o1[4 * g1 + 2] * inv, st.o1[4 * g1 + 3] * inv); }
        { auto r = __builtin_amdgcn_permlane32_swap(ax, bx, false, false); ax = r[0]; bx = r[1]; }
        { auto r = __builtin_amdgcn_permlane32_swap(ay, by, false, false); ay = r[0]; by = r[1]; }
        v4u w; w.x = ax; w.y = ay; w.z = bx; w.w = by;
        *(v4u*)(dst + 16 * kk) = w; }
}

__device__ __forceinline__ void quant_item(const float* W, int ldw, int K, signed char* WQ, float* sb, int n0, int dst_row0, LAS float* scr, int lane) {
    float cmax = 0.f;
#pragma nounroll
    for (int k0 = 0; k0 < K; k0 += 64) {
#pragma unroll
        for (int i = 0; i < 32; ++i) { const int kk = 2 * i + (lane >> 5); cmax = fmaxf(cmax, fabsf(W[(size_t)(k0 + kk) * ldw + n0 + (lane & 31)])); } }
    cmax = halfmax(cmax);
    const float sc = cmax > 0.f ? cmax * (1.f / 127.f) : 1.f;
    LAS float* scl = scr + 64 * 33;
    if (lane < 32) { scl[lane] = 1.f / sc; sb[dst_row0 + lane] = sc; }
    LDS_WAIT(); asm volatile("" ::: "memory");
    const int c = lane & 7;
#pragma nounroll
    for (int k0 = 0; k0 < K; k0 += 64) {
        LAS float* scr_ = scr; asm volatile("" : "+v"(scr_));
#pragma unroll 16
        for (int i = 0; i < 32; ++i) { const int kk = 2 * i + (lane >> 5); scr_[kk * 33 + (lane & 31)] = W[(size_t)(k0 + kk) * ldw + n0 + (lane & 31)]; }
        LDS_WAIT(); asm volatile("" ::: "memory");
#pragma unroll
        for (int j = 0; j < 4; ++j) { const int n = (lane >> 3) + 8 * j; const LAS float* sp = scr_ + (8 * c) * 33 + n; const float is = scl[n];
            int q[8];
#pragma unroll
            for (int e = 0; e < 8; ++e) q[e] = (int)rintf(sp[e * 33] * is) & 0xff;
            v2u o; o.x = (unsigned)q[0] | ((unsigned)q[1] << 8) | ((unsigned)q[2] << 16) | ((unsigned)q[3] << 24); o.y = (unsigned)q[4] | ((unsigned)q[5] << 8) | ((unsigned)q[6] << 16) | ((unsigned)q[7] << 24);
            *(GAS v2u*)(WQ + (size_t)(dst_row0 + n) * K + k0 + 8 * c) = o; }
        LDS_WAIT(); asm volatile("" ::: "memory");
    }
}


__device__ __forceinline__ void st_save(const FlashSt& st, LAS float* row) {
    *(LAS f32x2_t*)row = (f32x2_t){st.m, st.l};
#pragma unroll
    for (int g = 0; g < 4; ++g) { *(LAS f32x4*)(row + 4 + 4 * g) = (f32x4){st.o0[4 * g], st.o0[4 * g + 1], st.o0[4 * g + 2], st.o0[4 * g + 3]};
        *(LAS f32x4*)(row + 20 + 4 * g) = (f32x4){st.o1[4 * g], st.o1[4 * g + 1], st.o1[4 * g + 2], st.o1[4 * g + 3]}; }
}
__device__ __forceinline__ void st_load(FlashSt& st, const LAS float* row) {
    const f32x2_t ml = *(const LAS f32x2_t*)row; st.m = ml.x; st.l = ml.y;
#pragma unroll
    for (int g = 0; g < 4; ++g) { const f32x4 a = *(const LAS f32x4*)(row + 4 + 4 * g), b = *(const LAS f32x4*)(row + 20 + 4 * g);
#pragma unroll
        for (int c = 0; c < 4; ++c) { st.o0[4 * g + c] = a[c]; st.o1[4 * g + c] = b[c]; } }
}
__device__ __forceinline__ void st_save16(const FlashSt& st, LAS unsigned char* row) {
#pragma unroll
    for (int g = 0; g < 2; ++g) { v4u a, b;
        a.x = cvtpk_s(st.o0[8 * g], st.o0[8 * g + 1]); a.y = cvtpk_s(st.o0[8 * g + 2], st.o0[8 * g + 3]); a.z = cvtpk_s(st.o0[8 * g + 4], st.o0[8 * g + 5]); a.w = cvtpk_s(st.o0[8 * g + 6], st.o0[8 * g + 7]);
        b.x = cvtpk_s(st.o1[8 * g], st.o1[8 * g + 1]); b.y = cvtpk_s(st.o1[8 * g + 2], st.o1[8 * g + 3]); b.z = cvtpk_s(st.o1[8 * g + 4], st.o1[8 * g + 5]); b.w = cvtpk_s(st.o1[8 * g + 6], st.o1[8 * g + 7]);
        *(LAS v4u*)(row + 16 * g) = a; *(LAS v4u*)(row + 32 + 16 * g) = b; }
    *(LAS f32x2_t*)(row + 64) = (f32x2_t){st.m, st.l};
}
__device__ __forceinline__ void st_load16(FlashSt& st, const LAS unsigned char* row) {
#pragma unroll
    for (int g = 0; g < 2; ++g) { const v4u a = *(const LAS v4u*)(row + 16 * g), b = *(const LAS v4u*)(row + 32 + 16 * g);
        st.o0[8 * g] = bflo(a.x); st.o0[8 * g + 1] = bfhi(a.x); st.o0[8 * g + 2] = bflo(a.y); st.o0[8 * g + 3] = bfhi(a.y); st.o0[8 * g + 4] = bflo(a.z); st.o0[8 * g + 5] = bfhi(a.z); st.o0[8 * g + 6] = bflo(a.w); st.o0[8 * g + 7] = bfhi(a.w);
        st.o1[8 * g] = bflo(b.x); st.o1[8 * g + 1] = bfhi(b.x); st.o1[8 * g + 2] = bflo(b.y); st.o1[8 * g + 3] = bfhi(b.y); st.o1[8 * g + 4] = bflo(b.z); st.o1[8 * g + 5] = bfhi(b.z); st.o1[8 * g + 6] = bflo(b.w); st.o1[8 * g + 7] = bfhi(b.w); }
    const f32x2_t ml = *(const LAS f32x2_t*)(row + 64); st.m = ml.x; st.l = ml.y;
}
template <bool HAS_BIAS, int NQ, int SUB = 1>
__device__ __forceinline__ void coop_block(FlashSt (&st)[NQ], const bf16x8v (&qf)[NQ][4], const bf16* Kb, const bf16* Vb, int T0, int NT, const int (&LQ)[NQ], int W, const int (&qlast)[NQ], const int (&kmin)[NQ], const LAS float* cumL, LAS unsigned char* stage, int wave, int lane) {
    const int r32 = lane & 31, h5 = lane >> 5;
    const int drow = 8 * wave + (lane >> 3);
    const bf16* const ksrc = Kb + 8 * ((lane & 7) ^ (lane >> 3));
    const bf16* const vsrc = Vb + 8 * ((lane & 7) ^ (((lane >> 4) & 1) << 2));
    const LAS unsigned char* const kr = stage + r32 * 128;
    const int trq_ = (lane & 15) >> 2;
    const LAS unsigned char* const vr = stage + 8192 + (4 * h5 + trq_) * 128 + ((lane >> 4) & 1) * 32 + (lane & 3) * 8;
#define CB_DMA(T, B) do { _Pragma("unroll") for (int sb_ = 0; sb_ < SUB; ++sb_) { int rk_ = T0 + 64 * SUB * (T) + 64 * sb_ + drow; rk_ = rk_ < 0 ? 0 : rk_; \
        __builtin_amdgcn_global_load_lds((const unsigned*)(ksrc + (size_t)rk_ * NAB), (LAS unsigned*)(stage + ((B) * SUB + sb_) * 16384 + wave * 1024), 16, 0, 0); \
        __builtin_amdgcn_global_load_lds((const unsigned*)(vsrc + (size_t)rk_ * NAB), (LAS unsigned*)(stage + ((B) * SUB + sb_) * 16384 + 8192 + wave * 1024), 16, 0, 0); } } while (0)
    CB_DMA(NT - 1, 0);
    for (int tt = 0; tt < NT; ++tt) { const int t = NT - 1 - tt;
        asm volatile("s_waitcnt vmcnt(0)" ::: "memory"); __builtin_amdgcn_s_barrier(); asm volatile("" ::: "memory");
        if (tt + 1 < NT) CB_DMA(t - 1, (tt + 1) & 1);
        const int bo0 = (tt & 1) * SUB * 16384;
#pragma unroll
        for (int kq = 0; kq < 2 * SUB; ++kq) { const int kh2 = 2 * SUB - 1 - kq, kh = kh2 & 1, bo = bo0 + (kh2 >> 1) * 16384; const int k0 = T0 + 64 * SUB * t + 32 * kh2;
            bool need[NQ]; bool any = false;
#pragma unroll
            for (int q = 0; q < NQ; ++q) { need[q] = (k0 <= qlast[q]) && (k0 + 31 >= kmin[q]); any = any || need[q]; }
            if (any) {
                bf16x8v kf[4];
#pragma unroll
                for (int d0 = 0; d0 < 4; ++d0) kf[d0] = *(const LAS bf16x8v*)(kr + bo + kh * 4096 + (((2 * d0 + h5) ^ (r32 & 7)) << 4));
                f32x4 cb[4];
                if (HAS_BIAS) { const LAS float* cp = cumL + k0 + 4 * h5;
#pragma unroll
                    for (int g = 0; g < 4; ++g) cb[g] = *(const LAS f32x4*)(cp + 8 * g); }
                const LAS unsigned char* vb = vr + bo + kh * 4096;
#define FX_VF(DH, KS) ({ const s16x4 lo_ = vtr(vb + (((DH) ^ (trq_ >> 1)) * 64) + (KS) * 2048), hi_ = vtr(vb + (((DH) ^ (trq_ >> 1)) * 64) + (KS) * 2048 + 1024); (bf16x8v){lo_[0], lo_[1], lo_[2], lo_[3], hi_[0], hi_[1], hi_[2], hi_[3]}; })
                const bf16x8v a00 = FX_VF(0, 0), a01 = FX_VF(0, 1), a10 = FX_VF(1, 0), a11 = FX_VF(1, 1);
#undef FX_VF
#pragma unroll
                for (int q = 0; q < NQ; ++q) if (need[q]) {
                    f32x16 s;
                    if (HAS_BIAS) {
#pragma unroll
                        for (int g = 0; g < 4; ++g)
#pragma unroll
                            for (int c = 0; c < 4; ++c) s[4 * g + c] = cb[g][c]; }
                    else {
#pragma unroll
                        for (int r = 0; r < 16; ++r) s[r] = 0.f; }
                    { const int e = LQ[q] - k0 - 4 * h5; int lo = e - W; const int lo3 = -k0 - 4 * h5; lo = lo > lo3 ? lo : lo3;
                      if (!__all(lo <= 0 && e >= 27)) {
#pragma unroll
                          for (int r = 0; r < 16; ++r) { const int jr = (r & 3) + 8 * (r >> 2); if (jr < lo || jr > e) s[r] = -INFINITY; } } }
                    asm volatile("" : "+v"(s));
#pragma unroll
                    for (int d0 = 0; d0 < 4; ++d0) s = __builtin_amdgcn_mfma_f32_32x32x16_bf16(kf[d0], qf[q][d0], s, 0, 0, 0);
                    const float mloc = rowmax16(s);
                    const float mnew = fmaxf(st[q].m, mloc); const float alpha = __builtin_amdgcn_exp2f(st[q].m - mnew); st[q].m = mnew;
                    f32x2_t ls2 = {0.f, 0.f}; const f32x2_t mn2 = {mnew, mnew};
#pragma unroll
                    for (int r = 0; r < 16; r += 2) { f32x2_t d2 = (f32x2_t){s[r], s[r + 1]} - mn2; d2.x = __builtin_amdgcn_exp2f(d2.x); d2.y = __builtin_amdgcn_exp2f(d2.y); ls2 += d2; s[r] = d2.x; s[r + 1] = d2.y; }
                    st[q].l = st[q].l * alpha + (ls2.x + ls2.y);
                    if (__any(alpha != 1.f)) { st[q].o0 = st[q].o0 * alpha; st[q].o1 = st[q].o1 * alpha; }
                    v4u pw0, pw1;
                    pw0.x = cvtpk_s(s[0], s[1]); pw0.y = cvtpk_s(s[2], s[3]); pw0.z = cvtpk_s(s[4], s[5]); pw0.w = cvtpk_s(s[6], s[7]);
                    pw1.x = cvtpk_s(s[8], s[9]); pw1.y = cvtpk_s(s[10], s[11]); pw1.z = cvtpk_s(s[12], s[13]); pw1.w = cvtpk_s(s[14], s[15]);
                    const bf16x8v pf0 = __builtin_bit_cast(bf16x8v, pw0), pf1 = __builtin_bit_cast(bf16x8v, pw1);
                    st[q].o0 = __builtin_amdgcn_mfma_f32_32x32x16_bf16(a00, pf0, st[q].o0, 0, 0, 0); st[q].o0 = __builtin_amdgcn_mfma_f32_32x32x16_bf16(a01, pf1, st[q].o0, 0, 0, 0);
                    st[q].o1 = __builtin_amdgcn_mfma_f32_32x32x16_bf16(a10, pf0, st[q].o1, 0, 0, 0); st[q].o1 = __builtin_amdgcn_mfma_f32_32x32x16_bf16(a11, pf1, st[q].o1, 0, 0, 0);
                }
            }
        }
        asm volatile("s_waitcnt lgkmcnt(0)" ::: "memory");
    }
    __builtin_amdgcn_s_barrier(); asm volatile("" ::: "memory");
#undef CB_DMA
}

__device__ __forceinline__ void absmax_item(const float* W, int ldw, int k0, int n0, unsigned* wm, int lane) {
    float mx = 0.f;
#pragma unroll
    for (int i = 0; i < 32; ++i) { const int kk = 2 * i + (lane >> 5); mx = fmaxf(mx, fabsf(W[(size_t)(k0 + kk) * ldw + n0 + (lane & 31)])); }
    mx = wave_max(mx);
    if (lane == 0) atomicMax(wm, __float_as_uint(mx));
}
__device__ __forceinline__ void transpose_item_f8(const float* W, int ldw, int K, unsigned char* WT, int k0, int n0, int dst_row0, float sc, LAS float* scr, int lane) {
#pragma unroll 16
    for (int i = 0; i < 32; ++i) { const int kk = 2 * i + (lane >> 5); scr[kk * 33 + (lane & 31)] = W[(size_t)(k0 + kk) * ldw + n0 + (lane & 31)]; }
    LDS_WAIT(); asm volatile("" ::: "memory");
    const int c = lane & 7;
#pragma unroll
    for (int j = 0; j < 4; ++j) { const int n = (lane >> 3) + 8 * j; const LAS float* sp = scr + (8 * c) * 33 + n; float v[8];
#pragma unroll
        for (int e = 0; e < 8; ++e) v[e] = __builtin_amdgcn_fmed3f(sp[e * 33] * sc, -448.f, 448.f);
        int w0 = 0, w1 = 0;
        w0 = __builtin_amdgcn_cvt_pk_fp8_f32(v[0], v[1], w0, false); w0 = __builtin_amdgcn_cvt_pk_fp8_f32(v[2], v[3], w0, true);
        w1 = __builtin_amdgcn_cvt_pk_fp8_f32(v[4], v[5], w1, false); w1 = __builtin_amdgcn_cvt_pk_fp8_f32(v[6], v[7], w1, true);
        v2u o; o.x = (unsigned)w0; o.y = (unsigned)w1;
        *(GAS v2u*)(WT + (size_t)(dst_row0 + n) * K + k0 + 8 * c) = o; }
    LDS_WAIT(); asm volatile("" ::: "memory");
}

#define NORM_Q_ROW(v, rstd, gn, m) do { float am_ = 0.f; \
        _Pragma("unroll") for (int j = 0; j < 4; ++j) { v[j] = v[j] * rstd * gn[j]; am_ = fmaxf(am_, fmaxf(fmaxf(fabsf(v[j].x), fabsf(v[j].y)), fmaxf(fabsf(v[j].z), fabsf(v[j].w)))); } \
        am_ = wave_max(am_); \
        const float sc_ = am_ > 0.f ? am_ * (1.f / 127.f) : 1.f, is_ = 1.f / sc_; if (lane == 0) SA[m] = sc_; \
        GAS unsigned* q4_ = (GAS unsigned*)(XQ + (size_t)(m) * D) + lane; \
        _Pragma("unroll") for (int j = 0; j < 4; ++j) q4_[64 * j] = ((unsigned)((int)rintf(v[j].x * is_) & 0xff)) | ((unsigned)((int)rintf(v[j].y * is_) & 0xff) << 8) | ((unsigned)((int)rintf(v[j].z * is_) & 0xff) << 16) | ((unsigned)((int)rintf(v[j].w * is_) & 0xff) << 24); } while (0)
#define XROW4(MROW, J) ({ const v2u u_ = *(const GAS v2u*)(X + (size_t)(MROW) * D + 4 * lane + 256 * (J)); (f32x4){bflo(u_.x), bfhi(u_.x), bflo(u_.y), bfhi(u_.y)}; })
#define NORM_Q_PHASE(gain) do { f32x4 gn[4]; _Pragma("unroll") for (int j = 0; j < 4; ++j) gn[j] = *(const f32x4*)((gain) + 4 * lane + 256 * j); \
        for (int m = gw; m < M; m += 4 * NGW) {                    \
            f32x4 va[4], vb[4], vc[4], vd[4]; \
            const int mb_ = m + NGW < M ? m + NGW : m, mc_ = m + 2 * NGW < M ? m + 2 * NGW : m, md_ = m + 3 * NGW < M ? m + 3 * NGW : m;     \
            _Pragma("unroll") for (int j = 0; j < 4; ++j) { va[j] = XROW4(m, j); vb[j] = XROW4(mb_, j); vc[j] = XROW4(mc_, j); vd[j] = XROW4(md_, j); } \
            NORM_Q_ONE(va, m); if (mb_ != m) NORM_Q_ONE(vb, mb_); if (mc_ != m) NORM_Q_ONE(vc, mc_); if (md_ != m) NORM_Q_ONE(vd, md_); } } while (0)
#define NORM_Q_ONE(V, MROW) do { float ss_ = 0.f; \
        _Pragma("unroll") for (int j = 0; j < 4; ++j) ss_ += (V[j].x * V[j].x + V[j].y * V[j].y) + (V[j].z * V[j].z + V[j].w * V[j].w); \
        const float rstd_ = 1.f / sqrtf(wave_sum(ss_) * (1.f / D) + EPS); NORM_Q_ROW(V, rstd_, gn, MROW); } while (0)

__device__ __forceinline__ void quant_block(const float* W, int ldw, signed char* WQ, float* sb, int n0, int dst_row0, LAS unsigned char* T, LAS float* red, int wave, int lane) {
    const int tid = wave * 64 + lane;
    { const float* src = W + (size_t)(8 * wave + (lane >> 3)) * ldw + n0 + 4 * (lane & 7);
#pragma unroll
      for (int i = 0; i < 16; ++i) __builtin_amdgcn_global_load_lds((const unsigned*)(src + (size_t)(64 * i) * ldw), (LAS unsigned*)(T + (8 * wave + 64 * i) * 128), 16, 0, 0); }
    asm volatile("s_waitcnt vmcnt(0)" ::: "memory"); __builtin_amdgcn_s_barrier(); asm volatile("" ::: "memory");
    const LAS float* Tf = (const LAS float*)T;
    { const int n = tid & 31, part = tid >> 5; float mx = 0.f;
#pragma unroll 16
      for (int k = 0; k < 64; ++k) mx = fmaxf(mx, fabsf(Tf[(64 * part + k) * 32 + n]));
      red[part * 32 + n] = mx; }
    asm volatile("s_waitcnt lgkmcnt(0)" ::: "memory"); __builtin_amdgcn_s_barrier(); asm volatile("" ::: "memory");
    if (tid < 32) { float m = red[tid];
#pragma unroll
        for (int p = 1; p < 16; ++p) m = fmaxf(m, red[p * 32 + tid]);
        const float sc = m > 0.f ? m * (1.f / 127.f) : 1.f; red[512 + tid] = 1.f / sc; sb[dst_row0 + tid] = sc; }
    asm volatile("s_waitcnt lgkmcnt(0)" ::: "memory"); __builtin_amdgcn_s_barrier(); asm volatile("" ::: "memory");
    { const int n = tid & 31; const float is = red[512 + n];
#pragma unroll 2
      for (int i = 0; i < 8; ++i) { const int c = (tid >> 5) + 16 * i; const LAS float* sp = Tf + (8 * c) * 32 + n; int q[8];
#pragma unroll
          for (int e = 0; e < 8; ++e) q[e] = (int)rintf(sp[e * 32] * is) & 0xff;
          v2u o; o.x = (unsigned)q[0] | ((unsigned)q[1] << 8) | ((unsigned)q[2] << 16) | ((unsigned)q[3] << 24); o.y = (unsigned)q[4] | ((unsigned)q[5] << 8) | ((unsigned)q[6] << 16) | ((unsigned)q[7] << 24);
          *(GAS v2u*)(WQ + (size_t)(dst_row0 + n) * 1024 + 8 * c) = o; } }
    asm volatile("s_waitcnt lgkmcnt(0)" ::: "memory"); __builtin_amdgcn_s_barrier(); asm volatile("" ::: "memory");
}

struct Args { const float* in[19]; float* out; unsigned char* ws; int ph_lo, ph_hi; };

__global__ void __launch_bounds__(NTHR, 2) fwd_kernel(Args args) {
    extern __shared__ __attribute__((aligned(16))) unsigned char lds[];
    LAS unsigned char* const L = (LAS unsigned char*)lds;
    volatile LAS unsigned* const MISC = (volatile LAS unsigned*)(L + MISC_OFF);
    const int wave = __builtin_amdgcn_readfirstlane((int)threadIdx.x >> 6);
    const int G = gridDim.x, bx = blockIdx.x;
    const int gw = bx * NWAVES + wave, NGW = G * NWAVES;
    unsigned char* const ws = args.ws;
    gu32* const ctl = (gu32*)(ws + WS_CTL);
    const float* const x_in = args.in[0]; const int* const positions = (const int*)args.in[1];
    const float* const norm_mix = args.in[2]; const float* const norm_ffn = args.in[3];
    const float* const w_in_ab = args.in[4]; const float* const fgate_bias = args.in[5]; const float* const w_out_ab = args.in[6];
    const float* const w_in_c = args.in[7]; const float* const lower_bounds = args.in[8]; const float* const gnorm_c = args.in[9]; const float* const w_out_c = args.in[10];
    const float* const w_gate_ffn = args.in[11]; const float* const w_up_ffn = args.in[12]; const float* const w_down_ffn = args.in[13];
    const float* const router = args.in[14]; const float* const w_gate_moe = args.in[15]; const float* const w_up_moe = args.in[16]; const float* const w_down_moe = args.in[17];
    const float* const norm_final = args.in[18];
    bf16* const X = (bf16*)(ws + 880 * MiB);
    float* const OUTF = args.out;
#define ROPE ((float*)(ws + WS_ROPE))
#define LOGF ((float*)(ws + WS_LOGF))
#define CUM ((float*)(ws + WS_CUM))
#define TOPI ((int*)(ws + WS_TOPI))
#define TOPG ((float*)(ws + WS_TOPG))
#define RANK ((int*)(ws + WS_RANK))
#define POS ((int*)(ws + WS_POS))
#define ROWMAP ((int*)(ws + WS_ROWMAP))
#define CNT ((int*)(ws + WS_CNT))
#define META ((int*)(ws + WS_META))
#define WinAB_t ((bf16*)(ws + WS_WINAB))
#define WoutAB_t ((bf16*)(ws + WS_WOUTAB))
#define Wgu_t ((bf16*)(ws + WS_WGU))
#define Wdown_t ((bf16*)(ws + WS_WDOWN))
#define WinC_t ((bf16*)(ws + WS_WINC))
#define WoutC_t ((bf16*)(ws + WS_WOUTC))
#define WguM_t ((bf16*)(ws + WS_WGUM))
#define WdownM_t ((bf16*)(ws + WS_WDOWNM))
#define XN ((bf16*)(ws + WS_XN))
#define PROJ ((bf16*)(ws + WS_BIG))
#define HID ((bf16*)(ws + WS_BIG))
#define PROJC ((bf16*)(ws + WS_BIG))
#define HIDM ((bf16*)(ws + WS_BIG))
#define YB ((bf16*)(ws + WS_Y))
#define ATT XN
#define XQ ((signed char*)(ws + WS_XN))
#define SA ((float*)(ws + WS_SA))
#define SAS ((float*)(ws + WS_SAS))
#define SBD ((float*)(ws + WS_SBD))
#define SBM ((float*)(ws + WS_SBM))
#define WguQ ((signed char*)(ws + WS_WGU))
#define WinABQ ((signed char*)(ws + WS_WINAB))
#define WinCQ ((signed char*)(ws + WS_WINC))
#define SBAB ((float*)(ws + WS_SBAB))
#define SBC ((float*)(ws + WS_SBC))
#define WguMQ ((signed char*)(ws + WS_WGUM))

    { const int tid = wave * 64 + lane_id(); for (int u = tid; u < (LDS_BYTES - LDSCTL_OFF) / 4; u += NTHR) ((LAS unsigned*)(L + LDSCTL_OFF))[u] = 0u; }
    __syncthreads();
    if (!PER_PHASE_LAUNCH) (void)xcd_barrier_post((unsigned*)(ctl + CW_BAR), MISC + 8, wave == 0 && lane_id() == 0);
#define GRID_BAR() do { if (!PER_PHASE_LAUNCH) { XcdBarrier b_; b_.bar = (unsigned*)((gu32*)(args.ws + WS_CTL) + CW_BAR); b_.x = xb_xcc_id(); b_.st = (volatile LAS unsigned*)(L + MISC_OFF) + 8; xcd_barrier(b_, wave == 0 && lane_id() == 0); } } while (0)
    const int PH_LO = args.ph_lo, PH_HI = args.ph_hi;
#define IN(k) (PH_LO <= (k) && (k) < PH_HI)
#define BOTH(k) (IN(k) && IN((k) + 1))

    if (IN(0)) { const int lane = lane_id(), tid = wave * 64 + lane; (void)tid; (void)lane;
        { constexpr int NB_D = DFF / 32, NB_E = DFFE / 32, NB_AB = NAB / 32, NB_C = NC / 32;
          constexpr int NQ = NB_AB + NB_C + 2 * NB_D + NEXP * 2 * NB_E;
          LAS float* const red = (LAS float*)(L + LDSCTL_OFF + 1024);
          for (int q0_ = bx; q0_ < NQ; q0_ += G) {
              const float* src; int ldw, up = 0, nb, dst0; signed char* dq; float* sbq; int q = q0_;
              if (q < NB_AB + NB_C) { const bool isc = q >= NB_AB; nb = isc ? q - NB_AB : q; src = isc ? w_in_c : w_in_ab; ldw = isc ? NC : IN_AB; dq = isc ? WinCQ : WinABQ; sbq = isc ? SBC : SBAB; dst0 = 32 * nb; }
              else { q -= NB_AB + NB_C;
                  if (q < 2 * NB_D) { up = q >= NB_D; nb = up ? q - NB_D : q; src = up ? w_up_ffn : w_gate_ffn; ldw = DFF; dq = WguQ; sbq = SBD; }
                  else { const int r = q - 2 * NB_D, e = r / (2 * NB_E), rr = r - e * (2 * NB_E); up = rr >= NB_E; nb = up ? rr - NB_E : rr;
                      src = (up ? w_up_moe : w_gate_moe) + (size_t)e * D * DFFE; ldw = DFFE; dq = WguMQ + (size_t)e * NGUE * D; sbq = SBM + (size_t)e * NGUE; }
                  const int n0 = 32 * nb; dst0 = (n0 >> 7) * 256 + up * 128 + (n0 & 127); }
              quant_block(src, ldw, dq, sbq, 32 * nb, dst0, L + RING_OFF, red, wave, lane); } }
        LAS float* scr = (LAS float*)(L + RING_OFF + wave * 16384);
        {
          constexpr int I0 = (D / 64) * (NAB / 32), I1 = (D / 64) * (D / 32), I2 = (DFF / 64) * (D / 32), I3 = (D / 64) * (NC / 32), I4 = I1, I5E = (DFFE / 64) * (D / 32);
          constexpr int NIT = I1 + I2 + I4 + NEXP * I5E; (void)I0; (void)I3;
          for (int it = gw; it < NIT; it += NGW) {
              int r = it; const float* src; int ldw, Kd, nblk; bf16* dst;
              if (false) { src = nullptr; ldw = 0; Kd = 0; nblk = 1; dst = nullptr; }
              else if (r < I1) { src = w_out_ab; ldw = D; Kd = D; nblk = D / 32; dst = WoutAB_t; }
              else if ((r -= I1) < I2) { src = w_down_ffn; ldw = D; Kd = DFF; nblk = D / 32; dst = Wdown_t; }
              else if ((r -= I2) < I4) { src = w_out_c; ldw = D; Kd = D; nblk = D / 32; dst = WoutC_t; }
              else { r -= I4; const int e = r / I5E; r -= e * I5E; const int kb = r / (D / 32), nb = r - kb * (D / 32);
                  absmax_item(w_down_moe + (size_t)e * DFFE * D, D, 64 * kb, 32 * nb, (unsigned*)(ctl + CW_WMAX) + e, lane); continue; }
              const int kb = r / nblk, nb = r - kb * nblk;
              transpose_item(src, ldw, Kd, dst, 64 * kb, 32 * nb, 32 * nb, scr, lane); } }
        for (int idx = bx * NTHR + tid; idx < M * 8; idx += G * NTHR) { const int m = idx >> 3, i = idx & 7;
            const float invf = exp2f(-(float)i * (18.931568569324174f / 8.0f)); const float ang = (float)positions[m] * invf;
            ROPE[m * 16 + i] = cosf(ang); ROPE[m * 16 + 8 + i] = sinf(ang); }
        {
            float gw_[4][4][8]; f32x4 gn[4];
#pragma unroll
            for (int j = 0; j < 4; ++j) { gn[j] = *(const f32x4*)(norm_mix + 4 * lane + 256 * j);
#pragma unroll
                for (int c = 0; c < 4; ++c) { const int col = 4 * lane + 256 * j + c;
#pragma unroll
                    for (int h = 0; h < 8; ++h) gw_[j][c][h] = w_in_ab[(size_t)col * IN_AB + NAB + h] * gn[j][c]; } }
            float fb = (lane < 8) ? fgate_bias[lane] : 0.f;
            for (int m = gw; m < M; m += NGW) {
                const GAS f32x4* xr = (const GAS f32x4*)(x_in + (size_t)m * D) + lane;
                f32x4 v[4]; float ss = 0.f; float fl[8];
#pragma unroll
                for (int h = 0; h < 8; ++h) fl[h] = 0.f;
#pragma unroll
                for (int j = 0; j < 4; ++j) { v[j] = xr[64 * j]; ss += (v[j].x * v[j].x + v[j].y * v[j].y) + (v[j].z * v[j].z + v[j].w * v[j].w);
#pragma unroll
                    for (int c = 0; c < 4; ++c)
#pragma unroll
                        for (int h = 0; h < 8; ++h) fl[h] += v[j][c] * gw_[j][c][h]; }
                { GAS v2u* xo = (GAS v2u*)(X + (size_t)m * D) + lane;
#pragma unroll
                  for (int j = 0; j < 4; ++j) { v2u o; o.x = pk2(v[j].x, v[j].y); o.y = pk2(v[j].z, v[j].w); xo[64 * j] = o; } }
                const float rstd = 1.f / sqrtf(wave_sum(ss) * (1.f / D) + EPS);
                float mine = 0.f;
#pragma unroll
                for (int h = 0; h < 8; ++h) { const float t = wave_sum(fl[h]); if (lane == h) mine = t; }
                if (lane < 8) { const float z = mine * rstd + fb; LOGF[(size_t)m * 8 + lane] = fminf(z, 0.f) - log1pf(__expf(-fabsf(z))); }
                NORM_Q_ROW(v, rstd, gn, m);
            }
        }
        if (BOTH(0)) GRID_BAR();
    }

    if (IN(1)) { const int lane = lane_id(), tid = wave * 64 + lane; (void)tid; (void)lane;
        if (wave == 0) for (int bh = bx; bh < BATCH * NH; bh += G) { const int b = bh >> 3, h = bh & 7;
            float loc[32]; float s = 0.f;
#pragma unroll
            for (int i = 0; i < 32; ++i) { s += LOGF[((size_t)(b * SEQ + lane * 32 + i)) * 8 + h]; loc[i] = s; }
            float incl = s;
#pragma unroll
            for (int o = 1; o < 64; o <<= 1) { const float t = __shfl_up(incl, o); if (lane >= o) incl += t; }
            const float excl = incl - s;
#pragma unroll
            for (int i = 0; i < 32; ++i) CUM[(size_t)bh * SEQ + lane * 32 + i] = (excl + loc[i]) * LOG2E; }
        { LAS float* scr = (LAS float*)(L + RING_OFF + wave * 16384);
          constexpr int I5E = (DFFE / 64) * (D / 32);
          for (int it = gw; it < NEXP * I5E; it += NGW) { const int e = it / I5E, r = it - e * I5E, kb = r / (D / 32), nb = r - kb * (D / 32);
              const float am = __uint_as_float(((const unsigned*)(ctl + CW_WMAX))[e]); const float sc = am > 0.f ? 256.f / am : 1.f;
              transpose_item_f8(w_down_moe + (size_t)e * DFFE * D, D, DFFE, (unsigned char*)WdownM_t + (size_t)e * D * DFFE, 64 * kb, 32 * nb, 32 * nb, sc, scr, lane); }
          __syncthreads(); }
        pg8::Gemm g{(const bf16*)XQ, (const bf16*)WinABQ, M, NAB, D}; pg8::StaticOrder S; S.init(M, NAB, G, bx);
        pg8::EpiProjAB E{PROJ, NAB, ROPE, QSCALE_AB, SA, SBAB};
        pg8::gemm_phase<pg8::EpiProjAB, pg8::StaticOrder, true, false, 1>(L + RING_OFF, g, S, E, nullptr, wave);
        if (BOTH(1)) GRID_BAR();
    }

    if (IN(2)) { const int lane = lane_id(), tid = wave * 64 + lane; (void)tid; (void)lane;
        LAS unsigned char* const vbuf = L + wave * 4096;
        LAS float* const cumL = (LAS float*)(L + 32768);
        const int r32 = lane & 31, hi = lane >> 5;
        for (int bh = bx; bh < BATCH * NH; bh += G) { const int b = bh >> 3, h = bh & 7;
            const bf16* const Pb = PROJ + (size_t)b * SEQ * NAB;
            { const bf16* const Qb = Pb + h * HD; const bf16* const Kb = Pb + 512 + h * HD; const bf16* const Vb = Pb + 1024 + h * HD;
              LAS unsigned char* const STL = L + 40960;
              for (int qb2 = 0; qb2 < SEQ / 512; ++qb2) { const int q0 = 512 * qb2;
                { bf16x8v qfa[2][4]; FlashSt sta[2]; int lqa[2], qla[2], kma[2];
#pragma unroll
                  for (int q = 0; q < 2; ++q) { const int tq = q0 + 256 * q + 32 * wave + r32; lqa[q] = tq; qla[q] = q0 + 256 * q + 32 * wave + 31; kma[q] = q0 + 256 * q + 32 * wave - 128; flash_init(sta[q]);
#pragma unroll
                      for (int d0 = 0; d0 < 4; ++d0) qfa[q][d0] = *(const bf16x8v*)(Qb + (size_t)tq * NAB + 16 * d0 + 8 * hi); }
                  coop_block<false, 2>(sta, qfa, Kb, Vb, q0 - 128, 10, lqa, 128, qla, kma, cumL, L, wave, lane);
#pragma unroll
                  for (int q = 0; q < 2; ++q) st_save16(sta[q], STL + ((lqa[q] - q0) * 2 + hi) * 80); }
                __syncthreads();
                { const int c4 = wave & 3, hf = wave >> 2, l4b = (q0 >> 2) + 64 * hf;
                  bf16x8v qf2[2][4]; FlashSt st2[2]; int lq2[2], lqb2[2];
#pragma unroll
                  for (int q = 0; q < 2; ++q) { lqb2[q] = l4b + 32 * q; lq2[q] = lqb2[q] + r32; const int tq = 4 * lq2[q] + c4;
#pragma unroll
                      for (int d0 = 0; d0 < 4; ++d0) qf2[q][d0] = *(const bf16x8v*)(Qb + (size_t)tq * NAB + 16 * d0 + 8 * hi);
                      st_load16(st2[q], STL + ((tq - q0) * 2 + hi) * 80); }
                  flash_tiles2(st2, qf2, Kb, Vb, 4 * (l4b - 128) + c4, 4, 6, 128, lq2, lqb2, l4b - 128, 128, vbuf, lane);
#pragma unroll
                  for (int q = 0; q < 2; ++q) { const int tq = 4 * lq2[q] + c4; st_save16(st2[q], STL + ((tq - q0) * 2 + hi) * 80); } }
                __syncthreads();
                for (int cc = 0; cc < 2; ++cc) { const int cls = 2 * wave + cc, l16q = (q0 >> 4) + r32, tq = 16 * l16q + cls; bf16x8v qf[4];
#pragma unroll
                  for (int d0 = 0; d0 < 4; ++d0) qf[d0] = *(const bf16x8v*)(Qb + (size_t)tq * NAB + 16 * d0 + 8 * hi);
                  FlashSt st; st_load16(st, STL + ((tq - q0) * 2 + hi) * 80);
                  const int nt = ((q0 >> 4) + 32 + 31) >> 5;
                  flash_tiles<false>(st, qf, Kb, Vb, cls, 16, nt, 512, l16q, 0, 1 << 20, cumL, vbuf, lane);
                  flash_store(st, ATT + (size_t)(b * SEQ + tq) * D + h * HD, lane); }
                __syncthreads(); } }
            __syncthreads();
            LAS float* const cumF = (LAS float*)(L + 65536);
            for (int i = tid; i < SEQ; i += NTHR) cumF[i] = -CUM[(size_t)bh * SEQ + i];
            __syncthreads();
            { const bf16* const Qb = Pb + 1536 + h * HD; const bf16* const Kb = Pb + 2048 + h * HD; const bf16* const Vb = Pb + 2560 + h * HD;
              for (int qb = 0; qb < SEQ / 512; ++qb) { const int tq = 512 * qb + 32 * wave + r32;
                bf16x8v qf2[2][4];
#pragma unroll
                for (int q = 0; q < 2; ++q)
#pragma unroll
                    for (int d0 = 0; d0 < 4; ++d0) qf2[q][d0] = *(const bf16x8v*)(Qb + (size_t)(tq + 256 * q) * NAB + 16 * d0 + 8 * hi);
                FlashSt st2[2]; flash_init(st2[0]); flash_init(st2[1]);
                { const int lq2[2] = {tq, tq + 256}, ql2[2] = {512 * qb + 32 * wave + 31, 512 * qb + 256 + 32 * wave + 31}, km2[2] = {-(1 << 30), -(1 << 30)};
                  coop_block<true, 2, 2>(st2, qf2, Kb, Vb, 0, (512 * qb + 512) >> 7, lq2, 4096, ql2, km2, cumF, L, wave, lane); }
#pragma unroll
                for (int q = 0; q < 2; ++q) flash_store(st2[q], ATT + (size_t)(b * SEQ + tq + 256 * q) * D + 512 + h * HD, lane); } }
        }
        __syncthreads();
        if (BOTH(2)) GRID_BAR();
    }

    if (IN(3)) { const int lane = lane_id(), tid = wave * 64 + lane; (void)tid; (void)lane;
        pg8::Gemm g{ATT, WoutAB_t, M, D, D}; pg8::StaticOrder S; S.init(M, D, G, bx);
        pg8::EpiResidualB<false> E{X, X};
        pg8::gemm_phase<pg8::EpiResidualB<false>, pg8::StaticOrder, true, false>(L + RING_OFF, g, S, E, nullptr, wave);
        if (BOTH(3)) GRID_BAR();
    }

#define NORM_PHASE(gain) do { f32x4 gn[4]; _Pragma("unroll") for (int j = 0; j < 4; ++j) gn[j] = *(const f32x4*)((gain) + 4 * lane + 256 * j); \
        for (int m = gw; m < M; m += NGW) { f32x4 v[4]; float ss = 0.f; \
            _Pragma("unroll") for (int j = 0; j < 4; ++j) { v[j] = XROW4(m, j); ss += (v[j].x * v[j].x + v[j].y * v[j].y) + (v[j].z * v[j].z + v[j].w * v[j].w); } \
            const float rstd = 1.f / sqrtf(wave_sum(ss) * (1.f / D) + EPS); \
            GAS unsigned long long* o8 = (GAS unsigned long long*)(XN + (size_t)m * D) + lane; \
            _Pragma("unroll") for (int j = 0; j < 4; ++j) { const f32x4 y = v[j] * rstd * gn[j]; o8[64 * j] = (unsigned long long)pk2(y.x, y.y) | ((unsigned long long)pk2(y.z, y.w) << 32); } } } while (0)

    if (IN(4)) { const int lane = lane_id(), tid = wave * 64 + lane; (void)tid; (void)lane; NORM_Q_PHASE(norm_ffn); if (BOTH(4)) GRID_BAR(); }

    if (IN(5)) { const int lane = lane_id(), tid = wave * 64 + lane; (void)tid; (void)lane;
        pg8::Gemm g{(const bf16*)XQ, (const bf16*)WguQ, M, NGU, D}; pg8::StaticOrder S; S.init(M, NGU, G, bx);
        pg8::EpiSwiGLUI8 E{HID, DFF, 0, SA, SBD};
        pg8::gemm_phase<pg8::EpiSwiGLUI8, pg8::StaticOrder, true, false, 1>(L + RING_OFF, g, S, E, nullptr, wave);
        if (BOTH(5)) GRID_BAR();
    }
    if (IN(6)) { const int lane = lane_id(), tid = wave * 64 + lane; (void)tid; (void)lane;
        pg8::Gemm g{HID, Wdown_t, M, D, DFF}; pg8::StaticOrder S; S.init(M, D, G, bx);
        pg8::EpiResidualB<false> E{X, X};
        pg8::gemm_phase<pg8::EpiResidualB<false>, pg8::StaticOrder, true, false>(L + RING_OFF, g, S, E, nullptr, wave);
        if (BOTH(6)) GRID_BAR();
    }
    if (IN(7)) { const int lane = lane_id(), tid = wave * 64 + lane; (void)tid; (void)lane; NORM_Q_PHASE(norm_mix + D); if (BOTH(7)) GRID_BAR(); }
    if (IN(8)) { const int lane = lane_id(), tid = wave * 64 + lane; (void)tid; (void)lane;
        pg8::Gemm g{(const bf16*)XQ, (const bf16*)WinCQ, M, NC, D}; pg8::StaticOrder S; S.init(M, NC, G, bx);
        pg8::EpiBf16S E{PROJC, NC, 4, QSCALE_C, SA, SBC};
        pg8::gemm_phase<pg8::EpiBf16S, pg8::StaticOrder, true, false, 1>(L + RING_OFF, g, S, E, nullptr, wave);
        if (BOTH(8)) GRID_BAR();
    }
    if (IN(9)) { const int lane = lane_id(), tid = wave * 64 + lane; (void)tid; (void)lane;
#define HG_BAR() do { asm volatile("s_waitcnt lgkmcnt(0)" ::: "memory"); __builtin_amdgcn_s_barrier(); asm volatile("" ::: "memory"); } while (0)
        constexpr int PQ = 272, PV = 320;
        LAS unsigned char* const QT = L;
        LAS unsigned char* const KT = L + 17408;
        LAS unsigned char* const KH = L + 34816;
        LAS unsigned char* const VT = L + 55296;
        LAS float* const OL = (LAS float*)(L + 75776);
        LAS float* const EBL = (LAS float*)(L + 108544);
        LAS float* const GT = (LAS float*)(L + 109056);
        const int r32 = lane & 31, h5 = lane >> 5, tb = wave >> 2, eb = wave & 3, dp = lane, grp = wave;
        const int trq = (lane & 15) >> 2, trp = lane & 3, trc = (lane >> 4) & 1;
        for (int bh = bx; bh < BATCH * NH; bh += G) { const int b = bh >> 3, h = bh & 7;
            const float lbv0 = sigm_fast(lower_bounds[D + h * HK + 2 * dp] - lower_bounds[h * HK + 2 * dp]), lbv1 = sigm_fast(lower_bounds[D + h * HK + 2 * dp + 1] - lower_bounds[h * HK + 2 * dp + 1]);
            const float gn0 = gnorm_c[2 * lane], gn1 = gnorm_c[2 * lane + 1];
            f32x16 S[4];
#pragma unroll
            for (int i = 0; i < 4; ++i)
#pragma unroll
                for (int r = 0; r < 16; ++r) S[i][r] = 0.f;
            unsigned fraw[8], qraw[8]; v4u vraw[2]; unsigned graw[8];
#define HG_PRELOAD(CH) do { const int m0_ = b * SEQ + (CH) * 64; \
                _Pragma("unroll") for (int j = 0; j < 8; ++j) { const bf16* pr = PROJC + (size_t)(m0_ + 8 * grp + j) * NC + h * HK + 2 * dp; fraw[j] = *(const unsigned*)(pr + D); qraw[j] = *(const unsigned*)pr; } \
                _Pragma("unroll") for (int i = 0; i < 2; ++i) { const int c = tid + 512 * i, row = c >> 4, c16 = c & 15; vraw[i] = *(const v4u*)(PROJC + (size_t)(m0_ + row) * NC + 2 * D + h * HK + 8 * c16); } } while (0)
#define HG_GLOAD(CH) do { const int m0_ = b * SEQ + (CH) * 64; \
                _Pragma("unroll") for (int tt = 0; tt < 8; ++tt) graw[tt] = *(const unsigned*)(PROJC + (size_t)(m0_ + wave * 8 + tt) * NC + 3 * D + h * HK + 2 * lane); } while (0)
            HG_PRELOAD(0);
            for (int ch = 0; ch < SEQ / 64; ++ch) { const int m0 = b * SEQ + ch * 64;
                float bl0[8], bl1[8], k0[8], k1[8], q0[8], q1[8]; float run0 = 1.f, run1 = 1.f;
#pragma unroll
                for (int j = 0; j < 8; ++j) { const float f0 = lbv0 + (1.f - lbv0) * sigm_fast(bflo(fraw[j])), f1 = lbv1 + (1.f - lbv1) * sigm_fast(bfhi(fraw[j]));
                    run0 *= f0; run1 *= f1; bl0[j] = run0; bl1[j] = run1; k0[j] = 1.f - f0; k1[j] = 1.f - f1; q0[j] = bflo(qraw[j]); q1[j] = bfhi(qraw[j]); }
                *(LAS f32x2_t*)(GT + grp * 128 + 2 * dp) = (f32x2_t){run0, run1};
#pragma unroll
                for (int i = 0; i < 2; ++i) { const int c = tid + 512 * i, row = c >> 4, c16 = c & 15; *(LAS v4u*)(VT + row * PV + c16 * 16) = vraw[i]; }
                HG_BAR();
                { float off0 = 1.f, off1 = 1.f, tot0 = 1.f, tot1 = 1.f;
#pragma unroll
                  for (int g2 = 0; g2 < 8; ++g2) { const f32x2_t v = *(const LAS f32x2_t*)(GT + g2 * 128 + 2 * dp); tot0 *= v.x; tot1 *= v.y; if (g2 < grp) { off0 *= v.x; off1 *= v.y; } }
                  const float et0 = tot0, et1 = tot1;
#pragma unroll
                  for (int j = 0; j < 8; ++j) { const int t = 8 * grp + j;
                      const float e0 = off0 * bl0[j], e1 = off1 * bl1[j]; const float kt0 = k0[j] * __builtin_amdgcn_rcpf(e0), kt1 = k1[j] * __builtin_amdgcn_rcpf(e1);
                      *(LAS unsigned*)(QT + t * PQ + dp * 4) = cvtpk_s(q0[j] * e0, q1[j] * e1);
                      *(LAS unsigned*)(KT + t * PQ + dp * 4) = cvtpk_s(kt0, kt1);
                      *(LAS unsigned*)(KH + t * PV + dp * 4) = cvtpk_s(kt0 * et0, kt1 * et1); }
                  if (grp == 0) *(LAS f32x2_t*)(EBL + 2 * dp) = (f32x2_t){et0, et1}; }
                HG_GLOAD(ch); if (ch + 1 < SEQ / 64) HG_PRELOAD(ch + 1);
                HG_BAR();
                {
                    f32x16 o, sc;
#pragma unroll
                    for (int r = 0; r < 16; ++r) { o[r] = 0.f; sc[r] = 0.f; }
                    asm volatile("" : "+v"(o), "+v"(sc));
                    bf16x8v qb[8];
#pragma unroll
                    for (int ks = 0; ks < 8; ++ks) qb[ks] = *(const LAS bf16x8v*)(QT + (32 * tb + r32) * PQ + (16 * ks + 8 * h5) * 2);
#pragma unroll
                    for (int ks = 0; ks < 8; ++ks) { const int db = ks >> 1, k2 = ks & 1;
                        v4u bw; bw.x = cvtpk_s(S[db][8 * k2], S[db][8 * k2 + 1]); bw.y = cvtpk_s(S[db][8 * k2 + 2], S[db][8 * k2 + 3]); bw.z = cvtpk_s(S[db][8 * k2 + 4], S[db][8 * k2 + 5]); bw.w = cvtpk_s(S[db][8 * k2 + 6], S[db][8 * k2 + 7]);
                        const LAS unsigned char* qa = QT + (32 * tb + r32) * PQ + (32 * db + 16 * k2 + 4 * h5) * 2;
                        const v2u a0 = *(const LAS v2u*)qa, a1 = *(const LAS v2u*)(qa + 16);
                        v4u aw; aw.x = a0.x; aw.y = a0.y; aw.z = a1.x; aw.w = a1.y;
                        const bf16x8v ka = *(const LAS bf16x8v*)(KT + r32 * PQ + (16 * ks + 8 * h5) * 2);
                        o = __builtin_amdgcn_mfma_f32_32x32x16_bf16(__builtin_bit_cast(bf16x8v, aw), __builtin_bit_cast(bf16x8v, bw), o, 0, 0, 0);
                        sc = __builtin_amdgcn_mfma_f32_32x32x16_bf16(ka, qb[ks], sc, 0, 0, 0); }
                    for (int sb = 0; sb <= tb; ++sb) {
                        if (sb == 1) {
#pragma unroll
                            for (int r = 0; r < 16; ++r) sc[r] = 0.f;
                            asm volatile("" : "+v"(sc));
#pragma unroll
                            for (int ks = 0; ks < 8; ++ks) { const bf16x8v ka = *(const LAS bf16x8v*)(KT + (32 + r32) * PQ + (16 * ks + 8 * h5) * 2);
                                sc = __builtin_amdgcn_mfma_f32_32x32x16_bf16(ka, qb[ks], sc, 0, 0, 0); } }
                        if (sb == tb) {
#pragma unroll
                            for (int r = 0; r < 16; ++r) { const int sl = (r & 3) + 8 * (r >> 2) + 4 * h5; if (sl > r32) sc[r] = 0.f; } }
                        v4u p0, p1;
                        p0.x = cvtpk_s(sc[0], sc[1]); p0.y = cvtpk_s(sc[2], sc[3]); p0.z = cvtpk_s(sc[4], sc[5]); p0.w = cvtpk_s(sc[6], sc[7]);
                        p1.x = cvtpk_s(sc[8], sc[9]); p1.y = cvtpk_s(sc[10], sc[11]); p1.z = cvtpk_s(sc[12], sc[13]); p1.w = cvtpk_s(sc[14], sc[15]);
                        const LAS unsigned char* vb = VT + (32 * sb + 4 * h5 + trq) * PV + (32 * eb + 16 * trc + 4 * trp) * 2;
                        { const s16x4 l0 = vtr(vb), u0 = vtr(vb + 8 * PV), l1 = vtr(vb + 16 * PV), u1 = vtr(vb + 24 * PV);
                          const bf16x8v v0 = (bf16x8v){l0[0], l0[1], l0[2], l0[3], u0[0], u0[1], u0[2], u0[3]}, v1 = (bf16x8v){l1[0], l1[1], l1[2], l1[3], u1[0], u1[1], u1[2], u1[3]};
                          o = __builtin_amdgcn_mfma_f32_32x32x16_bf16(__builtin_bit_cast(bf16x8v, p0), v0, o, 0, 0, 0);
                          o = __builtin_amdgcn_mfma_f32_32x32x16_bf16(__builtin_bit_cast(bf16x8v, p1), v1, o, 0, 0, 0); }
                    }
#pragma unroll
                    for (int r = 0; r < 16; ++r) OL[(32 * tb + (r & 3) + 8 * (r >> 2) + 4 * h5) * 128 + 32 * eb + r32] = o[r];
                    const LAS unsigned char* kb_ = KH + (8 * h5 + trq) * PV + (16 * trc + 4 * trp) * 2;
                    const LAS unsigned char* vb_ = VT + (8 * h5 + trq) * PV + (32 * eb + 16 * trc + 4 * trp) * 2;
                    bf16x8v vf[4];
#pragma unroll
                    for (int ks = 0; ks < 4; ++ks) { const s16x4 l = vtr(vb_ + 16 * ks * PV), u = vtr(vb_ + (16 * ks + 4) * PV); vf[ks] = (bf16x8v){l[0], l[1], l[2], l[3], u[0], u[1], u[2], u[3]}; }
#pragma unroll
                    for (int db = 0; db < 4; ++db)
#pragma unroll
                        for (int g2 = 0; g2 < 4; ++g2) { const f32x4 e4 = *(const LAS f32x4*)(EBL + 32 * db + 8 * g2 + 4 * h5);
#pragma unroll
                            for (int c = 0; c < 4; ++c) S[db][4 * g2 + c] *= e4[c]; }
#pragma unroll
                    for (int ks = 0; ks < 4; ++ks)
#pragma unroll
                        for (int db = 0; db < 4; ++db) { const s16x4 l = vtr(kb_ + 16 * ks * PV + 64 * db), u = vtr(kb_ + (16 * ks + 4) * PV + 64 * db);
                            const bf16x8v kf_ = (bf16x8v){l[0], l[1], l[2], l[3], u[0], u[1], u[2], u[3]};
                            S[db] = __builtin_amdgcn_mfma_f32_32x32x16_bf16(kf_, vf[ks], S[db], 0, 0, 0); }
                }
                HG_BAR();
#pragma unroll
                for (int tt = 0; tt < 8; ++tt) { const int t = wave * 8 + tt; const int m = m0 + t;
                    const f32x2_t ov = *(const LAS f32x2_t*)(OL + t * 128 + 2 * lane); const float o0 = ov.x, o1 = ov.y;
                    const float rstd = __builtin_amdgcn_rsqf(wave_sum(o0 * o0 + o1 * o1) * (1.f / 128.f) + EPS);
                    const float g0 = bflo(graw[tt]), g1 = bfhi(graw[tt]);
                    *(unsigned*)(XN + (size_t)m * D + h * HK + 2 * lane) = cvtpk_s(o0 * rstd * gn0 * g0 * sigm_fast(g0), o1 * rstd * gn1 * g1 * sigm_fast(g1)); }
            }
#undef HG_PRELOAD
#undef HG_GLOAD
            __syncthreads();
        }
        __syncthreads();
        if (BOTH(9)) GRID_BAR();
    }
    if (IN(10)) { const int lane = lane_id(), tid = wave * 64 + lane; (void)tid; (void)lane;
        pg8::Gemm g{XN, WoutC_t, M, D, D}; pg8::StaticOrder S; S.init(M, D, G, bx);
        pg8::EpiResidualB<false> E{X, X};
        pg8::gemm_phase<pg8::EpiResidualB<false>, pg8::StaticOrder, true, false>(L + RING_OFF, g, S, E, nullptr, wave);
        if (BOTH(10)) GRID_BAR();
    }
    if (IN(11)) { const int lane = lane_id(), tid = wave * 64 + lane; (void)tid; (void)lane;
        LAS int* const cnt = (LAS int*)(L);
        float rw[4][4][8]; f32x4 gn[4];
#pragma unroll
        for (int j = 0; j < 4; ++j) { gn[j] = *(const f32x4*)(norm_ffn + D + 4 * lane + 256 * j);
#pragma unroll
            for (int c = 0; c < 4; ++c) { const int col = 4 * lane + 256 * j + c;
#pragma unroll
                for (int e = 0; e < 8; ++e) rw[j][c][e] = router[(size_t)col * NEXP + e] * gn[j][c]; } }
        for (int chunk = bx; chunk < M / 256; chunk += G) {
            __syncthreads();
            if (tid < 8) cnt[tid] = 0;
            __syncthreads();
            for (int r = 0; r < 32; ++r) { const int m = chunk * 256 + wave * 32 + r;
                f32x4 v[4]; float ss = 0.f; float lg[8];
#pragma unroll
                for (int e = 0; e < 8; ++e) lg[e] = 0.f;
#pragma unroll
                for (int j = 0; j < 4; ++j) { v[j] = XROW4(m, j); ss += (v[j].x * v[j].x + v[j].y * v[j].y) + (v[j].z * v[j].z + v[j].w * v[j].w);
#pragma unroll
                    for (int c = 0; c < 4; ++c)
#pragma unroll
                        for (int e = 0; e < 8; ++e) lg[e] += v[j][c] * rw[j][c][e]; }
                const float rstd = 1.f / sqrtf(wave_sum(ss) * (1.f / D) + EPS);
#pragma unroll
                for (int e = 0; e < 8; ++e) lg[e] = wave_sum(lg[e]) * rstd;
                NORM_Q_ROW(v, rstd, gn, m);
                if (lane == 0) {
                    int e0 = 0; float v0 = lg[0];
#pragma unroll
                    for (int e = 1; e < 8; ++e) if (lg[e] > v0) { v0 = lg[e]; e0 = e; }
                    int e1 = -1; float v1 = -INFINITY;
#pragma unroll
                    for (int e = 0; e < 8; ++e) if (e != e0 && lg[e] > v1) { v1 = lg[e]; e1 = e; }
                    const float g1 = 1.f / (1.f + __expf(v0 - v1)), g0 = 1.f - g1;
                    const int r0 = atomicAdd((int*)(cnt + e0), 1), r1 = atomicAdd((int*)(cnt + e1), 1);
                    TOPI[m] = e0 | (e1 << 8); TOPG[2 * m] = g0; TOPG[2 * m + 1] = g1; RANK[2 * m] = r0; RANK[2 * m + 1] = r1;
                }
            }
            __syncthreads();
            if (tid < 8) CNT[chunk * 8 + tid] = cnt[tid];
        }
        __syncthreads();
        if (BOTH(11)) GRID_BAR();
    }
    if (IN(12)) { const int lane = lane_id(), tid = wave * 64 + lane; (void)tid; (void)lane;
        LAS int* const lc = (LAS int*)(L);
        LAS int* const tot = lc + 2048;
        LAS int* const base = tot + 8;
        LAS int* const off = base + 16;
        __syncthreads();
        for (int i = tid; i < 2048; i += NTHR) lc[i] = CNT[i];
        __syncthreads();
        if (tid < 8) { int s = 0; for (int c = 0; c < 256; ++c) s += lc[c * 8 + tid]; tot[tid] = s; }
        __syncthreads();
        if (tid == 0) { int b = 0; for (int e = 0; e < 8; ++e) { base[e] = b; b += (tot[e] + 255) & ~255; } base[8] = b; }
        __syncthreads();
        for (int chunk = bx; chunk < M / 256; chunk += G) {
            __syncthreads();
            if (tid < 8) { int s = base[tid]; for (int c = 0; c < chunk; ++c) s += lc[c * 8 + tid]; off[tid] = s; }
            __syncthreads();
            { const int m = chunk * 256 + (tid >> 1), slot = tid & 1; const int ti = TOPI[m]; const int e = slot ? (ti >> 8) : (ti & 0xff);
              const int pos = off[e] + RANK[2 * m + slot]; ROWMAP[pos] = m; POS[2 * m + slot] = pos; SAS[pos] = SA[m]; }
        }
        if (bx == 0) {
            for (int e = 0; e < 8; ++e) for (int p = base[e] + tot[e] + tid; p < base[e + 1]; p += NTHR) { ROWMAP[p] = 0; SAS[p] = 0.f; }
            if (tid == 0) META[0] = base[8] >> 8;
            for (int p = tid; p < NPMAX; p += NTHR) { int e = 0; for (int k = 1; k < 8; ++k) if (p * 256 >= base[k]) e = k; META[64 + p] = e; }
        }
        __syncthreads();
        if (BOTH(12)) GRID_BAR();
    }
    for (int c = 0; c < NMCH; ++c) {
        if (IN(13 + 2 * c)) { const int lane = lane_id(), tid = wave * 64 + lane; (void)tid; (void)lane;
            const int ptot = __builtin_amdgcn_readfirstlane(META[0]); const int p_lo = c * PCHUNK; int p_n = ptot - p_lo; p_n = p_n < 0 ? 0 : (p_n > PCHUNK ? PCHUNK : p_n);
            int p_tail = (c == NMCH - 1) ? ptot - p_lo - p_n : 0; p_tail = p_tail < 0 ? 0 : p_tail;
            pg8::Gemm g{(const bf16*)XQ, (const bf16*)WguMQ, M, NGUE, D}; pg8::MoeOrder S{p_lo, p_n, p_tail, NGUE / 256, G, bx, 0, META + 64}; S.init();
            pg8::EpiSwiGLUI8F8 E{HIDM, DFFE, p_lo, SAS, SBM};
            pg8::gemm_phase<pg8::EpiSwiGLUI8F8, pg8::MoeOrder, true, true, 1>(L + RING_OFF, g, S, E, ROWMAP, wave);
            if (BOTH(13 + 2 * c)) GRID_BAR();
        }
        if (IN(14 + 2 * c)) { const int lane = lane_id(), tid = wave * 64 + lane; (void)tid; (void)lane;
            const int ptot = __builtin_amdgcn_readfirstlane(META[0]); const int p_lo = c * PCHUNK; int p_n = ptot - p_lo; p_n = p_n < 0 ? 0 : (p_n > PCHUNK ? PCHUNK : p_n);
            int p_tail = (c == NMCH - 1) ? ptot - p_lo - p_n : 0; p_tail = p_tail < 0 ? 0 : p_tail;
            pg8::Gemm g{HIDM, WdownM_t, (PCHUNK + 8) * 256, D, DFFE}; pg8::MoeOrder S{p_lo, p_n, p_tail, D / 256, G, bx, 1, META + 64}; S.init();
            pg8::EpiBf16RowsF8 E{YB, D, p_lo * 256, (const unsigned*)(ctl + CW_WMAX)};
            pg8::gemm_phase<pg8::EpiBf16RowsF8, pg8::MoeOrder, true, false, 2>(L + RING_OFF, g, S, E, nullptr, wave);
            if (BOTH(14 + 2 * c)) GRID_BAR();
        }
    }
    if (IN(13 + 2 * NMCH)) { const int lane = lane_id(), tid = wave * 64 + lane; (void)tid; (void)lane;
        f32x4 gn[4];
#pragma unroll
        for (int j = 0; j < 4; ++j) gn[j] = *(const f32x4*)(norm_final + 4 * lane + 256 * j);
        int pn0 = POS[2 * gw], pn1 = POS[2 * gw + 1]; float gq0 = TOPG[2 * gw], gq1 = TOPG[2 * gw + 1];
        for (int m = gw; m < M; m += NGW) {
            const int p0 = pn0, p1 = pn1; const float g0 = gq0, g1 = gq1;
            const GAS v2u* y0 = (const GAS v2u*)(YB + (size_t)p0 * D) + lane; const GAS v2u* y1 = (const GAS v2u*)(YB + (size_t)p1 * D) + lane;
            f32x4 v[4]; v2u ya[4], yb[4]; float ss = 0.f;
#pragma unroll
            for (int j = 0; j < 4; ++j) { v[j] = XROW4(m, j); ya[j] = __builtin_nontemporal_load(y0 + 64 * j); yb[j] = __builtin_nontemporal_load(y1 + 64 * j); }
            { const int mn = (m + NGW < M) ? m + NGW : m; pn0 = POS[2 * mn]; pn1 = POS[2 * mn + 1]; gq0 = TOPG[2 * mn]; gq1 = TOPG[2 * mn + 1]; }
#pragma unroll
            for (int j = 0; j < 4; ++j) { const v2u a = ya[j], bq = yb[j];
                v[j].x += g0 * bflo(a.x) + g1 * bflo(bq.x); v[j].y += g0 * bfhi(a.x) + g1 * bfhi(bq.x); v[j].z += g0 * bflo(a.y) + g1 * bflo(bq.y); v[j].w += g0 * bfhi(a.y) + g1 * bfhi(bq.y);
                ss += (v[j].x * v[j].x + v[j].y * v[j].y) + (v[j].z * v[j].z + v[j].w * v[j].w); }
            const float rstd = 1.f / sqrtf(wave_sum(ss) * (1.f / D) + EPS);
            GAS f32x4* orow = (GAS f32x4*)(OUTF + (size_t)m * D) + lane;
#pragma unroll
            for (int j = 0; j < 4; ++j) __builtin_nontemporal_store(v[j] * rstd * gn[j], orow + 64 * j);
        }
    }
#undef IN
#undef BOTH
}

extern "C" void kernel_launch(void* const* d_in, const int* in_sizes, int n_in, void* d_out, int out_size, void* d_ws, size_t ws_size, hipStream_t stream) {
    static int grid = 0;
    if (grid == 0) {
        if (n_in != 19 || in_sizes[0] != M * D || out_size != M * D || ws_size < WS_END) { fprintf(stderr, "kernel_launch: unexpected shapes (n_in %d, in0 %d, out %d, ws %zu)\n", n_in, n_in > 0 ? in_sizes[0] : -1, out_size, ws_size); grid = -1; return; }
        int dev = 0, cus = 0, per_cu = 0;
        if (hipGetDevice(&dev) != hipSuccess || hipDeviceGetAttribute(&cus, hipDeviceAttributeMultiprocessorCount, dev) != hipSuccess) { grid = -1; return; }
        if (hipFuncSetAttribute((const void*)fwd_kernel, hipFuncAttributeMaxDynamicSharedMemorySize, LDS_BYTES) != hipSuccess) { fprintf(stderr, "kernel_launch: hipFuncSetAttribute failed\n"); grid = -1; return; }
        if (hipOccupancyMaxActiveBlocksPerMultiprocessor(&per_cu, (const void*)fwd_kernel, NTHR, LDS_BYTES) != hipSuccess || per_cu < 1) fprintf(stderr, "kernel_launch: occupancy query reports %d\n", per_cu);
        (void)hipGetLastError();
        grid = cus;
    }
    if (grid < 0) return;
    if (hipMemsetAsync((char*)d_ws + WS_CTL, 0, CTL_ZERO_BYTES, stream) != hipSuccess) return;
    Args a{};
    for (int i = 0; i < 19; ++i) a.in[i] = (const float*)d_in[i];
    a.out = (float*)d_out; a.ws = (unsigned char*)d_ws;
#if PER_PHASE_LAUNCH
    for (int p = 0; p < NPHASE; ++p) { a.ph_lo = p; a.ph_hi = p + 1; hipLaunchKernelGGL(fwd_kernel, dim3(grid), dim3(NTHR), LDS_BYTES, stream, a); }
#else
    a.ph_lo = 0; a.ph_hi = NPHASE; hipLaunchKernelGGL(fwd_kernel, dim3(grid), dim3(NTHR), LDS_BYTES, stream, a);
#endif
}
```

```cpp
#include <hip/hip_runtime.h>
#include <cstdio>
#include <cstdint>

#ifndef DIL_MFMA
#define DIL_MFMA 1
#endif
#ifndef FOX_MFMA
#define FOX_MFMA 1
#endif
#ifndef PER_PHASE_LAUNCH
#define PER_PHASE_LAUNCH 0
#endif

namespace pg8 {
#define PG8_LAS __attribute__((address_space(3)))
typedef unsigned short bf16_t;
typedef short bf16x8 __attribute__((ext_vector_type(8)));
typedef float f32x4 __attribute__((ext_vector_type(4)));
typedef unsigned u32x4 __attribute__((ext_vector_type(4)));
typedef int i32x4 __attribute__((ext_vector_type(4)));
typedef int i32x8 __attribute__((ext_vector_type(8)));
template <int MODE> struct AccSel { typedef f32x4 T; };
template <> struct AccSel<1> { typedef i32x4 T; };
constexpr int BM = 256, BK = 64, HALF = 128, HTB = HALF * BK * 2  , STAGE_BYTES = 8 * HTB, NXCD = 8, WGM = 8;

__host__ __device__ __forceinline__ int lds_byte(int r, int c) { const int st = (r >> 4) * 2 + (c >> 5), rr = r & 15, cc = c & 31, ob = rr * 64 + cc * 2; return st * 1024 + (ob ^ (((ob >> 9) & 1) << 5)); }
__host__ __device__ __forceinline__ void stage_rc(int b, int& R, int& C) { const int st = b / 1024, sb = b % 1024, swz = sb ^ (((sb >> 9) & 1) << 5); R = (st >> 1) * 16 + swz / 64; C = (st & 1) * 32 + (swz % 64) / 2; }
__host__ __device__ __forceinline__ int perm32(int rho) { const int n = rho >> 4, i = rho & 15; return 8 * (i >> 2) + 4 * n + (i & 3); }

struct Unit { int pm, pn, aux; };
struct Gemm { const bf16_t* A; const bf16_t* Bt; int M, N, K; };

struct StaticOrder {
    int nM, nN, nwg, G, c;
    __host__ __device__ void init(int M, int N, int G_, int c_) { nM = M / BM; nN = N / BM; nwg = nM * nN; G = G_; c = c_; }
    __host__ __device__ bool next(int i, Unit& u) const {
        const long L = (long)i * G + c; if (L >= nwg) return false;
        int wgid = (int)L; { const int q = nwg / NXCD, r = nwg % NXCD, xcd = wgid % NXCD, off = wgid / NXCD; wgid = (xcd < r ? xcd * (q + 1) : r * (q + 1) + (xcd - r) * q) + off; }
        const int nig = WGM * nN, gid = wgid / nig, fm = gid * WGM, gsz = (nM - fm) < WGM ? (nM - fm) : WGM;
        u.pm = fm + ((wgid % nig) % gsz); u.pn = (wgid % nig) / gsz; u.aux = u.pn; return true;
    }
};
struct MoeOrder {
    int p_lo, p_n, p_tail, nN, G, c, a_local; const int* pexp;
    unsigned nreg, R, ntail; int uni, fast, cm, cd, gd, e_fast; int xd, xpl, xpn, e_x0, e_x1;
    __device__ __forceinline__ void init() {
#define PG8_U(x) ((unsigned)__builtin_amdgcn_readfirstlane((int)(x)))
        nreg = (unsigned)p_n * (unsigned)nN; ntail = (unsigned)p_tail * (unsigned)nN; const unsigned qr = PG8_U(nreg / (unsigned)G), rr = PG8_U(nreg % (unsigned)G); R = qr + (rr != 0u);
        uni = (p_tail > 0 && rr != 0u); fast = (p_n > 0) && (PG8_U((unsigned)G % (unsigned)(p_n > 0 ? p_n : 1)) == 0u);
        cm = fast ? (int)PG8_U((unsigned)c % (unsigned)p_n) : 0; cd = fast ? (int)PG8_U((unsigned)c / (unsigned)p_n) : 0; gd = fast ? (int)PG8_U((unsigned)G / (unsigned)p_n) : 0;
        xd = (!uni && G == 256 && p_n == 128 && nN == 4 && a_local == 1);
        xpl = 8 * (c & 7) + (c >> 5); xpn = (c >> 3) & 3;
        e_x0 = xd ? __builtin_amdgcn_readfirstlane(pexp[p_lo + xpl]) : 0; e_x1 = xd ? __builtin_amdgcn_readfirstlane(pexp[p_lo + xpl + 64]) : 0;
        e_fast = fast ? __builtin_amdgcn_readfirstlane(pexp[p_lo + cm]) : 0;
    }
    __device__ __forceinline__ bool next(int i, Unit& u) const {
        int pl, pn; bool known = false; int ek = 0;
        if (xd && i < 2) { pl = xpl + 64 * i; pn = xpn; known = true; ek = i ? e_x1 : e_x0; }
        else if (uni) { const unsigned P = (unsigned)(p_n + p_tail); const unsigned L = (unsigned)i * (unsigned)G + (unsigned)c; if (L >= P * (unsigned)nN) return false; pl = (int)PG8_U(L % P); pn = (int)PG8_U(L / P); }
        else if ((unsigned)i < R) { const unsigned L = (unsigned)i * (unsigned)G + (unsigned)c; if (L >= nreg) return false;
            if (fast) { pl = cm; pn = i * gd + cd; known = true; ek = e_fast; } else { pl = (int)PG8_U(L % (unsigned)p_n); pn = (int)PG8_U(L / (unsigned)p_n); } }
        else { const unsigned L = ((unsigned)i - R) * (unsigned)G + (unsigned)c; if (L >= ntail) return false; pl = p_n + (int)PG8_U(L % (unsigned)p_tail); pn = (int)PG8_U(L / (unsigned)p_tail); }
        const int panel = p_lo + pl;
        int e; if (known) e = ek; else e = __builtin_amdgcn_readfirstlane(pexp[panel]);
        u.pm = __builtin_amdgcn_readfirstlane(a_local ? pl : panel); u.pn = __builtin_amdgcn_readfirstlane(e * nN + pn); u.aux = __builtin_amdgcn_readfirstlane(pn); return true;
    }
};

__device__ __forceinline__ unsigned cvt_pk_bf16(float lo, float hi) { unsigned r; asm volatile("v_cvt_pk_bf16_f32 %0, %1, %2" : "=v"(r) : "v"(lo), "v"(hi)); return r; }


struct EpiBf16S {
    static constexpr bool PERM = true, AFTER_DRAIN = false;
    bf16_t* O; int ldc; int nsc; float sc; const float* sa; const float* sb;
    static constexpr bool LDS_SCALES = true;
    __device__ __forceinline__ const float* row_scales(const Unit& u) const { return sa + (size_t)u.pm * BM; }
    __device__ __forceinline__ const float* col_scales(const Unit& u) const { return sb + (size_t)u.pn * BM; }
    __device__ __forceinline__ void operator()(const i32x4 (&acc)[2][2][4][2], const Unit& u, int wr, int wc, int fr, int fq, const PG8_LAS float* scl) const {
        const int row0 = u.pm * BM + wr * 64 + fr; const int col0 = u.aux * BM + wc * 32 + 8 * fq; const float s = (u.aux < nsc) ? sc : 1.f;
        float srv[2][4];
#pragma unroll
        for (int ai = 0; ai < 2; ++ai)
#pragma unroll
            for (int m = 0; m < 4; ++m) srv[ai][m] = scl[wr * 64 + fr + ai * HALF + m * 16];
#pragma unroll
        for (int bj = 0; bj < 2; ++bj) { const f32x4 sb0 = *(const PG8_LAS f32x4*)(scl + 256 + wc * 32 + 8 * fq + bj * HALF) * s, sb1 = *(const PG8_LAS f32x4*)(scl + 256 + wc * 32 + 8 * fq + bj * HALF + 4) * s;
#pragma unroll
            for (int ai = 0; ai < 2; ++ai)
#pragma unroll
                for (int m = 0; m < 4; ++m) { const int row = row0 + ai * HALF + m * 16; const float sr = srv[ai][m];
                    const f32x4 v0 = __builtin_convertvector(acc[ai][bj][m][0], f32x4) * sb0 * sr, v1 = __builtin_convertvector(acc[ai][bj][m][1], f32x4) * sb1 * sr;
                    u32x4 w; w.x = cvt_pk_bf16(v0[0], v0[1]); w.y = cvt_pk_bf16(v0[2], v0[3]); w.z = cvt_pk_bf16(v1[0], v1[1]); w.w = cvt_pk_bf16(v1[2], v1[3]);
                    *(u32x4*)(O + (size_t)row * ldc + col0 + bj * HALF) = w; } }
    }
};
__device__ __forceinline__ float xor16(float v, int fq) { auto r = __builtin_amdgcn_permlane16_swap(__builtin_bit_cast(unsigned, v), __builtin_bit_cast(unsigned, v), false, false); return __builtin_bit_cast(float, (fq & 1) ? r[0] : r[1]); }
struct EpiProjAB {
    static constexpr bool PERM = true, AFTER_DRAIN = false;
    bf16_t* O; int ldc; const float* rope; float qscale; const float* sa; const float* sb;
    static constexpr bool LDS_SCALES = true;
    __device__ __forceinline__ const float* row_scales(const Unit& u) const { return sa + (size_t)u.pm * BM; }
    __device__ __forceinline__ const float* col_scales(const Unit& u) const { return sb + (size_t)u.pn * BM; }
    __device__ __forceinline__ void operator()(const i32x4 (&acc)[2][2][4][2], const Unit& u, int wr, int wc, int fr, int fq, const PG8_LAS float* scl) const {
        const int row0 = u.pm * BM + wr * 64 + fr; const int col0 = u.aux * BM + wc * 32 + 8 * fq;
        const int tt = u.aux >> 1; const bool do_rope = tt < 2; const float s = (tt == 0 || tt == 3) ? qscale : 1.f;
        const bool rl = ((wc & 1) == 0) && (fq < 2);
        float srv[2][4];
#pragma unroll
        for (int ai = 0; ai < 2; ++ai)
#pragma unroll
            for (int m = 0; m < 4; ++m) srv[ai][m] = scl[wr * 64 + fr + ai * HALF + m * 16];
        f32x4 sbv[2][2];
#pragma unroll
        for (int bj = 0; bj < 2; ++bj) { sbv[bj][0] = *(const PG8_LAS f32x4*)(scl + 256 + wc * 32 + 8 * fq + bj * HALF) * s; sbv[bj][1] = *(const PG8_LAS f32x4*)(scl + 256 + wc * 32 + 8 * fq + bj * HALF + 4) * s; }
        if (!do_rope) {
#pragma unroll
            for (int bj = 0; bj < 2; ++bj)
#pragma unroll
                for (int ai = 0; ai < 2; ++ai)
#pragma unroll
                    for (int m = 0; m < 4; ++m) { const int row = row0 + ai * HALF + m * 16; const float sr = srv[ai][m];
                        const f32x4 v0 = __builtin_convertvector(acc[ai][bj][m][0], f32x4) * sbv[bj][0] * sr, v1 = __builtin_convertvector(acc[ai][bj][m][1], f32x4) * sbv[bj][1] * sr;
                        u32x4 w; w.x = cvt_pk_bf16(v0[0], v0[1]); w.y = cvt_pk_bf16(v0[2], v0[3]); w.z = cvt_pk_bf16(v1[0], v1[1]); w.w = cvt_pk_bf16(v1[2], v1[3]);
                        *(u32x4*)(O + (size_t)row * ldc + col0 + bj * HALF) = w; }
        } else {
            const float sg = (fq == 0) ? -1.f : 1.f;
            f32x4 rc[4];
            { const f32x4* rp = (const f32x4*)(rope + (size_t)row0 * 16); rc[0] = rp[0]; rc[1] = rp[1]; rc[2] = rp[2]; rc[3] = rp[3]; }
#pragma unroll
            for (int idx = 0; idx < 8; ++idx) { const int ai = idx >> 2, m = idx & 3; const int row = row0 + ai * HALF + m * 16; const float sr = srv[ai][m];
                f32x4 rn[4];
                if (idx + 1 < 8) { const int rown = row0 + ((idx + 1) >> 2) * HALF + ((idx + 1) & 3) * 16; const f32x4* rp = (const f32x4*)(rope + (size_t)rown * 16); rn[0] = rp[0]; rn[1] = rp[1]; rn[2] = rp[2]; rn[3] = rp[3]; }
                const f32x4 s0 = rc[2] * sg, s1 = rc[3] * sg;
#pragma unroll
                for (int bj = 0; bj < 2; ++bj) {
                    f32x4 v0 = __builtin_convertvector(acc[ai][bj][m][0], f32x4) * sbv[bj][0] * sr, v1 = __builtin_convertvector(acc[ai][bj][m][1], f32x4) * sbv[bj][1] * sr;
                    f32x4 p0, p1;
#pragma unroll
                    for (int c = 0; c < 4; ++c) { p0[c] = xor16(v0[c], fq); p1[c] = xor16(v1[c], fq); }
                    const f32x4 r0 = v0 * rc[0] + p0 * s0, r1 = v1 * rc[1] + p1 * s1;
#pragma unroll
                    for (int c = 0; c < 4; ++c) { v0[c] = rl ? r0[c] : v0[c]; v1[c] = rl ? r1[c] : v1[c]; }
                    u32x4 w; w.x = cvt_pk_bf16(v0[0], v0[1]); w.y = cvt_pk_bf16(v0[2], v0[3]); w.z = cvt_pk_bf16(v1[0], v1[1]); w.w = cvt_pk_bf16(v1[2], v1[3]);
                    *(u32x4*)(O + (size_t)row * ldc + col0 + bj * HALF) = w; }
                if (idx + 1 < 8) { rc[0] = rn[0]; rc[1] = rn[1]; rc[2] = rn[2]; rc[3] = rn[3]; } }
        }
    }
};
struct EpiSwiGLU {
    static constexpr bool PERM = true, AFTER_DRAIN = false;
    bf16_t* O; int ldc;
    __device__ __forceinline__ void operator()(const f32x4 (&acc)[2][2][4][2], const Unit& u, int wr, int wc, int fr, int fq) const {
        const int row0 = u.pm * BM + wr * 64 + fr; const int col0 = u.aux * HALF + wc * 32 + 8 * fq;
#pragma unroll
        for (int ai = 0; ai < 2; ++ai)
#pragma unroll
            for (int m = 0; m < 4; ++m) { bf16_t* rowp = O + (size_t)(row0 + ai * HALF + m * 16) * ldc + col0;
                float h[8];
#pragma unroll
                for (int n = 0; n < 2; ++n)
#pragma unroll
                    for (int c = 0; c < 4; ++c) { const float g = acc[ai][0][m][n][c], up = acc[ai][1][m][n][c];
                        h[4 * n + c] = g * up * __builtin_amdgcn_rcpf(1.f + __builtin_amdgcn_exp2f(-1.4426950408889634f * g)); }
                u32x4 w; w.x = cvt_pk_bf16(h[0], h[1]); w.y = cvt_pk_bf16(h[2], h[3]); w.z = cvt_pk_bf16(h[4], h[5]); w.w = cvt_pk_bf16(h[6], h[7]);
                *(u32x4*)rowp = w; }
    }
};
struct EpiSwiGLURows {
    static constexpr bool PERM = true, AFTER_DRAIN = false;
    bf16_t* O; int ldc; int p_lo;
    __device__ __forceinline__ void operator()(const f32x4 (&acc)[2][2][4][2], const Unit& u, int wr, int wc, int fr, int fq) const {
        Unit v = u; v.pm = u.pm - p_lo; EpiSwiGLU E{O, ldc}; E(acc, v, wr, wc, fr, fq); }
};
typedef float f32x2v __attribute__((ext_vector_type(2)));
__device__ __forceinline__ f32x2v pkmul(f32x2v a, f32x2v b) { f32x2v d; asm("v_pk_mul_f32 %0, %1, %2" : "=v"(d) : "v"(a), "v"(b)); return d; }
template <bool OUT_F8> struct EpiSwiGLUI8T {
    static constexpr bool PERM = true, AFTER_DRAIN = false;
    bf16_t* O; int ldc; int p_lo; const float* sa; const float* sb;
    static constexpr bool LDS_SCALES = true;
    __device__ __forceinline__ const float* row_scales(const Unit& u) const { return sa + (size_t)u.pm * BM; }
    __device__ __forceinline__ const float* col_scales(const Unit& u) const { return sb + (size_t)u.pn * BM; }
    __device__ __forceinline__ void operator()(const i32x4 (&acc)[2][2][4][2], const Unit& u, int wr, int wc, int fr, int fq, const PG8_LAS float* scl) const {
        const int rl = wr * 64 + fr; const int row0 = (u.pm - p_lo) * BM + rl; const int col0 = u.aux * HALF + wc * 32 + 8 * fq;
        const PG8_LAS float* sbp = scl + 256 + wc * 32 + 8 * fq; const PG8_LAS float* sap = scl + rl;
        f32x4 sg[2], su[2]; float sr[2][4];
#pragma unroll
        for (int n = 0; n < 2; ++n) { sg[n] = *(const PG8_LAS f32x4*)(sbp + 4 * n); su[n] = *(const PG8_LAS f32x4*)(sbp + HALF + 4 * n); }
        f32x2v sgE[2][2], cP[2][2];
#pragma unroll
        for (int n = 0; n < 2; ++n)
#pragma unroll
            for (int hh = 0; hh < 2; ++hh) { sgE[n][hh] = (f32x2v){sg[n][2 * hh], sg[n][2 * hh + 1]} * -1.4426950408889634f; cP[n][hh] = (f32x2v){sg[n][2 * hh] * su[n][2 * hh], sg[n][2 * hh + 1] * su[n][2 * hh + 1]} * (OUT_F8 ? 16.f : 1.f); }
#pragma unroll
        for (int ai = 0; ai < 2; ++ai)
#pragma unroll
            for (int m = 0; m < 4; ++m) sr[ai][m] = sap[ai * HALF + m * 16];
#pragma unroll
        for (int ai = 0; ai < 2; ++ai)
#pragma unroll
            for (int m = 0; m < 4; ++m) { const float r1 = sr[ai][m], rq = r1 * r1; const f32x2v r1p = {r1, r1}, rqp = {rq, rq}; float h[8];
#pragma unroll
                for (int n = 0; n < 2; ++n)
#pragma unroll
                    for (int hh = 0; hh < 2; ++hh) { const f32x2v ag = {(float)acc[ai][0][m][n][2 * hh], (float)acc[ai][0][m][n][2 * hh + 1]}, au = {(float)acc[ai][1][m][n][2 * hh], (float)acc[ai][1][m][n][2 * hh + 1]};
                        const f32x2v e2 = pkmul(ag, pkmul(sgE[n][hh], r1p)), num = pkmul(pkmul(ag, au), pkmul(cP[n][hh], rqp));
                        const f32x2v d2 = (f32x2v){__builtin_amdgcn_exp2f(e2.x), __builtin_amdgcn_exp2f(e2.y)} + 1.f;
                        const f32x2v hv = num * (f32x2v){__builtin_amdgcn_rcpf(d2.x), __builtin_amdgcn_rcpf(d2.y)};
                        h[4 * n + 2 * hh] = hv.x; h[4 * n + 2 * hh + 1] = hv.y; }
                if constexpr (OUT_F8) {
#pragma unroll
                    for (int c = 0; c < 8; ++c) h[c] = __builtin_amdgcn_fmed3f(h[c], -448.f, 448.f);
                    int w0 = 0, w1 = 0; w0 = __builtin_amdgcn_cvt_pk_fp8_f32(h[0], h[1], w0, false); w0 = __builtin_amdgcn_cvt_pk_fp8_f32(h[2], h[3], w0, true);
                    w1 = __builtin_amdgcn_cvt_pk_fp8_f32(h[4], h[5], w1, false); w1 = __builtin_amdgcn_cvt_pk_fp8_f32(h[6], h[7], w1, true);
                    typedef int i32x2 __attribute__((ext_vector_type(2)));
                    *(i32x2*)((unsigned char*)O + (size_t)(row0 + ai * HALF + m * 16) * ldc + col0) = (i32x2){w0, w1};
                } else {
                    u32x4 w; w.x = cvt_pk_bf16(h[0], h[1]); w.y = cvt_pk_bf16(h[2], h[3]); w.z = cvt_pk_bf16(h[4], h[5]); w.w = cvt_pk_bf16(h[6], h[7]);
                    *(u32x4*)(O + (size_t)(row0 + ai * HALF + m * 16) * ldc + col0) = w; } }
    }
};
typedef EpiSwiGLUI8T<false> EpiSwiGLUI8;
typedef EpiSwiGLUI8T<true> EpiSwiGLUI8F8;
struct EpiBf16RowsF8 {
    static constexpr bool PERM = true, AFTER_DRAIN = false;
    unsigned char* O; int ldc; int row_off; const unsigned* wmax;
    __device__ __forceinline__ void operator()(const f32x4 (&acc)[2][2][4][2], const Unit& u, int wr, int wc, int fr, int fq) const {
        const int row0 = row_off + u.pm * BM + wr * 64 + fr; const int col0 = u.aux * BM + wc * 32 + 8 * fq;
        const float sc16 = __uint_as_float(wmax[u.pn >> 2]) * (16.f / 4096.f);
#pragma unroll
        for (int ai = 0; ai < 2; ++ai)
#pragma unroll
            for (int m = 0; m < 4; ++m) { unsigned char* rowp = O + (size_t)(row0 + ai * HALF + m * 16) * ldc + col0;
#pragma unroll
                for (int bj = 0; bj < 2; ++bj) { const f32x4 v0 = acc[ai][bj][m][0] * sc16, v1 = acc[ai][bj][m][1] * sc16;
                    int w0 = 0, w1 = 0;
                    w0 = __builtin_amdgcn_cvt_pk_fp8_f32(__builtin_amdgcn_fmed3f(v0[0], -448.f, 448.f), __builtin_amdgcn_fmed3f(v0[1], -448.f, 448.f), w0, false);
                    w0 = __builtin_amdgcn_cvt_pk_fp8_f32(__builtin_amdgcn_fmed3f(v0[2], -448.f, 448.f), __builtin_amdgcn_fmed3f(v0[3], -448.f, 448.f), w0, true);
                    w1 = __builtin_amdgcn_cvt_pk_fp8_f32(__builtin_amdgcn_fmed3f(v1[0], -448.f, 448.f), __builtin_amdgcn_fmed3f(v1[1], -448.f, 448.f), w1, false);
                    w1 = __builtin_amdgcn_cvt_pk_fp8_f32(__builtin_amdgcn_fmed3f(v1[2], -448.f, 448.f), __builtin_amdgcn_fmed3f(v1[3], -448.f, 448.f), w1, true);
                    typedef int i32x2y __attribute__((ext_vector_type(2)));
                    *(i32x2y*)(rowp + bj * HALF) = (i32x2y){w0, w1}; } }
    }
};
struct EpiResidual {
    static constexpr bool PERM = false, AFTER_DRAIN = false;
    const float* base; float* out; int ldc;
    __device__ __forceinline__ void operator()(const f32x4 (&acc)[2][2][4][2], const Unit& u, int wr, int wc, int fr, int fq) const {
        const int row0 = u.pm * BM + wr * 64 + fr; const int col0 = u.aux * BM + wc * 32 + 4 * fq;
#pragma unroll
        for (int ai = 0; ai < 2; ++ai) {
            f32x4 bb[4][2][2];
#pragma unroll
            for (int m = 0; m < 4; ++m) { const size_t off = (size_t)(row0 + ai * HALF + m * 16) * ldc + col0;
#pragma unroll
                for (int bj = 0; bj < 2; ++bj)
#pragma unroll
                    for (int n = 0; n < 2; ++n) bb[m][bj][n] = *(const f32x4*)(base + off + bj * HALF + n * 16); }
#pragma unroll
            for (int m = 0; m < 4; ++m) { const size_t off = (size_t)(row0 + ai * HALF + m * 16) * ldc + col0;
#pragma unroll
                for (int bj = 0; bj < 2; ++bj)
#pragma unroll
                    for (int n = 0; n < 2; ++n) *(f32x4*)(out + off + bj * HALF + n * 16) = bb[m][bj][n] + acc[ai][bj][m][n]; }
        }
    }
};
template <bool BASE_F32> struct EpiResidualB {
    static constexpr bool PERM = true, AFTER_DRAIN = false;
    const void* base; bf16_t* out;
    __device__ __forceinline__ void operator()(const f32x4 (&acc)[2][2][4][2], const Unit& u, int wr, int wc, int fr, int fq) const {
        const int row0 = u.pm * BM + wr * 64 + fr; const int col0 = u.aux * BM + wc * 32 + 8 * fq;
        static_assert(!BASE_F32, "the stream is bf16 from the first phase on");
        u32x4 raw[2][4][2];
#pragma unroll
        for (int ai = 0; ai < 2; ++ai)
#pragma unroll
            for (int m = 0; m < 4; ++m) { const size_t off = (size_t)(row0 + ai * HALF + m * 16) * 1024 + col0;
#pragma unroll
                for (int bj = 0; bj < 2; ++bj) raw[ai][m][bj] = *(const u32x4*)((const bf16_t*)base + off + bj * HALF); }
#pragma unroll
        for (int ai = 0; ai < 2; ++ai)
#pragma unroll
            for (int m = 0; m < 4; ++m) { const size_t off = (size_t)(row0 + ai * HALF + m * 16) * 1024 + col0;
#pragma unroll
                for (int bj = 0; bj < 2; ++bj) { const u32x4 r = raw[ai][m][bj];
                    const f32x4 v0 = (f32x4){__uint_as_float(r.x << 16), __uint_as_float(r.x & 0xffff0000u), __uint_as_float(r.y << 16), __uint_as_float(r.y & 0xffff0000u)} + acc[ai][bj][m][0];
                    const f32x4 v1 = (f32x4){__uint_as_float(r.z << 16), __uint_as_float(r.z & 0xffff0000u), __uint_as_float(r.w << 16), __uint_as_float(r.w & 0xffff0000u)} + acc[ai][bj][m][1];
                    u32x4 w; w.x = cvt_pk_bf16(v0[0], v0[1]); w.y = cvt_pk_bf16(v0[2], v0[3]); w.z = cvt_pk_bf16(v1[0], v1[1]); w.w = cvt_pk_bf16(v1[2], v1[3]);
                    *(u32x4*)(out + off + bj * HALF) = w; } }
    }
};
struct EpiBf16Rows {
    static constexpr bool PERM = true, AFTER_DRAIN = false;
    bf16_t* O; int ldc; int row_off;
    __device__ __forceinline__ void operator()(const f32x4 (&acc)[2][2][4][2], const Unit& u, int wr, int wc, int fr, int fq) const {
        const int row0 = row_off + u.pm * BM + wr * 64 + fr; const int col0 = u.aux * BM + wc * 32 + 8 * fq;
#pragma unroll
        for (int ai = 0; ai < 2; ++ai)
#pragma unroll
            for (int m = 0; m < 4; ++m) { bf16_t* rowp = O + (size_t)(row0 + ai * HALF + m * 16) * ldc + col0;
#pragma unroll
                for (int bj = 0; bj < 2; ++bj) { const f32x4 v0 = acc[ai][bj][m][0], v1 = acc[ai][bj][m][1];
                    u32x4 w; w.x = cvt_pk_bf16(v0[0], v0[1]); w.y = cvt_pk_bf16(v0[2], v0[3]); w.z = cvt_pk_bf16(v1[0], v1[1]); w.w = cvt_pk_bf16(v1[2], v1[3]);
                    *(u32x4*)(rowp + bj * HALF) = w; } }
    }
};

template <class Epi, class Sched, bool ALIGN_EPI, bool GATHER, int MODE = 0>
__device__ __forceinline__ void gemm_phase(PG8_LAS unsigned char* lds, const Gemm g, const Sched& S, const Epi& E, const int* rowmap, int wave_) {
    int lane; asm volatile("v_mbcnt_lo_u32_b32 %0, -1, 0\n\tv_mbcnt_hi_u32_b32 %0, -1, %0" : "=v"(lane));
    const int wid = wave_, tid = wid * 64 + lane, wr = wid >> 2, wc = wid & 3, fr = lane & 15, fq = lane >> 4;
    typedef typename AccSel<MODE>::T AccT;
    const int K = MODE ? g.K / 2 : g.K, nt = K / BK;
    unsigned voffB[2]; int Rr[2], Cc[2];
#pragma unroll
    for (int i = 0; i < 2; ++i) { int R, C; stage_rc(tid * 16 + i * 8192, R, C); Rr[i] = R; Cc[i] = C; const int Rb = Epi::PERM ? ((R & ~31) + perm32(R & 31)) : R;
        voffB[i] = (unsigned)(Rb * K + C) * 2u; }
    const size_t kstep = (size_t)(BK * 2);
    const size_t hstep = (size_t)HALF * K * 2;
    const size_t tstep = 2 * hstep;
    const unsigned ldsw = (unsigned)wid * 1024u;
    const int aoff = lds_byte(wr * 64 + fr, fq * 8), boff = lds_byte(wc * 32 + fr, fq * 8);
#define PG8_SA(b, h) (((b) * 2 + (h)) * HTB)
#define PG8_SB(b, h) ((4 + (b) * 2 + (h)) * HTB)
#define PG8_STAGE(bufoff, gbase, voff) do { _Pragma("unroll") for (int _i = 0; _i < 2; ++_i) \
        __builtin_amdgcn_global_load_lds((const unsigned*)((const char*)(gbase) + (voff)[_i]), (PG8_LAS unsigned*)(lds + (bufoff) + ldsw + _i * 8192), 16, 0, 0); } while (0)
#define PG8_LD16(off) (*(const PG8_LAS i32x4*)(lds + (off)))
#define PG8_LDA(dst, b, h) do { if constexpr (MODE == 2) { _Pragma("unroll") for (int m = 0; m < 4; ++m) dst##8[m] = __builtin_shufflevector(PG8_LD16(PG8_SA(b, h) + aoff + m * 2048), PG8_LD16(PG8_SA(b, h) + aoff + m * 2048 + 1024), 0, 1, 2, 3, 4, 5, 6, 7); } \
        else { _Pragma("unroll") for (int m = 0; m < 4; ++m) _Pragma("unroll") for (int k = 0; k < 2; ++k) dst[m][k] = *(const PG8_LAS bf16x8*)(lds + PG8_SA(b, h) + aoff + m * 2048 + k * 1024); } } while (0)
#define PG8_LDB(dst, b, h) do { if constexpr (MODE == 2) { _Pragma("unroll") for (int n = 0; n < 2; ++n) dst##8[n] = __builtin_shufflevector(PG8_LD16(PG8_SB(b, h) + boff + n * 2048), PG8_LD16(PG8_SB(b, h) + boff + n * 2048 + 1024), 0, 1, 2, 3, 4, 5, 6, 7); } \
        else { _Pragma("unroll") for (int n = 0; n < 2; ++n) _Pragma("unroll") for (int k = 0; k < 2; ++k) dst[n][k] = *(const PG8_LAS bf16x8*)(lds + PG8_SB(b, h) + boff + n * 2048 + k * 1024); } } while (0)
#define PG8_MMA(ai, bj, At, Bt) do { __builtin_amdgcn_s_setprio(1); _Pragma("unroll") for (int m = 0; m < 4; ++m) _Pragma("unroll") for (int n = 0; n < 2; ++n) { \
        if constexpr (MODE == 2) { asm volatile("v_mfma_scale_f32_16x16x128_f8f6f4 %0, %1, %2, %0, %3, %3 op_sel_hi:[0,0,0]" : "+v"(acc[ai][bj][m][n]) : "v"(Bt##8[n]), "v"(At##8[m]), "v"(sc127_)); } \
        else { _Pragma("unroll") for (int k = 0; k < 2; ++k) { \
          if constexpr (MODE == 1) acc[ai][bj][m][n] = __builtin_bit_cast(AccT, __builtin_amdgcn_mfma_i32_16x16x64_i8(__builtin_bit_cast(i32x4, Bt[n][k]), __builtin_bit_cast(i32x4, At[m][k]), __builtin_bit_cast(i32x4, acc[ai][bj][m][n]), 0, 0, 0)); \
          else acc[ai][bj][m][n] = __builtin_bit_cast(AccT, __builtin_amdgcn_mfma_f32_16x16x32_bf16(Bt[n][k], At[m][k], __builtin_bit_cast(f32x4, acc[ai][bj][m][n]), 0, 0, 0)); } } } __builtin_amdgcn_s_setprio(0); } while (0)
#define PG8_WAIT_V(n) asm volatile("s_waitcnt vmcnt(" #n ")" ::: "memory")
#define PG8_WAIT_L(n) asm volatile("s_waitcnt lgkmcnt(" #n ")" ::: "memory")
#define PG8_BAR __builtin_amdgcn_s_barrier()
#define PG8_SCHED __builtin_amdgcn_sched_barrier(0)
#define PG8_LOAD_VA(dst, u) do { _Pragma("unroll") for (int _h = 0; _h < 2; ++_h) _Pragma("unroll") for (int _i = 0; _i < 2; ++_i) \
        dst[_h][_i] = GATHER ? ((unsigned)rowmap[(u).pm * BM + _h * HALF + Rr[_i]] * (unsigned)(K * 2) + (unsigned)Cc[_i] * 2u) : ((unsigned)((_h * HALF + Rr[_i]) * K + Cc[_i]) * 2u); } while (0)
    Unit cur, nxt; int ui = 0;
    if (!S.next(0, cur)) return;
    AccT acc[2][2][4][2];
#pragma unroll
    for (int a = 0; a < 2; ++a)
#pragma unroll
        for (int b = 0; b < 2; ++b)
#pragma unroll
            for (int m = 0; m < 4; ++m)
#pragma unroll
                for (int n = 0; n < 2; ++n) acc[a][b][m][n] = __builtin_bit_cast(AccT, (f32x4){0.f, 0.f, 0.f, 0.f});
    PG8_LAS float* const sclb = (PG8_LAS float*)(lds + STAGE_BYTES + 4096);
#define PG8_SCALE_DMA(U, PAR) do { if constexpr (MODE == 1) { const float* src_ = (tid < 256) ? E.row_scales(U) + tid : E.col_scales(U) + (tid - 256); \
        __builtin_amdgcn_global_load_lds((const unsigned*)src_, (PG8_LAS unsigned*)(sclb + (PAR) * 512 + wid * 64), 4, 0, 0); } } while (0)
    int sc127_ = 0x7f7f7f7f; asm volatile("" : "+v"(sc127_));
    bf16x8 At[4][2], B0[2][2], B1[2][2]; i32x8 At8[4], B08[2], B18[2];
    unsigned vAc[2][2], vAn[2][2];
    PG8_LOAD_VA(vAc, cur);
    const char* cA = GATHER ? (const char*)g.A : (const char*)g.A + (size_t)cur.pm * tstep; const char* cB = (const char*)g.Bt + (size_t)cur.pn * tstep;
    PG8_SCALE_DMA(cur, 0);
    PG8_STAGE(PG8_SB(0, 0), cB, voffB); PG8_STAGE(PG8_SB(0, 1), cB + hstep, voffB); PG8_STAGE(PG8_SA(0, 0), cA, vAc[0]); PG8_STAGE(PG8_SA(0, 1), cA, vAc[1]);
    if (wr == 1) PG8_BAR;
    PG8_WAIT_V(2); PG8_BAR;
    PG8_STAGE(PG8_SB(1, 0), cB + kstep, voffB); PG8_STAGE(PG8_SA(1, 0), cA + kstep, vAc[0]); PG8_STAGE(PG8_SB(1, 1), cB + hstep + kstep, voffB);
    PG8_WAIT_V(6); PG8_BAR;
    for (;;) {
        const bool has_next = S.next(ui + 1, nxt);
        if constexpr (GATHER) { if (has_next && nxt.pm != cur.pm) { PG8_LOAD_VA(vAn, nxt); } else {
#pragma unroll
            for (int _h = 0; _h < 2; ++_h)
#pragma unroll
                for (int _i = 0; _i < 2; ++_i) vAn[_h][_i] = vAc[_h][_i]; } }
        const char* nA = GATHER ? (const char*)g.A : (has_next ? (const char*)g.A + (size_t)nxt.pm * tstep : cA); const char* nB = has_next ? (const char*)g.Bt + (size_t)nxt.pn * tstep : cB;
        for (int t = 0; t < nt; t += 2) {
            const bool last = (t == nt - 2);
            const char* a1 = cA + (size_t)(t + 1) * kstep;
            const char* a2 = last ? nA : cA + (size_t)(t + 2) * kstep; const char* b2 = last ? nB : cB + (size_t)(t + 2) * kstep;
            const char* a3 = a2 + kstep; const char* b3 = b2 + kstep;
            unsigned o2[2][2];
#pragma unroll
            for (int _h = 0; _h < 2; ++_h)
#pragma unroll
                for (int _i = 0; _i < 2; ++_i) o2[_h][_i] = (GATHER && last) ? vAn[_h][_i] : vAc[_h][_i];
            PG8_LDB(B0, 0, 0); PG8_LDB(B1, 0, 1); PG8_SCHED; PG8_LDA(At, 0, 0); PG8_STAGE(PG8_SA(1, 1), a1, vAc[1]);
            PG8_WAIT_V(8); PG8_WAIT_L(0); PG8_BAR; PG8_MMA(0, 0, At, B0); PG8_MMA(0, 1, At, B1); PG8_BAR; PG8_SCHED;
            PG8_LDA(At, 0, 1); PG8_STAGE(PG8_SB(0, 0), b2, voffB); PG8_STAGE(PG8_SB(0, 1), b2 + hstep, voffB); PG8_STAGE(PG8_SA(0, 0), a2, o2[0]);
            PG8_WAIT_V(8); PG8_WAIT_L(0); PG8_BAR; PG8_MMA(1, 0, At, B0); PG8_MMA(1, 1, At, B1); PG8_BAR; PG8_SCHED;
            PG8_LDB(B0, 1, 0); PG8_LDB(B1, 1, 1); PG8_SCHED; PG8_LDA(At, 1, 0); PG8_STAGE(PG8_SA(0, 1), a2, o2[1]);
            PG8_WAIT_V(8); PG8_WAIT_L(0); PG8_BAR; PG8_MMA(0, 0, At, B0); PG8_MMA(0, 1, At, B1); PG8_BAR; PG8_SCHED;
            PG8_LDA(At, 1, 1); PG8_STAGE(PG8_SB(1, 0), b3, voffB); PG8_STAGE(PG8_SB(1, 1), b3 + hstep, voffB); PG8_STAGE(PG8_SA(1, 0), a3, o2[0]);
            PG8_WAIT_V(8); PG8_WAIT_L(0); PG8_BAR; PG8_MMA(1, 0, At, B0); PG8_MMA(1, 1, At, B1); PG8_BAR; PG8_SCHED;
        }
        if constexpr (ALIGN_EPI) { if (wr == 0) PG8_BAR; }
        if constexpr (MODE == 2) asm volatile("s_nop 15\n\ts_nop 15" ::: "memory");
        { Unit ue = cur; int fr_e = fr, fq_e = fq; asm volatile("" : "+s"(ue.pm), "+s"(ue.pn), "+s"(ue.aux), "+v"(fr_e), "+v"(fq_e));
          if constexpr (MODE == 1) E(acc, ue, wr, wc, fr_e, fq_e, sclb + (ui & 1) * 512); else E(acc, ue, wr, wc, fr_e, fq_e); }
        if (!has_next) break;
#pragma unroll
        for (int a = 0; a < 2; ++a)
#pragma unroll
            for (int b = 0; b < 2; ++b)
#pragma unroll
                for (int m = 0; m < 4; ++m)
#pragma unroll
                    for (int n = 0; n < 2; ++n) { typedef double f64x2 __attribute__((ext_vector_type(2))); double z0, z1;
                        asm("v_mov_b64 %0, 0" : "=v"(z0)); asm("v_mov_b64 %0, 0" : "=v"(z1)); acc[a][b][m][n] = __builtin_bit_cast(AccT, (f64x2){z0, z1}); }
        cur = nxt; cA = nA; cB = nB; ++ui;
        PG8_SCALE_DMA(cur, ui & 1);
        if constexpr (GATHER) {
#pragma unroll
        for (int _h = 0; _h < 2; ++_h)
#pragma unroll
            for (int _i = 0; _i < 2; ++_i) vAc[_h][_i] = vAn[_h][_i]; }
        if constexpr (ALIGN_EPI) { if (wr == 1) PG8_BAR; }
    }
    PG8_WAIT_V(0);
    if constexpr (!ALIGN_EPI) { if (wr == 0) PG8_BAR; }
    PG8_BAR;
#undef PG8_SA
#undef PG8_SB
#undef PG8_STAGE
#undef PG8_LDA
#undef PG8_LDB
#undef PG8_MMA
#undef PG8_WAIT_V
#undef PG8_WAIT_L
#undef PG8_BAR
#undef PG8_SCHED
#undef PG8_LOAD_VA
#undef PG8_SCALE_DMA
}
}

constexpr int NWAVES = 8, NTHR = NWAVES * 64;
constexpr int BATCH = 32, SEQ = 2048, D = 1024, M = BATCH * SEQ;
constexpr int NAB = 3072, IN_AB = 3080, HD = 64, NH = 8;
constexpr int DFF = 2816, NGU = 2 * DFF;
constexpr int NC = 4096, HK = 128;
constexpr int NEXP = 8, DFFE = 3584, NGUE = 2 * DFFE;
constexpr float EPS = 1e-6f;
constexpr float LOG2E = 1.4426950408889634f;
constexpr float QSCALE_AB = 0.125f * LOG2E;
constexpr float QSCALE_C = 0.08838834764831845f;
constexpr int PCHUNK = 128, NPMAX = 520, NMCH = 4;
constexpr int NPHASE = 13 + 2 * NMCH + 1;

constexpr size_t MiB = 1u << 20;
constexpr size_t WS_CTL = 0, CTL_ZERO_BYTES = 64 * 1024;
constexpr size_t WS_ROPE = 1 * MiB;
constexpr size_t WS_LOGF = 5 * MiB;
constexpr size_t WS_CUM = 7 * MiB;
constexpr size_t WS_TOPI = 9 * MiB;
constexpr size_t WS_TOPG = 9 * MiB + 256 * 1024;
constexpr size_t WS_RANK = 9 * MiB + 768 * 1024;
constexpr size_t WS_POS = 10 * MiB + 256 * 1024;
constexpr size_t WS_ROWMAP = 10 * MiB + 768 * 1024;
constexpr size_t WS_CNT = 11 * MiB + 512 * 1024;
constexpr size_t WS_META = 11 * MiB + 768 * 1024;
constexpr size_t WS_SA = 12 * MiB;
constexpr size_t WS_SAS = 12 * MiB + 512 * 1024;
constexpr size_t WS_SBD = 13 * MiB + 256 * 1024;
constexpr size_t WS_SBM = 13 * MiB + 512 * 1024;
constexpr size_t WS_SBAB = 13 * MiB + 768 * 1024;
constexpr size_t WS_SBC = 13 * MiB + 832 * 1024;
constexpr size_t WS_WINAB = 16 * MiB, WS_WOUTAB = 22 * MiB, WS_WGU = 24 * MiB, WS_WDOWN = 35 * MiB, WS_WINC = 41 * MiB, WS_WOUTC = 49 * MiB, WS_WGUM = 51 * MiB, WS_WDOWNM = 163 * MiB;
constexpr size_t WS_XN = 224 * MiB;
constexpr size_t WS_BIG = 352 * MiB;
constexpr size_t WS_Y = 580 * MiB;
constexpr size_t WS_END = 1024 * MiB;
static_assert(WS_WDOWNM + (size_t)NEXP * D * DFFE * 2 <= WS_XN && WS_BIG + (size_t)M * NC * 2 <= WS_END && WS_BIG + (size_t)(PCHUNK + 8) * 256 * DFFE <= WS_Y && WS_Y + (size_t)NPMAX * 256 * D * 2 <= WS_END, "ws map");
constexpr int CW_TMO = 0, CW_BAR = 4096, CW_WMAX = 8192;

constexpr int RING_OFF = 0, RING_BYTES = 131072;
constexpr int LDSCTL_OFF = RING_BYTES, MISC_OFF = LDSCTL_OFF + 320;
constexpr int LDS_BYTES = 147456;

#define GAS __attribute__((address_space(1)))
#define LAS __attribute__((address_space(3)))
typedef unsigned short bf16;
typedef unsigned v4u __attribute__((ext_vector_type(4)));
typedef unsigned v2u __attribute__((ext_vector_type(2)));
typedef float f32x4 __attribute__((ext_vector_type(4)));
typedef GAS unsigned gu32;
#define RLX_AGENT __ATOMIC_RELAXED, __HIP_MEMORY_SCOPE_AGENT
#define LDS_WAIT() asm volatile("s_waitcnt lgkmcnt(0)" ::: "memory")
#define VM_WAIT() asm volatile("s_waitcnt vmcnt(0)" ::: "memory")
__device__ __forceinline__ unsigned f2bf(float f) { unsigned u = __builtin_bit_cast(unsigned, f); return (u + 0x7fffu + ((u >> 16) & 1u)) >> 16; }
__device__ __forceinline__ unsigned pk2(float lo, float hi) { return f2bf(lo) | (f2bf(hi) << 16); }
__device__ __forceinline__ float bflo(unsigned u) { return __uint_as_float(u << 16); }
__device__ __forceinline__ float bfhi(unsigned u) { return __uint_as_float(u & 0xffff0000u); }
__device__ __forceinline__ float bf1(bf16 h) { return __uint_as_float((unsigned)h << 16); }

#define XB_TMO      128
#define XB_XCNT(j)  (256  + 64 * (j))
#define XB_XSUB(j)  (1280 + 64 * (j))
#define XB_XGEN(j)  (2304 + 64 * (j))
#define XB_TOP      3328
#define XB_TOPGEN   3392
#define XCD_BAR_WORDS 3456
#define XB_SPIN_CAP (1u << 22)
__device__ __forceinline__ unsigned xb_ld(unsigned* p)              { return __hip_atomic_load(p, __ATOMIC_RELAXED, __HIP_MEMORY_SCOPE_AGENT); }
__device__ __forceinline__ unsigned xb_add(unsigned* p, unsigned v) { return __hip_atomic_fetch_add(p, v, __ATOMIC_RELAXED, __HIP_MEMORY_SCOPE_AGENT); }
__device__ __forceinline__ unsigned xb_xcc_id() { return (unsigned)__builtin_amdgcn_s_getreg((3 << 11) | 20) & 0xFu; }
#define XB_SPIN(cond, bar) do { unsigned _sp = 0; while (cond) { __builtin_amdgcn_s_sleep(1); \
    if ((++_sp & 255u) == 0u) { if (xb_ld(&(bar)[XB_TMO])) break; if (_sp > XB_SPIN_CAP) { atomicAdd(&(bar)[XB_TMO], 1u); break; } } } } while (0)
struct XcdBarrier { unsigned* bar; unsigned x; volatile LAS unsigned* st; };
__device__ __forceinline__ XcdBarrier xcd_barrier_post(unsigned* bar, volatile LAS unsigned* st, bool t0) {
    XcdBarrier b; b.bar = bar; b.x = xb_xcc_id(); b.st = st;
    if (t0) (void)xb_add(&bar[XB_XCNT(b.x)], 1u);
    return b;
}
__device__ __forceinline__ void xcd_barrier_complete(unsigned* bar, unsigned x, unsigned& nloc, unsigned& nx) {
    const unsigned G = gridDim.x * gridDim.y * gridDim.z;
    unsigned sum, cnt, mine, sp = 0u;
    for (;;) {
        sum = 0u; cnt = 0u; mine = 0u;
#pragma unroll
        for (unsigned j = 0; j < 16; ++j) { const unsigned c = xb_ld(&bar[XB_XCNT(j)]); sum += c; cnt += (c > 0u) ? 1u : 0u; mine = (j == x) ? c : mine; }
        if (sum == G) break;
        __builtin_amdgcn_s_sleep(1);
        if ((++sp & 255u) == 0u) { if (xb_ld(&bar[XB_TMO])) break; if (sp > XB_SPIN_CAP) { atomicAdd(&bar[XB_TMO], 1u); break; } }
    }
    nloc = mine > 0u ? mine : 1u; nx = cnt > 0u ? cnt : 1u;
}
__device__ __forceinline__ void xcd_barrier(const XcdBarrier& b, bool t0) {
    asm volatile("s_waitcnt vmcnt(0)" ::: "memory");
    __syncthreads();
    if (t0) {
        unsigned* bar = b.bar;
        __builtin_amdgcn_s_waitcnt(0);
        unsigned nloc = b.st[0], nx = b.st[1];
        if (nloc == 0u) { xcd_barrier_complete(bar, b.x, nloc, nx); b.st[0] = nloc; b.st[1] = nx; }
        const unsigned old = xb_add(&bar[XB_XSUB(b.x)], 1u);
        const unsigned gen = old / nloc;
        if (old + 1u == (gen + 1u) * nloc) {
            __builtin_amdgcn_fence(__ATOMIC_RELEASE, "agent");
            asm volatile("s_waitcnt vmcnt(0)" ::: "memory");
            const unsigned og = xb_add(&bar[XB_TOP], 1u);
            const unsigned tg = og / nx;
            if (og + 1u == (tg + 1u) * nx) xb_add(&bar[XB_TOPGEN], 1u);
            else XB_SPIN(xb_ld(&bar[XB_TOPGEN]) == tg, bar);
            __builtin_amdgcn_fence(__ATOMIC_ACQUIRE, "agent");
            xb_add(&bar[XB_XGEN(b.x)], 1u);
            asm volatile("s_waitcnt vmcnt(0)" ::: "memory");
        } else {
            XB_SPIN(xb_ld(&bar[XB_XGEN(b.x)]) == gen, bar);
            __builtin_amdgcn_fence(__ATOMIC_ACQUIRE, "agent");
            asm volatile("s_waitcnt vmcnt(0)" ::: "memory");
        }
    }
    __syncthreads();
}

__device__ __forceinline__ int lane_id() { int l; asm volatile("v_mbcnt_lo_u32_b32 %0, -1, 0\n\tv_mbcnt_hi_u32_b32 %0, -1, %0" : "=v"(l)); return l; }
template <int CTRL> __device__ __forceinline__ float dpp_f(float v) { return __int_as_float(__builtin_amdgcn_update_dpp(0, __float_as_int(v), CTRL, 0xf, 0xf, true)); }
__device__ __forceinline__ float wave_sum(float v) {
    v += dpp_f<0xB1>(v); v += dpp_f<0x4E>(v); v += dpp_f<0x141>(v); v += dpp_f<0x140>(v);
    { auto r = __builtin_amdgcn_permlane16_swap(__float_as_uint(v), __float_as_uint(v), false, false); v = __uint_as_float(r[0]) + __uint_as_float(r[1]); }
    { auto r = __builtin_amdgcn_permlane32_swap(__float_as_uint(v), __float_as_uint(v), false, false); v = __uint_as_float(r[0]) + __uint_as_float(r[1]); }
    return v;
}
__device__ __forceinline__ float wave_max(float v) {
    v = fmaxf(v, dpp_f<0xB1>(v)); v = fmaxf(v, dpp_f<0x4E>(v)); v = fmaxf(v, dpp_f<0x141>(v)); v = fmaxf(v, dpp_f<0x140>(v));
    { auto r = __builtin_amdgcn_permlane16_swap(__float_as_uint(v), __float_as_uint(v), false, false); v = fmaxf(__uint_as_float(r[0]), __uint_as_float(r[1])); }
    { auto r = __builtin_amdgcn_permlane32_swap(__float_as_uint(v), __float_as_uint(v), false, false); v = fmaxf(__uint_as_float(r[0]), __uint_as_float(r[1])); }
    return v;
}
__device__ __forceinline__ float sigmoidf_(float z) { return 1.f / (1.f + __expf(-z)); }
__device__ __forceinline__ float sigm_fast(float z) { return __builtin_amdgcn_rcpf(1.f + __builtin_amdgcn_exp2f(-1.4426950408889634f * z)); }

__device__ __forceinline__ void transpose_item(const float* W, int ldw, int K, bf16* WT, int k0, int n0, int dst_row0, LAS float* scr, int lane) {
#pragma unroll 16
    for (int i = 0; i < 32; ++i) { const int kk = 2 * i + (lane >> 5); scr[kk * 33 + (lane & 31)] = W[(size_t)(k0 + kk) * ldw + n0 + (lane & 31)]; }
    LDS_WAIT(); asm volatile("" ::: "memory");
    const int c = lane & 7;
#pragma unroll
    for (int j = 0; j < 4; ++j) { const int n = (lane >> 3) + 8 * j; const LAS float* s = scr + (8 * c) * 33 + n;
        v4u o; o.x = pk2(s[0 * 33], s[1 * 33]); o.y = pk2(s[2 * 33], s[3 * 33]); o.z = pk2(s[4 * 33], s[5 * 33]); o.w = pk2(s[6 * 33], s[7 * 33]);
        *(GAS v4u*)(WT + (size_t)(dst_row0 + n) * K + k0 + 8 * c) = o; }
    LDS_WAIT(); asm volatile("" ::: "memory");
}


typedef float f32x16 __attribute__((ext_vector_type(16)));
typedef short s16x4 __attribute__((ext_vector_type(4)));
typedef short v4i16_t __attribute__((ext_vector_type(4)));
typedef short bf16x8v __attribute__((ext_vector_type(8)));
typedef float f32x2_t __attribute__((ext_vector_type(2))); typedef __bf16 bf16x2_t __attribute__((ext_vector_type(2)));
__device__ __forceinline__ unsigned cvtpk_s(float lo, float hi) { f32x2_t v = {lo, hi}; bf16x2_t b = __builtin_convertvector(v, bf16x2_t); return __builtin_bit_cast(unsigned, b); }
__device__ __forceinline__ s16x4 vtr(const LAS unsigned char* p) { return __builtin_bit_cast(s16x4, __builtin_amdgcn_ds_read_tr16_b64_v4i16((LAS v4i16_t*)p)); }
__device__ __forceinline__ float max3f(float a, float b, float c) { float r; asm("v_max3_f32 %0, %1, %2, %3" : "=v"(r) : "v"(a), "v"(b), "v"(c)); return r; }
__device__ __forceinline__ float max2f(float a, float b) { float r; asm("v_max_f32_e32 %0, %1, %2" : "=v"(r) : "v"(a), "v"(b)); return r; }
typedef float f32x16r __attribute__((ext_vector_type(16)));
__device__ __forceinline__ float rowmax16(f32x16r& s) {
    asm volatile("s_nop 15\n\ts_nop 7" : "+v"(s));
    float a = max3f(s[0], s[1], s[2]), b = max3f(s[3], s[4], s[5]);
    a = max3f(a, s[6], s[7]); b = max3f(b, s[8], s[9]); a = max3f(a, s[10], s[11]); b = max3f(b, s[12], s[13]); a = max3f(a, s[14], s[15]);
    float m = max2f(a, b);
    auto rr = __builtin_amdgcn_permlane32_swap(__float_as_uint(m), __float_as_uint(m), false, false);
    return max2f(__uint_as_float(rr[0]), __uint_as_float(rr[1]));
}
__device__ __forceinline__ float halfmax(float m) { auto rr = __builtin_amdgcn_permlane32_swap(__float_as_uint(m), __float_as_uint(m), false, false); return fmaxf(__uint_as_float(rr[0]), __uint_as_float(rr[1])); }
__device__ __forceinline__ float halfsum(float m) { auto rr = __builtin_amdgcn_permlane32_swap(__float_as_uint(m), __float_as_uint(m), false, false); return __uint_as_float(rr[0]) + __uint_as_float(rr[1]); }
struct FlashSt { float m, l; f32x16 o0, o1; };
template <bool HAS_BIAS>
__device__ __forceinline__ void flash_tiles(FlashSt& st, const bf16x8v (&qf)[4], const bf16* Kb, const bf16* Vb, int tok0, int stride, int ntiles, int tstep, int LQ, int LK0, int W,
                                            const LAS float* cumL, LAS unsigned char* vbuf, int lane) {
    const int r32 = lane & 31, hi = lane >> 5, vj = lane >> 3, vc = lane & 7;
    LAS unsigned char* const vw = vbuf + (vc >> 2) * 2048 + vj * 64 + (vc & 3) * 16;
    const LAS unsigned char* const vr = vbuf + ((lane >> 4) & 1) * 32 + (lane & 3) * 8 + (4 * hi + ((lane & 15) >> 2)) * 64;
    bf16x8v kf[4]; v4u vch[4];
#define FL_LOAD(KT, KF, VCH) do { const int t0_ = tok0 + (KT) * tstep; int tk_ = t0_ + stride * r32; tk_ = tk_ < 0 ? 0 : tk_; const bf16* kp_ = Kb + (size_t)tk_ * NAB + 8 * hi; \
        _Pragma("unroll") for (int d0 = 0; d0 < 4; ++d0) KF[d0] = *(const bf16x8v*)(kp_ + 16 * d0); \
        _Pragma("unroll") for (int i = 0; i < 4; ++i) { int tv_ = t0_ + stride * (vj + 8 * i); tv_ = tv_ < 0 ? 0 : tv_; VCH[i] = *(const v4u*)(Vb + (size_t)tv_ * NAB + 8 * vc); } } while (0)
    FL_LOAD(0, kf, vch);
    for (int kt = 0; kt < ntiles; ++kt) {
        bf16x8v kfn[4]; v4u vchn[4];
        { const int ktn = (kt + 1 < ntiles) ? kt + 1 : kt; FL_LOAD(ktn, kfn, vchn); }
#pragma unroll
        for (int i = 0; i < 4; ++i) *(LAS v4u*)(vw + i * 512) = vch[i];
        asm volatile("s_waitcnt lgkmcnt(0)" ::: "memory");
        f32x16 s; const int LKt = LK0 + 32 * kt;
        if (HAS_BIAS) { const LAS float* cp = cumL + tok0 + kt * tstep + 4 * hi;
#pragma unroll
            for (int g = 0; g < 4; ++g) { const f32x4 c4 = *(const LAS f32x4*)(cp + 8 * g);
#pragma unroll
                for (int c = 0; c < 4; ++c) s[4 * g + c] = -c4[c]; } }
        else {
#pragma unroll
            for (int r = 0; r < 16; ++r) s[r] = 0.f; }
        { const int e = LQ - LKt - 4 * hi; int lo = e - W; const int lo3 = -LKt - 4 * hi; lo = lo > lo3 ? lo : lo3;
          if (!__all(lo <= 0 && e >= 27)) {
#pragma unroll
              for (int r = 0; r < 16; ++r) { const int jr = (r & 3) + 8 * (r >> 2); if (jr < lo || jr > e) s[r] = -INFINITY; } } }
        asm volatile("" : "+v"(s));
#pragma unroll
        for (int d0 = 0; d0 < 4; ++d0) s = __builtin_amdgcn_mfma_f32_32x32x16_bf16(kf[d0], qf[d0], s, 0, 0, 0);
        const float mloc = rowmax16(s);
        const float mnew = fmaxf(st.m, mloc); const float alpha = __builtin_amdgcn_exp2f(st.m - mnew); st.m = mnew;
        float lsum = 0.f;
#pragma unroll
        for (int r = 0; r < 16; ++r) { s[r] = __builtin_amdgcn_exp2f(s[r] - mnew); lsum += s[r]; }
        st.l = st.l * alpha + lsum;
        if (__any(alpha != 1.f)) { st.o0 = st.o0 * alpha; st.o1 = st.o1 * alpha; }
        v4u pw0, pw1;
        pw0.x = cvtpk_s(s[0], s[1]); pw0.y = cvtpk_s(s[2], s[3]); pw0.z = cvtpk_s(s[4], s[5]); pw0.w = cvtpk_s(s[6], s[7]);
        pw1.x = cvtpk_s(s[8], s[9]); pw1.y = cvtpk_s(s[10], s[11]); pw1.z = cvtpk_s(s[12], s[13]); pw1.w = cvtpk_s(s[14], s[15]);
        const bf16x8v pf0 = __builtin_bit_cast(bf16x8v, pw0), pf1 = __builtin_bit_cast(bf16x8v, pw1);
#define FL_VF(D0, KS) ({ const s16x4 lo_ = vtr(vr + (D0) * 2048 + (KS) * 1024), hi_ = vtr(vr + (D0) * 2048 + (KS) * 1024 + 512); (bf16x8v){lo_[0], lo_[1], lo_[2], lo_[3], hi_[0], hi_[1], hi_[2], hi_[3]}; })
        { const bf16x8v a00 = FL_VF(0, 0), a01 = FL_VF(0, 1), a10 = FL_VF(1, 0), a11 = FL_VF(1, 1);
          st.o0 = __builtin_amdgcn_mfma_f32_32x32x16_bf16(a00, pf0, st.o0, 0, 0, 0); st.o0 = __builtin_amdgcn_mfma_f32_32x32x16_bf16(a01, pf1, st.o0, 0, 0, 0);
          st.o1 = __builtin_amdgcn_mfma_f32_32x32x16_bf16(a10, pf0, st.o1, 0, 0, 0); st.o1 = __builtin_amdgcn_mfma_f32_32x32x16_bf16(a11, pf1, st.o1, 0, 0, 0); }
#undef FL_VF
        asm volatile("s_waitcnt lgkmcnt(0)" ::: "memory");
#pragma unroll
        for (int d0 = 0; d0 < 4; ++d0) kf[d0] = kfn[d0];
#pragma unroll
        for (int i = 0; i < 4; ++i) vch[i] = vchn[i];
    }
#undef FL_LOAD
}
__device__ __forceinline__ void flash_tiles2(FlashSt (&st)[2], const bf16x8v (&qf)[2][4], const bf16* Kb, const bf16* Vb, int tok0, int stride, int ntiles, int tstep, const int (&LQ)[2], const int (&LQb)[2], int LK0, int W,
                                             LAS unsigned char* vbuf, int lane) {
    const int r32 = lane & 31, hi = lane >> 5, vj = lane >> 3, vc = lane & 7;
    LAS unsigned char* const vw = vbuf + (vc >> 2) * 2048 + vj * 64 + (vc & 3) * 16;
    const LAS unsigned char* const vr = vbuf + ((lane >> 4) & 1) * 32 + (lane & 3) * 8 + (4 * hi + ((lane & 15) >> 2)) * 64;
    bf16x8v kf[4]; v4u vch[4];
#define FL_LOAD(KT, KF, VCH) do { const int t0_ = tok0 + (KT) * tstep; int tk_ = t0_ + stride * r32; tk_ = tk_ < 0 ? 0 : tk_; const bf16* kp_ = Kb + (size_t)tk_ * NAB + 8 * hi; \
        _Pragma("unroll") for (int d0 = 0; d0 < 4; ++d0) KF[d0] = *(const bf16x8v*)(kp_ + 16 * d0); \
        _Pragma("unroll") for (int i = 0; i < 4; ++i) { int tv_ = t0_ + stride * (vj + 8 * i); tv_ = tv_ < 0 ? 0 : tv_; VCH[i] = *(const v4u*)(Vb + (size_t)tv_ * NAB + 8 * vc); } } while (0)
    FL_LOAD(0, kf, vch);
    for (int kt = 0; kt < ntiles; ++kt) {
        bf16x8v kfn[4]; v4u vchn[4];
        { const int ktn = (kt + 1 < ntiles) ? kt + 1 : kt; FL_LOAD(ktn, kfn, vchn); }
#pragma unroll
        for (int i = 0; i < 4; ++i) *(LAS v4u*)(vw + i * 512) = vch[i];
        asm volatile("s_waitcnt lgkmcnt(0)" ::: "memory");
        const int LKt = LK0 + 32 * kt;
#define FL_VF(D0, KS) ({ const s16x4 lo_ = vtr(vr + (D0) * 2048 + (KS) * 1024), hi_ = vtr(vr + (D0) * 2048 + (KS) * 1024 + 512); (bf16x8v){lo_[0], lo_[1], lo_[2], lo_[3], hi_[0], hi_[1], hi_[2], hi_[3]}; })
        const bf16x8v a00 = FL_VF(0, 0), a01 = FL_VF(0, 1), a10 = FL_VF(1, 0), a11 = FL_VF(1, 1);
#undef FL_VF
#pragma unroll
        for (int q = 0; q < 2; ++q) if (LKt <= LQb[q] + 31 && LKt + 31 >= LQb[q] - W && LKt + 31 >= 0) {
            f32x16 s;
#pragma unroll
            for (int r = 0; r < 16; ++r) s[r] = 0.f;
            { const int e = LQ[q] - LKt - 4 * hi; int lo = e - W; const int lo3 = -LKt - 4 * hi; lo = lo > lo3 ? lo : lo3;
              if (!__all(lo <= 0 && e >= 27)) {
#pragma unroll
                  for (int r = 0; r < 16; ++r) { const int jr = (r & 3) + 8 * (r >> 2); if (jr < lo || jr > e) s[r] = -INFINITY; } } }
            asm volatile("" : "+v"(s));
#pragma unroll
            for (int d0 = 0; d0 < 4; ++d0) s = __builtin_amdgcn_mfma_f32_32x32x16_bf16(kf[d0], qf[q][d0], s, 0, 0, 0);
            const float mloc = rowmax16(s);
            const float mnew = fmaxf(st[q].m, mloc); const float alpha = __builtin_amdgcn_exp2f(st[q].m - mnew); st[q].m = mnew;
            float lsum = 0.f;
#pragma unroll
            for (int r = 0; r < 16; ++r) { s[r] = __builtin_amdgcn_exp2f(s[r] - mnew); lsum += s[r]; }
            st[q].l = st[q].l * alpha + lsum;
            if (__any(alpha != 1.f)) { st[q].o0 = st[q].o0 * alpha; st[q].o1 = st[q].o1 * alpha; }
            v4u pw0, pw1;
            pw0.x = cvtpk_s(s[0], s[1]); pw0.y = cvtpk_s(s[2], s[3]); pw0.z = cvtpk_s(s[4], s[5]); pw0.w = cvtpk_s(s[6], s[7]);
            pw1.x = cvtpk_s(s[8], s[9]); pw1.y = cvtpk_s(s[10], s[11]); pw1.z = cvtpk_s(s[12], s[13]); pw1.w = cvtpk_s(s[14], s[15]);
            const bf16x8v pf0 = __builtin_bit_cast(bf16x8v, pw0), pf1 = __builtin_bit_cast(bf16x8v, pw1);
            st[q].o0 = __builtin_amdgcn_mfma_f32_32x32x16_bf16(a00, pf0, st[q].o0, 0, 0, 0); st[q].o0 = __builtin_amdgcn_mfma_f32_32x32x16_bf16(a01, pf1, st[q].o0, 0, 0, 0);
            st[q].o1 = __builtin_amdgcn_mfma_f32_32x32x16_bf16(a10, pf0, st[q].o1, 0, 0, 0); st[q].o1 = __builtin_amdgcn_mfma_f32_32x32x16_bf16(a11, pf1, st[q].o1, 0, 0, 0);
        }
        asm volatile("s_waitcnt lgkmcnt(0)" ::: "memory");
#pragma unroll
        for (int d0 = 0; d0 < 4; ++d0) kf[d0] = kfn[d0];
#pragma unroll
        for (int i = 0; i < 4; ++i) vch[i] = vchn[i];
    }
#undef FL_LOAD
}
__device__ __forceinline__ void flash_init(FlashSt& st) { st.m = -1e30f; st.l = 0.f;
#pragma unroll
    for (int r = 0; r < 16; ++r) { st.o0[r] = 0.f; st.o1[r] = 0.f; } }
__device__ __forceinline__ void flash_store(const FlashSt& st, bf16* orow, int lane) {
    const int hi = lane >> 5; const float inv = 1.f / halfsum(st.l);
    bf16* const dst = orow + 8 * hi;
#pragma unroll
    for (int kk = 0; kk < 4; ++kk) {
        const int g0 = (2 * kk) & 3, g1 = (2 * kk + 1) & 3;
        unsigned ax, ay, bx, by;
        if (kk < 2) { ax = cvtpk_s(st.o0[4 * g0] * inv, st.o0[4 * g0 + 1] * inv); ay = cvtpk_s(st.o0[4 * g0 + 2] * inv, st.o0[4 * g0 + 3] * inv);
                      bx = cvtpk_s(st.o0[4 * g1] * inv, st.o0[4 * g1 + 1] * inv); by = cvtpk_s(st.o0[4 * g1 + 2] * inv, st.o0[4 * g1 + 3] * inv); }
        else        { ax = cvtpk_s(st.o1[4 * g0] * inv, st.o1[4 * g0 + 1] * inv); ay = cvtpk_s(st.o1[4 * g0 + 2] * inv, st.o1[4 * g0 + 3] * inv);
                      bx = cvtpk_s(st.o1[4 * g1] * inv, st.o1[4 * g1 + 1] * inv); by = cvtpk_s(st.o1[4 * g1 + 2] * inv, st.o1[4 * g1 + 3] * inv); }
        { auto r = __builtin_amdgcn_permlane32_swap(ax, bx, false, false); ax = r[0]; bx = r[1]; }
        { auto r = __builtin_amdgcn_permlane32_swap(ay, by, false, false); ay = r[0]; by = r[1]; }
        v4u w; w.x = ax; w.y = ay; w.z = bx; w.w = by;
        *(v4u*)(dst + 16 * kk) = w; }
}

__device__ __forceinline__ void quant_item(const float* W, int ldw, int K, signed char* WQ, float* sb, int n0, int dst_row0, LAS float* scr, int lane) {
    float cmax = 0.f;
#pragma nounroll
    for (int k0 = 0; k0 < K; k0 += 64) {
#pragma unroll
        for (int i = 0; i < 32; ++i) { const int kk = 2 * i + (lane >> 5); cmax = fmaxf(cmax, fabsf(W[(size_t)(k0 + kk) * ldw + n0 + (lane & 31)])); } }
    cmax = halfmax(cmax);
    const float sc = cmax > 0.f ? cmax * (1.f / 127.f) : 1.f;
    LAS float* scl = scr + 64 * 33;
    if (lane < 32) { scl[lane] = 1.f / sc; sb[dst_row0 + lane] = sc; }
    LDS_WAIT(); asm volatile("" ::: "memory");
    const int c = lane & 7;
#pragma nounroll
    for (int k0 = 0; k0 < K; k0 += 64) {
        LAS float* scr_ = scr; asm volatile("" : "+v"(scr_));
#pragma unroll 16
        for (int i = 0; i < 32; ++i) { const int kk = 2 * i + (lane >> 5); scr_[kk * 33 + (lane & 31)] = W[(size_t)(k0 + kk) * ldw + n0 + (lane & 31)]; }
        LDS_WAIT(); asm volatile("" ::: "memory");
#pragma unroll
        for (int j = 0; j < 4; ++j) { const int n = (lane >> 3) + 8 * j; const LAS float* sp = scr_ + (8 * c) * 33 + n; const float is = scl[n];
            int q[8];
#pragma unroll
            for (int e = 0; e < 8; ++e) q[e] = (int)rintf(sp[e * 33] * is) & 0xff;
            v2u o; o.x = (unsigned)q[0] | ((unsigned)q[1] << 8) | ((unsigned)q[2] << 16) | ((unsigned)q[3] << 24); o.y = (unsigned)q[4] | ((unsigned)q[5] << 8) | ((unsigned)q[6] << 16) | ((unsigned)q[7] << 24);
            *(GAS v2u*)(WQ + (size_t)(dst_row0 + n) * K + k0 + 8 * c) = o; }
        LDS_WAIT(); asm volatile("" ::: "memory");
    }
}


__device__ __forceinline__ void st_save(const FlashSt& st, LAS float* row) {
    *(LAS f32x2_t*)row = (f32x2_t){st.m, st.l};
#pragma unroll
    for (int g = 0; g < 4; ++g) { *(LAS f32x4*)(row + 4 + 4 * g) = (f32x4){st.o0[4 * g], st.o0[4 * g + 1], st.o0[4 * g + 2], st.o0[4 * g + 3]};
        *(LAS f32x4*)(row + 20 + 4 * g) = (f32x4){st.o1[4 * g], st.o1[4 * g + 1], st.o1[4 * g + 2], st.o1[4 * g + 3]}; }
}
__device__ __forceinline__ void st_load(FlashSt& st, const LAS float* row) {
    const f32x2_t ml = *(const LAS f32x2_t*)row; st.m = ml.x; st.l = ml.y;
#pragma unroll
    for (int g = 0; g < 4; ++g) { const f32x4 a = *(const LAS f32x4*)(row + 4 + 4 * g), b = *(const LAS f32x4*)(row + 20 + 4 * g);
#pragma unroll
        for (int c = 0; c < 4; ++c) { st.o0[4 * g + c] = a[c]; st.o1[4 * g + c] = b[c]; } }
}
__device__ __forceinline__ void st_save16(const FlashSt& st, LAS unsigned char* row) {
#pragma unroll
    for (int g = 0; g < 2; ++g) { v4u a, b;
        a.x = cvtpk_s(st.o0[8 * g], st.o0[8 * g + 1]); a.y = cvtpk_s(st.o0[8 * g + 2], st.o0[8 * g + 3]); a.z = cvtpk_s(st.o0[8 * g + 4], st.o0[8 * g + 5]); a.w = cvtpk_s(st.o0[8 * g + 6], st.o0[8 * g + 7]);
        b.x = cvtpk_s(st.o1[8 * g], st.o1[8 * g + 1]); b.y = cvtpk_s(st.o1[8 * g + 2], st.o1[8 * g + 3]); b.z = cvtpk_s(st.o1[8 * g + 4], st.o1[8 * g + 5]); b.w = cvtpk_s(st.o1[8 * g + 6], st.o1[8 * g + 7]);
        *(LAS v4u*)(row + 16 * g) = a; *(LAS v4u*)(row + 32 + 16 * g) = b; }
    *(LAS f32x2_t*)(row + 64) = (f32x2_t){st.m, st.l};
}
__device__ __forceinline__ void st_load16(FlashSt& st, const LAS unsigned char* row) {
#pragma unroll
    for (int g = 0; g < 2; ++g) { const v4u a = *(const LAS v4u*)(row + 16 * g), b = *(const LAS v4u*)(row + 32 + 16 * g);
        st.o0[8 * g] = bflo(a.x); st.o0[8 * g + 1] = bfhi(a.x); st.o0[8 * g + 2] = bflo(a.y); st.o0[8 * g + 3] = bfhi(a.y); st.o0[8 * g + 4] = bflo(a.z); st.o0[8 * g + 5] = bfhi(a.z); st.o0[8 * g + 6] = bflo(a.w); st.o0[8 * g + 7] = bfhi(a.w);
        st.o1[8 * g] = bflo(b.x); st.o1[8 * g + 1] = bfhi(b.x); st.o1[8 * g + 2] = bflo(b.y); st.o1[8 * g + 3] = bfhi(b.y); st.o1[8 * g + 4] = bflo(b.z); st.o1[8 * g + 5] = bfhi(b.z); st.o1[8 * g + 6] = bflo(b.w); st.o1[8 * g + 7] = bfhi(b.w); }
    const f32x2_t ml = *(const LAS f32x2_t*)(row + 64); st.m = ml.x; st.l = ml.y;
}
template <bool HAS_BIAS, int NQ, int SUB = 1>
__device__ __forceinline__ void coop_block(FlashSt (&st)[NQ], const bf16x8v (&qf)[NQ][4], const bf16* Kb, const bf16* Vb, int T0, int NT, const int (&LQ)[NQ], int W, const int (&qlast)[NQ], const int (&kmin)[NQ], const LAS float* cumL, LAS unsigned char* stage, int wave, int lane) {
    const int r32 = lane & 31, h5 = lane >> 5;
    const int drow = 8 * wave + (lane >> 3);
    const bf16* const ksrc = Kb + 8 * ((lane & 7) ^ (lane >> 3));
    const bf16* const vsrc = Vb + 8 * ((lane & 7) ^ (((lane >> 4) & 1) << 2));
    const LAS unsigned char* const kr = stage + r32 * 128;
    const int trq_ = (lane & 15) >> 2;
    const LAS unsigned char* const vr = stage + 8192 + (4 * h5 + trq_) * 128 + ((lane >> 4) & 1) * 32 + (lane & 3) * 8;
#define CB_DMA(T, B) do { _Pragma("unroll") for (int sb_ = 0; sb_ < SUB; ++sb_) { int rk_ = T0 + 64 * SUB * (T) + 64 * sb_ + drow; rk_ = rk_ < 0 ? 0 : rk_; \
        __builtin_amdgcn_global_load_lds((const unsigned*)(ksrc + (size_t)rk_ * NAB), (LAS unsigned*)(stage + ((B) * SUB + sb_) * 16384 + wave * 1024), 16, 0, 0); \
        __builtin_amdgcn_global_load_lds((const unsigned*)(vsrc + (size_t)rk_ * NAB), (LAS unsigned*)(stage + ((B) * SUB + sb_) * 16384 + 8192 + wave * 1024), 16, 0, 0); } } while (0)
    CB_DMA(NT - 1, 0);
    for (int tt = 0; tt < NT; ++tt) { const int t = NT - 1 - tt;
        asm volatile("s_waitcnt vmcnt(0)" ::: "memory"); __builtin_amdgcn_s_barrier(); asm volatile("" ::: "memory");
        if (tt + 1 < NT) CB_DMA(t - 1, (tt + 1) & 1);
        const int bo0 = (tt & 1) * SUB * 16384;
#pragma unroll
        for (int kq = 0; kq < 2 * SUB; ++kq) { const int kh2 = 2 * SUB - 1 - kq, kh = kh2 & 1, bo = bo0 + (kh2 >> 1) * 16384; const int k0 = T0 + 64 * SUB * t + 32 * kh2;
            bool need[NQ]; bool any = false;
#pragma unroll
            for (int q = 0; q < NQ; ++q) { need[q] = (k0 <= qlast[q]) && (k0 + 31 >= kmin[q]); any = any || need[q]; }
            if (any) {
                bf16x8v kf[4];
#pragma unroll
                for (int d0 = 0; d0 < 4; ++d0) kf[d0] = *(const LAS bf16x8v*)(kr + bo + kh * 4096 + (((2 * d0 + h5) ^ (r32 & 7)) << 4));
                f32x4 cb[4];
                if (HAS_BIAS) { const LAS float* cp = cumL + k0 + 4 * h5;
#pragma unroll
                    for (int g = 0; g < 4; ++g) cb[g] = *(const LAS f32x4*)(cp + 8 * g); }
                const LAS unsigned char* vb = vr + bo + kh * 4096;
#define FX_VF(DH, KS) ({ const s16x4 lo_ = vtr(vb + (((DH) ^ (trq_ >> 1)) * 64) + (KS) * 2048), hi_ = vtr(vb + (((DH) ^ (trq_ >> 1)) * 64) + (KS) * 2048 + 1024); (bf16x8v){lo_[0], lo_[1], lo_[2], lo_[3], hi_[0], hi_[1], hi_[2], hi_[3]}; })
                const bf16x8v a00 = FX_VF(0, 0), a01 = FX_VF(0, 1), a10 = FX_VF(1, 0), a11 = FX_VF(1, 1);
#undef FX_VF
#pragma unroll
                for (int q = 0; q < NQ; ++q) if (need[q]) {
                    f32x16 s;
                    if (HAS_BIAS) {
#pragma unroll
                        for (int g = 0; g < 4; ++g)
#pragma unroll
                            for (int c = 0; c < 4; ++c) s[4 * g + c] = cb[g][c]; }
                    else {
#pragma unroll
                        for (int r = 0; r < 16; ++r) s[r] = 0.f; }
                    { const int e = LQ[q] - k0 - 4 * h5; int lo = e - W; const int lo3 = -k0 - 4 * h5; lo = lo > lo3 ? lo : lo3;
                      if (!__all(lo <= 0 && e >= 27)) {
#pragma unroll
                          for (int r = 0; r < 16; ++r) { const int jr = (r & 3) + 8 * (r >> 2); if (jr < lo || jr > e) s[r] = -INFINITY; } } }
                    asm volatile("" : "+v"(s));
#pragma unroll
                    for (int d0 = 0; d0 < 4; ++d0) s = __builtin_amdgcn_mfma_f32_32x32x16_bf16(kf[d0], qf[q][d0], s, 0, 0, 0);
                    const float mloc = rowmax16(s);
                    const float mnew = fmaxf(st[q].m, mloc); const float alpha = __builtin_amdgcn_exp2f(st[q].m - mnew); st[q].m = mnew;
                    f32x2_t ls2 = {0.f, 0.f}; const f32x2_t mn2 = {mnew, mnew};
#pragma unroll
                    for (int r = 0; r < 16; r += 2) { f32x2_t d2 = (f32x2_t){s[r], s[r + 1]} - mn2; d2.x = __builtin_amdgcn_exp2f(d2.x); d2.y = __builtin_amdgcn_exp2f(d2.y); ls2 += d2; s[r] = d2.x; s[r + 1] = d2.y; }
                    st[q].l = st[q].l * alpha + (ls2.x + ls2.y);
                    if (__any(alpha != 1.f)) { st[q].o0 = st[q].o0 * alpha; st[q].o1 = st[q].o1 * alpha; }
                    v4u pw0, pw1;
                    pw0.x = cvtpk_s(s[0], s[1]); pw0.y = cvtpk_s(s[2], s[3]); pw0.z = cvtpk_s(s[4], s[5]); pw0.w = cvtpk_s(s[6], s[7]);
                    pw1.x = cvtpk_s(s[8], s[9]); pw1.y = cvtpk_s(s[10], s[11]); pw1.z = cvtpk_s(s[12], s[13]); pw1.w = cvtpk_s(s[14], s[15]);
                    const bf16x8v pf0 = __builtin_bit_cast(bf16x8v, pw0), pf1 = __builtin_bit_cast(bf16x8v, pw1);
                    st[q].o0 = __builtin_amdgcn_mfma_f32_32x32x16_bf16(a00, pf0, st[q].o0, 0, 0, 0); st[q].o0 = __builtin_amdgcn_mfma_f32_32x32x16_bf16(a01, pf1, st[q].o0, 0, 0, 0);
                    st[q].o1 = __builtin_amdgcn_mfma_f32_32x32x16_bf16(a10, pf0, st[q].o1, 0, 0, 0); st[q].o1 = __builtin_amdgcn_mfma_f32_32x32x16_bf16(a11, pf1, st[q].o1, 0, 0, 0);
                }
            }
        }
        asm volatile("s_waitcnt lgkmcnt(0)" ::: "memory");
    }
    __builtin_amdgcn_s_barrier(); asm volatile("" ::: "memory");
#undef CB_DMA
}

__device__ __forceinline__ void absmax_item(const float* W, int ldw, int k0, int n0, unsigned* wm, int lane) {
    float mx = 0.f;
#pragma unroll
    for (int i = 0; i < 32; ++i) { const int kk = 2 * i + (lane >> 5); mx = fmaxf(mx, fabsf(W[(size_t)(k0 + kk) * ldw + n0 + (lane & 31)])); }
    mx = wave_max(mx);
    if (lane == 0) atomicMax(wm, __float_as_uint(mx));
}
__device__ __forceinline__ void transpose_item_f8(const float* W, int ldw, int K, unsigned char* WT, int k0, int n0, int dst_row0, float sc, LAS float* scr, int lane) {
#pragma unroll 16
    for (int i = 0; i < 32; ++i) { const int kk = 2 * i + (lane >> 5); scr[kk * 33 + (lane & 31)] = W[(size_t)(k0 + kk) * ldw + n0 + (lane & 31)]; }
    LDS_WAIT(); asm volatile("" ::: "memory");
    const int c = lane & 7;
#pragma unroll
    for (int j = 0; j < 4; ++j) { const int n = (lane >> 3) + 8 * j; const LAS float* sp = scr + (8 * c) * 33 + n; float v[8];
#pragma unroll
        for (int e = 0; e < 8; ++e) v[e] = __builtin_amdgcn_fmed3f(sp[e * 33] * sc, -448.f, 448.f);
        int w0 = 0, w1 = 0;
        w0 = __builtin_amdgcn_cvt_pk_fp8_f32(v[0], v[1], w0, false); w0 = __builtin_amdgcn_cvt_pk_fp8_f32(v[2], v[3], w0, true);
        w1 = __builtin_amdgcn_cvt_pk_fp8_f32(v[4], v[5], w1, false); w1 = __builtin_amdgcn_cvt_pk_fp8_f32(v[6], v[7], w1, true);
        v2u o; o.x = (unsigned)w0; o.y = (unsigned)w1;
        *(GAS v2u*)(WT + (size_t)(dst_row0 + n) * K + k0 + 8 * c) = o; }
    LDS_WAIT(); asm volatile("" ::: "memory");
}

#define NORM_Q_ROW(v, rstd, gn, m) do { float am_ = 0.f; \
        _Pragma("unroll") for (int j = 0; j < 4; ++j) { v[j] = v[j] * rstd * gn[j]; am_ = fmaxf(am_, fmaxf(fmaxf(fabsf(v[j].x), fabsf(v[j].y)), fmaxf(fabsf(v[j].z), fabsf(v[j].w)))); } \
        am_ = wave_max(am_); \
        const float sc_ = am_ > 0.f ? am_ * (1.f / 127.f) : 1.f, is_ = 1.f / sc_; if (lane == 0) SA[m] = sc_; \
        GAS unsigned* q4_ = (GAS unsigned*)(XQ + (size_t)(m) * D) + lane; \
        _Pragma("unroll") for (int j = 0; j < 4; ++j) q4_[64 * j] = ((unsigned)((int)rintf(v[j].x * is_) & 0xff)) | ((unsigned)((int)rintf(v[j].y * is_) & 0xff) << 8) | ((unsigned)((int)rintf(v[j].z * is_) & 0xff) << 16) | ((unsigned)((int)rintf(v[j].w * is_) & 0xff) << 24); } while (0)
#define XROW4(MROW, J) ({ const v2u u_ = *(const GAS v2u*)(X + (size_t)(MROW) * D + 4 * lane + 256 * (J)); (f32x4){bflo(u_.x), bfhi(u_.x), bflo(u_.y), bfhi(u_.y)}; })
#define NORM_Q_PHASE(gain) do { f32x4 gn[4]; _Pragma("unroll") for (int j = 0; j < 4; ++j) gn[j] = *(const f32x4*)((gain) + 4 * lane + 256 * j); \
        for (int m = gw; m < M; m += 2 * NGW) { const int m2 = m + NGW; const bool has2 = m2 < M;       \
            f32x4 v[4], w[4]; float ss = 0.f, ss2 = 0.f; \
            _Pragma("unroll") for (int j = 0; j < 4; ++j) { v[j] = XROW4(m, j); w[j] = XROW4(has2 ? m2 : m, j); } \
            _Pragma("unroll") for (int j = 0; j < 4; ++j) { ss += (v[j].x * v[j].x + v[j].y * v[j].y) + (v[j].z * v[j].z + v[j].w * v[j].w); ss2 += (w[j].x * w[j].x + w[j].y * w[j].y) + (w[j].z * w[j].z + w[j].w * w[j].w); } \
            const float rstd = 1.f / sqrtf(wave_sum(ss) * (1.f / D) + EPS); NORM_Q_ROW(v, rstd, gn, m); \
            if (has2) { const float rstd2 = 1.f / sqrtf(wave_sum(ss2) * (1.f / D) + EPS); NORM_Q_ROW(w, rstd2, gn, m2); } } } while (0)

__device__ __forceinline__ void quant_block(const float* W, int ldw, signed char* WQ, float* sb, int n0, int dst_row0, LAS unsigned char* T, LAS float* red, int wave, int lane) {
    const int tid = wave * 64 + lane;
    { const float* src = W + (size_t)(8 * wave + (lane >> 3)) * ldw + n0 + 4 * (lane & 7);
#pragma unroll
      for (int i = 0; i < 16; ++i) __builtin_amdgcn_global_load_lds((const unsigned*)(src + (size_t)(64 * i) * ldw), (LAS unsigned*)(T + (8 * wave + 64 * i) * 128), 16, 0, 0); }
    asm volatile("s_waitcnt vmcnt(0)" ::: "memory"); __builtin_amdgcn_s_barrier(); asm volatile("" ::: "memory");
    const LAS float* Tf = (const LAS float*)T;
    { const int n = tid & 31, part = tid >> 5; float mx = 0.f;
#pragma unroll 16
      for (int k = 0; k < 64; ++k) mx = fmaxf(mx, fabsf(Tf[(64 * part + k) * 32 + n]));
      red[part * 32 + n] = mx; }
    asm volatile("s_waitcnt lgkmcnt(0)" ::: "memory"); __builtin_amdgcn_s_barrier(); asm volatile("" ::: "memory");
    if (tid < 32) { float m = red[tid];
#pragma unroll
        for (int p = 1; p < 16; ++p) m = fmaxf(m, red[p * 32 + tid]);
        const float sc = m > 0.f ? m * (1.f / 127.f) : 1.f; red[512 + tid] = 1.f / sc; sb[dst_row0 + tid] = sc; }
    asm volatile("s_waitcnt lgkmcnt(0)" ::: "memory"); __builtin_amdgcn_s_barrier(); asm volatile("" ::: "memory");
    { const int n = tid & 31; const float is = red[512 + n];
#pragma unroll 2
      for (int i = 0; i < 8; ++i) { const int c = (tid >> 5) + 16 * i; const LAS float* sp = Tf + (8 * c) * 32 + n; int q[8];
#pragma unroll
          for (int e = 0; e < 8; ++e) q[e] = (int)rintf(sp[e * 32] * is) & 0xff;
          v2u o; o.x = (unsigned)q[0] | ((unsigned)q[1] << 8) | ((unsigned)q[2] << 16) | ((unsigned)q[3] << 24); o.y = (unsigned)q[4] | ((unsigned)q[5] << 8) | ((unsigned)q[6] << 16) | ((unsigned)q[7] << 24);
          *(GAS v2u*)(WQ + (size_t)(dst_row0 + n) * 1024 + 8 * c) = o; } }
    asm volatile("s_waitcnt lgkmcnt(0)" ::: "memory"); __builtin_amdgcn_s_barrier(); asm volatile("" ::: "memory");
}

struct Args { const float* in[19]; float* out; unsigned char* ws; int ph_lo, ph_hi; };

__global__ void __launch_bounds__(NTHR, 2) fwd_kernel(Args args) {
    extern __shared__ __attribute__((aligned(16))) unsigned char lds[];
    LAS unsigned char* const L = (LAS unsigned char*)lds;
    volatile LAS unsigned* const MISC = (volatile LAS unsigned*)(L + MISC_OFF);
    const int wave = __builtin_amdgcn_readfirstlane((int)threadIdx.x >> 6);
    const int G = gridDim.x, bx = blockIdx.x;
    const int gw = bx * NWAVES + wave, NGW = G * NWAVES;
    unsigned char* const ws = args.ws;
    gu32* const ctl = (gu32*)(ws + WS_CTL);
    const float* const x_in = args.in[0]; const int* const positions = (const int*)args.in[1];
    const float* const norm_mix = args.in[2]; const float* const norm_ffn = args.in[3];
    const float* const w_in_ab = args.in[4]; const float* const fgate_bias = args.in[5]; const float* const w_out_ab = args.in[6];
    const float* const w_in_c = args.in[7]; const float* const lower_bounds = args.in[8]; const float* const gnorm_c = args.in[9]; const float* const w_out_c = args.in[10];
    const float* const w_gate_ffn = args.in[11]; const float* const w_up_ffn = args.in[12]; const float* const w_down_ffn = args.in[13];
    const float* const router = args.in[14]; const float* const w_gate_moe = args.in[15]; const float* const w_up_moe = args.in[16]; const float* const w_down_moe = args.in[17];
    const float* const norm_final = args.in[18];
    bf16* const X = (bf16*)(ws + 880 * MiB);
    float* const OUTF = args.out;
#define ROPE ((float*)(ws + WS_ROPE))
#define LOGF ((float*)(ws + WS_LOGF))
#define CUM ((float*)(ws + WS_CUM))
#define TOPI ((int*)(ws + WS_TOPI))
#define TOPG ((float*)(ws + WS_TOPG))
#define RANK ((int*)(ws + WS_RANK))
#define POS ((int*)(ws + WS_POS))
#define ROWMAP ((int*)(ws + WS_ROWMAP))
#define CNT ((int*)(ws + WS_CNT))
#define META ((int*)(ws + WS_META))
#define WinAB_t ((bf16*)(ws + WS_WINAB))
#define WoutAB_t ((bf16*)(ws + WS_WOUTAB))
#define Wgu_t ((bf16*)(ws + WS_WGU))
#define Wdown_t ((bf16*)(ws + WS_WDOWN))
#define WinC_t ((bf16*)(ws + WS_WINC))
#define WoutC_t ((bf16*)(ws + WS_WOUTC))
#define WguM_t ((bf16*)(ws + WS_WGUM))
#define WdownM_t ((bf16*)(ws + WS_WDOWNM))
#define XN ((bf16*)(ws + WS_XN))
#define PROJ ((bf16*)(ws + WS_BIG))
#define HID ((bf16*)(ws + WS_BIG))
#define PROJC ((bf16*)(ws + WS_BIG))
#define HIDM ((bf16*)(ws + WS_BIG))
#define YB ((unsigned char*)(ws + WS_Y))
#define ATT XN
#define XQ ((signed char*)(ws + WS_XN))
#define SA ((float*)(ws + WS_SA))
#define SAS ((float*)(ws + WS_SAS))
#define SBD ((float*)(ws + WS_SBD))
#define SBM ((float*)(ws + WS_SBM))
#define WguQ ((signed char*)(ws + WS_WGU))
#define WinABQ ((signed char*)(ws + WS_WINAB))
#define WinCQ ((signed char*)(ws + WS_WINC))
#define SBAB ((float*)(ws + WS_SBAB))
#define SBC ((float*)(ws + WS_SBC))
#define WguMQ ((signed char*)(ws + WS_WGUM))

    { const int tid = wave * 64 + lane_id(); for (int u = tid; u < (LDS_BYTES - LDSCTL_OFF) / 4; u += NTHR) ((LAS unsigned*)(L + LDSCTL_OFF))[u] = 0u; }
    __syncthreads();
    if (!PER_PHASE_LAUNCH) (void)xcd_barrier_post((unsigned*)(ctl + CW_BAR), MISC + 8, wave == 0 && lane_id() == 0);
#define GRID_BAR() do { if (!PER_PHASE_LAUNCH) { XcdBarrier b_; b_.bar = (unsigned*)((gu32*)(args.ws + WS_CTL) + CW_BAR); b_.x = xb_xcc_id(); b_.st = (volatile LAS unsigned*)(L + MISC_OFF) + 8; xcd_barrier(b_, wave == 0 && lane_id() == 0); } } while (0)
    const int PH_LO = args.ph_lo, PH_HI = args.ph_hi;
#define IN(k) (PH_LO <= (k) && (k) < PH_HI)
#define BOTH(k) (IN(k) && IN((k) + 1))

    if (IN(0)) { const int lane = lane_id(), tid = wave * 64 + lane; (void)tid; (void)lane;
        { constexpr int NB_D = DFF / 32, NB_E = DFFE / 32, NB_AB = NAB / 32, NB_C = NC / 32;
          constexpr int NQ = NB_AB + NB_C + 2 * NB_D + NEXP * 2 * NB_E;
          LAS float* const red = (LAS float*)(L + LDSCTL_OFF + 1024);
          for (int q0_ = bx; q0_ < NQ; q0_ += G) {
              const float* src; int ldw, up = 0, nb, dst0; signed char* dq; float* sbq; int q = q0_;
              if (q < NB_AB + NB_C) { const bool isc = q >= NB_AB; nb = isc ? q - NB_AB : q; src = isc ? w_in_c : w_in_ab; ldw = isc ? NC : IN_AB; dq = isc ? WinCQ : WinABQ; sbq = isc ? SBC : SBAB; dst0 = 32 * nb; }
              else { q -= NB_AB + NB_C;
                  if (q < 2 * NB_D) { up = q >= NB_D; nb = up ? q - NB_D : q; src = up ? w_up_ffn : w_gate_ffn; ldw = DFF; dq = WguQ; sbq = SBD; }
                  else { const int r = q - 2 * NB_D, e = r / (2 * NB_E), rr = r - e * (2 * NB_E); up = rr >= NB_E; nb = up ? rr - NB_E : rr;
                      src = (up ? w_up_moe : w_gate_moe) + (size_t)e * D * DFFE; ldw = DFFE; dq = WguMQ + (size_t)e * NGUE * D; sbq = SBM + (size_t)e * NGUE; }
                  const int n0 = 32 * nb; dst0 = (n0 >> 7) * 256 + up * 128 + (n0 & 127); }
              quant_block(src, ldw, dq, sbq, 32 * nb, dst0, L + RING_OFF, red, wave, lane); } }
        LAS float* scr = (LAS float*)(L + RING_OFF + wave * 16384);
        {
          constexpr int I0 = (D / 64) * (NAB / 32), I1 = (D / 64) * (D / 32), I2 = (DFF / 64) * (D / 32), I3 = (D / 64) * (NC / 32), I4 = I1, I5E = (DFFE / 64) * (D / 32);
          constexpr int NIT = I1 + I2 + I4 + NEXP * I5E; (void)I0; (void)I3;
          for (int it = gw; it < NIT; it += NGW) {
              int r = it; const float* src; int ldw, Kd, nblk; bf16* dst;
              if (false) { src = nullptr; ldw = 0; Kd = 0; nblk = 1; dst = nullptr; }
              else if (r < I1) { src = w_out_ab; ldw = D; Kd = D; nblk = D / 32; dst = WoutAB_t; }
              else if ((r -= I1) < I2) { src = w_down_ffn; ldw = D; Kd = DFF; nblk = D / 32; dst = Wdown_t; }
              else if ((r -= I2) < I4) { src = w_out_c; ldw = D; Kd = D; nblk = D / 32; dst = WoutC_t; }
              else { r -= I4; const int e = r / I5E; r -= e * I5E; const int kb = r / (D / 32), nb = r - kb * (D / 32);
                  absmax_item(w_down_moe + (size_t)e * DFFE * D, D, 64 * kb, 32 * nb, (unsigned*)(ctl + CW_WMAX) + e, lane); continue; }
              const int kb = r / nblk, nb = r - kb * nblk;
              transpose_item(src, ldw, Kd, dst, 64 * kb, 32 * nb, 32 * nb, scr, lane); } }
        for (int idx = bx * NTHR + tid; idx < M * 8; idx += G * NTHR) { const int m = idx >> 3, i = idx & 7;
            const float invf = exp2f(-(float)i * (18.931568569324174f / 8.0f)); const float ang = (float)positions[m] * invf;
            ROPE[m * 16 + i] = cosf(ang); ROPE[m * 16 + 8 + i] = sinf(ang); }
        {
            float gw_[4][4][8]; f32x4 gn[4];
#pragma unroll
            for (int j = 0; j < 4; ++j) { gn[j] = *(const f32x4*)(norm_mix + 4 * lane + 256 * j);
#pragma unroll
                for (int c = 0; c < 4; ++c) { const int col = 4 * lane + 256 * j + c;
#pragma unroll
                    for (int h = 0; h < 8; ++h) gw_[j][c][h] = w_in_ab[(size_t)col * IN_AB + NAB + h] * gn[j][c]; } }
            float fb = (lane < 8) ? fgate_bias[lane] : 0.f;
            for (int m = gw; m < M; m += NGW) {
                const GAS f32x4* xr = (const GAS f32x4*)(x_in + (size_t)m * D) + lane;
                f32x4 v[4]; float ss = 0.f; float fl[8];
#pragma unroll
                for (int h = 0; h < 8; ++h) fl[h] = 0.f;
#pragma unroll
                for (int j = 0; j < 4; ++j) { v[j] = xr[64 * j]; ss += (v[j].x * v[j].x + v[j].y * v[j].y) + (v[j].z * v[j].z + v[j].w * v[j].w);
#pragma unroll
                    for (int c = 0; c < 4; ++c)
#pragma unroll
                        for (int h = 0; h < 8; ++h) fl[h] += v[j][c] * gw_[j][c][h]; }
                { GAS v2u* xo = (GAS v2u*)(X + (size_t)m * D) + lane;
#pragma unroll
                  for (int j = 0; j < 4; ++j) { v2u o; o.x = pk2(v[j].x, v[j].y); o.y = pk2(v[j].z, v[j].w); xo[64 * j] = o; } }
                const float rstd = 1.f / sqrtf(wave_sum(ss) * (1.f / D) + EPS);
                float mine = 0.f;
#pragma unroll
                for (int h = 0; h < 8; ++h) { const float t = wave_sum(fl[h]); if (lane == h) mine = t; }
                if (lane < 8) { const float z = mine * rstd + fb; LOGF[(size_t)m * 8 + lane] = fminf(z, 0.f) - log1pf(__expf(-fabsf(z))); }
                NORM_Q_ROW(v, rstd, gn, m);
            }
        }
        if (BOTH(0)) GRID_BAR();
    }

    if (IN(1)) { const int lane = lane_id(), tid = wave * 64 + lane; (void)tid; (void)lane;
        if (wave == 0) for (int bh = bx; bh < BATCH * NH; bh += G) { const int b = bh >> 3, h = bh & 7;
            float loc[32]; float s = 0.f;
#pragma unroll
            for (int i = 0; i < 32; ++i) { s += LOGF[((size_t)(b * SEQ + lane * 32 + i)) * 8 + h]; loc[i] = s; }
            float incl = s;
#pragma unroll
            for (int o = 1; o < 64; o <<= 1) { const float t = __shfl_up(incl, o); if (lane >= o) incl += t; }
            const float excl = incl - s;
#pragma unroll
            for (int i = 0; i < 32; ++i) CUM[(size_t)bh * SEQ + lane * 32 + i] = (excl + loc[i]) * LOG2E; }
        { LAS float* scr = (LAS float*)(L + RING_OFF + wave * 16384);
          constexpr int I5E = (DFFE / 64) * (D / 32);
          for (int it = gw; it < NEXP * I5E; it += NGW) { const int e = it / I5E, r = it - e * I5E, kb = r / (D / 32), nb = r - kb * (D / 32);
              const float am = __uint_as_float(((const unsigned*)(ctl + CW_WMAX))[e]); const float sc = am > 0.f ? 256.f / am : 1.f;
              transpose_item_f8(w_down_moe + (size_t)e * DFFE * D, D, DFFE, (unsigned char*)WdownM_t + (size_t)e * D * DFFE, 64 * kb, 32 * nb, 32 * nb, sc, scr, lane); }
          __syncthreads(); }
        pg8::Gemm g{(const bf16*)XQ, (const bf16*)WinABQ, M, NAB, D}; pg8::StaticOrder S; S.init(M, NAB, G, bx);
        pg8::EpiProjAB E{PROJ, NAB, ROPE, QSCALE_AB, SA, SBAB};
        pg8::gemm_phase<pg8::EpiProjAB, pg8::StaticOrder, true, false, 1>(L + RING_OFF, g, S, E, nullptr, wave);
        if (BOTH(1)) GRID_BAR();
    }

    if (IN(2)) { const int lane = lane_id(), tid = wave * 64 + lane; (void)tid; (void)lane;
        LAS unsigned char* const vbuf = L + wave * 4096;
        LAS float* const cumL = (LAS float*)(L + 32768);
        const int r32 = lane & 31, hi = lane >> 5;
        for (int bh = bx; bh < BATCH * NH; bh += G) { const int b = bh >> 3, h = bh & 7;
            const bf16* const Pb = PROJ + (size_t)b * SEQ * NAB;
            { const bf16* const Qb = Pb + h * HD; const bf16* const Kb = Pb + 512 + h * HD; const bf16* const Vb = Pb + 1024 + h * HD;
              LAS unsigned char* const STL = L + 40960;
              for (int qb2 = 0; qb2 < SEQ / 512; ++qb2) { const int q0 = 512 * qb2;
                { bf16x8v qfa[2][4]; FlashSt sta[2]; int lqa[2], qla[2], kma[2];
#pragma unroll
                  for (int q = 0; q < 2; ++q) { const int tq = q0 + 256 * q + 32 * wave + r32; lqa[q] = tq; qla[q] = q0 + 256 * q + 32 * wave + 31; kma[q] = q0 + 256 * q + 32 * wave - 128; flash_init(sta[q]);
#pragma unroll
                      for (int d0 = 0; d0 < 4; ++d0) qfa[q][d0] = *(const bf16x8v*)(Qb + (size_t)tq * NAB + 16 * d0 + 8 * hi); }
                  coop_block<false, 2>(sta, qfa, Kb, Vb, q0 - 128, 10, lqa, 128, qla, kma, cumL, L, wave, lane);
#pragma unroll
                  for (int q = 0; q < 2; ++q) st_save16(sta[q], STL + ((lqa[q] - q0) * 2 + hi) * 80); }
                __syncthreads();
                { const int c4 = wave & 3, hf = wave >> 2, l4b = (q0 >> 2) + 64 * hf;
                  bf16x8v qf2[2][4]; FlashSt st2[2]; int lq2[2], lqb2[2];
#pragma unroll
                  for (int q = 0; q < 2; ++q) { lqb2[q] = l4b + 32 * q; lq2[q] = lqb2[q] + r32; const int tq = 4 * lq2[q] + c4;
#pragma unroll
                      for (int d0 = 0; d0 < 4; ++d0) qf2[q][d0] = *(const bf16x8v*)(Qb + (size_t)tq * NAB + 16 * d0 + 8 * hi);
                      st_load16(st2[q], STL + ((tq - q0) * 2 + hi) * 80); }
                  flash_tiles2(st2, qf2, Kb, Vb, 4 * (l4b - 128) + c4, 4, 6, 128, lq2, lqb2, l4b - 128, 128, vbuf, lane);
#pragma unroll
                  for (int q = 0; q < 2; ++q) { const int tq = 4 * lq2[q] + c4; st_save16(st2[q], STL + ((tq - q0) * 2 + hi) * 80); } }
                __syncthreads();
                for (int cc = 0; cc < 2; ++cc) { const int cls = 2 * wave + cc, l16q = (q0 >> 4) + r32, tq = 16 * l16q + cls; bf16x8v qf[4];
#pragma unroll
                  for (int d0 = 0; d0 < 4; ++d0) qf[d0] = *(const bf16x8v*)(Qb + (size_t)tq * NAB + 16 * d0 + 8 * hi);
                  FlashSt st; st_load16(st, STL + ((tq - q0) * 2 + hi) * 80);
                  const int nt = ((q0 >> 4) + 32 + 31) >> 5;
                  flash_tiles<false>(st, qf, Kb, Vb, cls, 16, nt, 512, l16q, 0, 1 << 20, cumL, vbuf, lane);
                  flash_store(st, ATT + (size_t)(b * SEQ + tq) * D + h * HD, lane); }
                __syncthreads(); } }
            __syncthreads();
            LAS float* const cumF = (LAS float*)(L + 65536);
            for (int i = tid; i < SEQ; i += NTHR) cumF[i] = -CUM[(size_t)bh * SEQ + i];
            __syncthreads();
            { const bf16* const Qb = Pb + 1536 + h * HD; const bf16* const Kb = Pb + 2048 + h * HD; const bf16* const Vb = Pb + 2560 + h * HD;
              for (int qb = 0; qb < SEQ / 512; ++qb) { const int tq = 512 * qb + 32 * wave + r32;
                bf16x8v qf2[2][4];
#pragma unroll
                for (int q = 0; q < 2; ++q)
#pragma unroll
                    for (int d0 = 0; d0 < 4; ++d0) qf2[q][d0] = *(const bf16x8v*)(Qb + (size_t)(tq + 256 * q) * NAB + 16 * d0 + 8 * hi);
                FlashSt st2[2]; flash_init(st2[0]); flash_init(st2[1]);
                { const int lq2[2] = {tq, tq + 256}, ql2[2] = {512 * qb + 32 * wave + 31, 512 * qb + 256 + 32 * wave + 31}, km2[2] = {-(1 << 30), -(1 << 30)};
                  coop_block<true, 2, 2>(st2, qf2, Kb, Vb, 0, (512 * qb + 512) >> 7, lq2, 4096, ql2, km2, cumF, L, wave, lane); }
#pragma unroll
                for (int q = 0; q < 2; ++q) flash_store(st2[q], ATT + (size_t)(b * SEQ + tq + 256 * q) * D + 512 + h * HD, lane); } }
        }
        __syncthreads();
        if (BOTH(2)) GRID_BAR();
    }

    if (IN(3)) { const int lane = lane_id(), tid = wave * 64 + lane; (void)tid; (void)lane;
        pg8::Gemm g{ATT, WoutAB_t, M, D, D}; pg8::StaticOrder S; S.init(M, D, G, bx);
        pg8::EpiResidualB<false> E{X, X};
        pg8::gemm_phase<pg8::EpiResidualB<false>, pg8::StaticOrder, true, false>(L + RING_OFF, g, S, E, nullptr, wave);
        if (BOTH(3)) GRID_BAR();
    }

#define NORM_PHASE(gain) do { f32x4 gn[4]; _Pragma("unroll") for (int j = 0; j < 4; ++j) gn[j] = *(const f32x4*)((gain) + 4 * lane + 256 * j); \
        for (int m = gw; m < M; m += NGW) { f32x4 v[4]; float ss = 0.f; \
            _Pragma("unroll") for (int j = 0; j < 4; ++j) { v[j] = XROW4(m, j); ss += (v[j].x * v[j].x + v[j].y * v[j].y) + (v[j].z * v[j].z + v[j].w * v[j].w); } \
            const float rstd = 1.f / sqrtf(wave_sum(ss) * (1.f / D) + EPS); \
            GAS unsigned long long* o8 = (GAS unsigned long long*)(XN + (size_t)m * D) + lane; \
            _Pragma("unroll") for (int j = 0; j < 4; ++j) { const f32x4 y = v[j] * rstd * gn[j]; o8[64 * j] = (unsigned long long)pk2(y.x, y.y) | ((unsigned long long)pk2(y.z, y.w) << 32); } } } while (0)

    if (IN(4)) { const int lane = lane_id(), tid = wave * 64 + lane; (void)tid; (void)lane; NORM_Q_PHASE(norm_ffn); if (BOTH(4)) GRID_BAR(); }

    if (IN(5)) { const int lane = lane_id(), tid = wave * 64 + lane; (void)tid; (void)lane;
        pg8::Gemm g{(const bf16*)XQ, (const bf16*)WguQ, M, NGU, D}; pg8::StaticOrder S; S.init(M, NGU, G, bx);
        pg8::EpiSwiGLUI8 E{HID, DFF, 0, SA, SBD};
        pg8::gemm_phase<pg8::EpiSwiGLUI8, pg8::StaticOrder, true, false, 1>(L + RING_OFF, g, S, E, nullptr, wave);
        if (BOTH(5)) GRID_BAR();
    }
    if (IN(6)) { const int lane = lane_id(), tid = wave * 64 + lane; (void)tid; (void)lane;
        pg8::Gemm g{HID, Wdown_t, M, D, DFF}; pg8::StaticOrder S; S.init(M, D, G, bx);
        pg8::EpiResidualB<false> E{X, X};
        pg8::gemm_phase<pg8::EpiResidualB<false>, pg8::StaticOrder, true, false>(L + RING_OFF, g, S, E, nullptr, wave);
        if (BOTH(6)) GRID_BAR();
    }
    if (IN(7)) { const int lane = lane_id(), tid = wave * 64 + lane; (void)tid; (void)lane; NORM_Q_PHASE(norm_mix + D); if (BOTH(7)) GRID_BAR(); }
    if (IN(8)) { const int lane = lane_id(), tid = wave * 64 + lane; (void)tid; (void)lane;
        pg8::Gemm g{(const bf16*)XQ, (const bf16*)WinCQ, M, NC, D}; pg8::StaticOrder S; S.init(M, NC, G, bx);
        pg8::EpiBf16S E{PROJC, NC, 4, QSCALE_C, SA, SBC};
        pg8::gemm_phase<pg8::EpiBf16S, pg8::StaticOrder, true, false, 1>(L + RING_OFF, g, S, E, nullptr, wave);
        if (BOTH(8)) GRID_BAR();
    }
    if (IN(9)) { const int lane = lane_id(), tid = wave * 64 + lane; (void)tid; (void)lane;
#define HG_BAR() do { asm volatile("s_waitcnt lgkmcnt(0)" ::: "memory"); __builtin_amdgcn_s_barrier(); asm volatile("" ::: "memory"); } while (0)
        constexpr int PQ = 272, PV = 320;
        LAS unsigned char* const QT = L;
        LAS unsigned char* const KT = L + 17408;
        LAS unsigned char* const KH = L + 34816;
        LAS unsigned char* const VT = L + 55296;
        LAS float* const OL = (LAS float*)(L + 75776);
        LAS float* const EBL = (LAS float*)(L + 108544);
        LAS float* const GT = (LAS float*)(L + 109056);
        const int r32 = lane & 31, h5 = lane >> 5, tb = wave >> 2, eb = wave & 3, dp = lane, grp = wave;
        const int trq = (lane & 15) >> 2, trp = lane & 3, trc = (lane >> 4) & 1;
        for (int bh = bx; bh < BATCH * NH; bh += G) { const int b = bh >> 3, h = bh & 7;
            const float lbv0 = sigm_fast(lower_bounds[D + h * HK + 2 * dp] - lower_bounds[h * HK + 2 * dp]), lbv1 = sigm_fast(lower_bounds[D + h * HK + 2 * dp + 1] - lower_bounds[h * HK + 2 * dp + 1]);
            const float gn0 = gnorm_c[2 * lane], gn1 = gnorm_c[2 * lane + 1];
            f32x16 S[4];
#pragma unroll
            for (int i = 0; i < 4; ++i)
#pragma unroll
                for (int r = 0; r < 16; ++r) S[i][r] = 0.f;
            unsigned fraw[8], qraw[8]; v4u vraw[2]; unsigned graw[8];
#define HG_PRELOAD(CH) do { const int m0_ = b * SEQ + (CH) * 64; \
                _Pragma("unroll") for (int j = 0; j < 8; ++j) { const bf16* pr = PROJC + (size_t)(m0_ + 8 * grp + j) * NC + h * HK + 2 * dp; fraw[j] = *(const unsigned*)(pr + D); qraw[j] = *(const unsigned*)pr; } \
                _Pragma("unroll") for (int i = 0; i < 2; ++i) { const int c = tid + 512 * i, row = c >> 4, c16 = c & 15; vraw[i] = *(const v4u*)(PROJC + (size_t)(m0_ + row) * NC + 2 * D + h * HK + 8 * c16); } } while (0)
#define HG_GLOAD(CH) do { const int m0_ = b * SEQ + (CH) * 64; \
                _Pragma("unroll") for (int tt = 0; tt < 8; ++tt) graw[tt] = *(const unsigned*)(PROJC + (size_t)(m0_ + wave * 8 + tt) * NC + 3 * D + h * HK + 2 * lane); } while (0)
            HG_PRELOAD(0);
            for (int ch = 0; ch < SEQ / 64; ++ch) { const int m0 = b * SEQ + ch * 64;
                float bl0[8], bl1[8], k0[8], k1[8], q0[8], q1[8]; float run0 = 1.f, run1 = 1.f;
#pragma unroll
                for (int j = 0; j < 8; ++j) { const float f0 = lbv0 + (1.f - lbv0) * sigm_fast(bflo(fraw[j])), f1 = lbv1 + (1.f - lbv1) * sigm_fast(bfhi(fraw[j]));
                    run0 *= f0; run1 *= f1; bl0[j] = run0; bl1[j] = run1; k0[j] = 1.f - f0; k1[j] = 1.f - f1; q0[j] = bflo(qraw[j]); q1[j] = bfhi(qraw[j]); }
                *(LAS f32x2_t*)(GT + grp * 128 + 2 * dp) = (f32x2_t){run0, run1};
#pragma unroll
                for (int i = 0; i < 2; ++i) { const int c = tid + 512 * i, row = c >> 4, c16 = c & 15; *(LAS v4u*)(VT + row * PV + c16 * 16) = vraw[i]; }
                HG_BAR();
                { float off0 = 1.f, off1 = 1.f, tot0 = 1.f, tot1 = 1.f;
#pragma unroll
                  for (int g2 = 0; g2 < 8; ++g2) { const f32x2_t v = *(const LAS f32x2_t*)(GT + g2 * 128 + 2 * dp); tot0 *= v.x; tot1 *= v.y; if (g2 < grp) { off0 *= v.x; off1 *= v.y; } }
                  const float et0 = tot0, et1 = tot1;
#pragma unroll
                  for (int j = 0; j < 8; ++j) { const int t = 8 * grp + j;
                      const float e0 = off0 * bl0[j], e1 = off1 * bl1[j]; const float kt0 = k0[j] * __builtin_amdgcn_rcpf(e0), kt1 = k1[j] * __builtin_amdgcn_rcpf(e1);
                      *(LAS unsigned*)(QT + t * PQ + dp * 4) = cvtpk_s(q0[j] * e0, q1[j] * e1);
                      *(LAS unsigned*)(KT + t * PQ + dp * 4) = cvtpk_s(kt0, kt1);
                      *(LAS unsigned*)(KH + t * PV + dp * 4) = cvtpk_s(kt0 * et0, kt1 * et1); }
                  if (grp == 0) *(LAS f32x2_t*)(EBL + 2 * dp) = (f32x2_t){et0, et1}; }
                HG_GLOAD(ch); if (ch + 1 < SEQ / 64) HG_PRELOAD(ch + 1);
                HG_BAR();
                {
                    f32x16 o, sc;
#pragma unroll
                    for (int r = 0; r < 16; ++r) { o[r] = 0.f; sc[r] = 0.f; }
                    asm volatile("" : "+v"(o), "+v"(sc));
                    bf16x8v qb[8];
#pragma unroll
                    for (int ks = 0; ks < 8; ++ks) qb[ks] = *(const LAS bf16x8v*)(QT + (32 * tb + r32) * PQ + (16 * ks + 8 * h5) * 2);
#pragma unroll
                    for (int ks = 0; ks < 8; ++ks) { const int db = ks >> 1, k2 = ks & 1;
                        v4u bw; bw.x = cvtpk_s(S[db][8 * k2], S[db][8 * k2 + 1]); bw.y = cvtpk_s(S[db][8 * k2 + 2], S[db][8 * k2 + 3]); bw.z = cvtpk_s(S[db][8 * k2 + 4], S[db][8 * k2 + 5]); bw.w = cvtpk_s(S[db][8 * k2 + 6], S[db][8 * k2 + 7]);
                        const LAS unsigned char* qa = QT + (32 * tb + r32) * PQ + (32 * db + 16 * k2 + 4 * h5) * 2;
                        const v2u a0 = *(const LAS v2u*)qa, a1 = *(const LAS v2u*)(qa + 16);
                        v4u aw; aw.x = a0.x; aw.y = a0.y; aw.z = a1.x; aw.w = a1.y;
                        const bf16x8v ka = *(const LAS bf16x8v*)(KT + r32 * PQ + (16 * ks + 8 * h5) * 2);
                        o = __builtin_amdgcn_mfma_f32_32x32x16_bf16(__builtin_bit_cast(bf16x8v, aw), __builtin_bit_cast(bf16x8v, bw), o, 0, 0, 0);
                        sc = __builtin_amdgcn_mfma_f32_32x32x16_bf16(ka, qb[ks], sc, 0, 0, 0); }
                    for (int sb = 0; sb <= tb; ++sb) {
                        if (sb == 1) {
#pragma unroll
                            for (int r = 0; r < 16; ++r) sc[r] = 0.f;
                            asm volatile("" : "+v"(sc));
#pragma unroll
                            for (int ks = 0; ks < 8; ++ks) { const bf16x8v ka = *(const LAS bf16x8v*)(KT + (32 + r32) * PQ + (16 * ks + 8 * h5) * 2);
                                sc = __builtin_amdgcn_mfma_f32_32x32x16_bf16(ka, qb[ks], sc, 0, 0, 0); } }
                        if (sb == tb) {
#pragma unroll
                            for (int r = 0; r < 16; ++r) { const int sl = (r & 3) + 8 * (r >> 2) + 4 * h5; if (sl > r32) sc[r] = 0.f; } }
                        v4u p0, p1;
                        p0.x = cvtpk_s(sc[0], sc[1]); p0.y = cvtpk_s(sc[2], sc[3]); p0.z = cvtpk_s(sc[4], sc[5]); p0.w = cvtpk_s(sc[6], sc[7]);
                        p1.x = cvtpk_s(sc[8], sc[9]); p1.y = cvtpk_s(sc[10], sc[11]); p1.z = cvtpk_s(sc[12], sc[13]); p1.w = cvtpk_s(sc[14], sc[15]);
                        const LAS unsigned char* vb = VT + (32 * sb + 4 * h5 + trq) * PV + (32 * eb + 16 * trc + 4 * trp) * 2;
                        { const s16x4 l0 = vtr(vb), u0 = vtr(vb + 8 * PV), l1 = vtr(vb + 16 * PV), u1 = vtr(vb + 24 * PV);
                          const bf16x8v v0 = (bf16x8v){l0[0], l0[1], l0[2], l0[3], u0[0], u0[1], u0[2], u0[3]}, v1 = (bf16x8v){l1[0], l1[1], l1[2], l1[3], u1[0], u1[1], u1[2], u1[3]};
                          o = __builtin_amdgcn_mfma_f32_32x32x16_bf16(__builtin_bit_cast(bf16x8v, p0), v0, o, 0, 0, 0);
                          o = __builtin_amdgcn_mfma_f32_32x32x16_bf16(__builtin_bit_cast(bf16x8v, p1), v1, o, 0, 0, 0); }
                    }
#pragma unroll
                    for (int r = 0; r < 16; ++r) OL[(32 * tb + (r & 3) + 8 * (r >> 2) + 4 * h5) * 128 + 32 * eb + r32] = o[r];
                    const LAS unsigned char* kb_ = KH + (8 * h5 + trq) * PV + (16 * trc + 4 * trp) * 2;
                    const LAS unsigned char* vb_ = VT + (8 * h5 + trq) * PV + (32 * eb + 16 * trc + 4 * trp) * 2;
                    bf16x8v vf[4];
#pragma unroll
                    for (int ks = 0; ks < 4; ++ks) { const s16x4 l = vtr(vb_ + 16 * ks * PV), u = vtr(vb_ + (16 * ks + 4) * PV); vf[ks] = (bf16x8v){l[0], l[1], l[2], l[3], u[0], u[1], u[2], u[3]}; }
#pragma unroll
                    for (int db = 0; db < 4; ++db)
#pragma unroll
                        for (int g2 = 0; g2 < 4; ++g2) { const f32x4 e4 = *(const LAS f32x4*)(EBL + 32 * db + 8 * g2 + 4 * h5);
#pragma unroll
                            for (int c = 0; c < 4; ++c) S[db][4 * g2 + c] *= e4[c]; }
#pragma unroll
                    for (int ks = 0; ks < 4; ++ks)
#pragma unroll
                        for (int db = 0; db < 4; ++db) { const s16x4 l = vtr(kb_ + 16 * ks * PV + 64 * db), u = vtr(kb_ + (16 * ks + 4) * PV + 64 * db);
                            const bf16x8v kf_ = (bf16x8v){l[0], l[1], l[2], l[3], u[0], u[1], u[2], u[3]};
                            S[db] = __builtin_amdgcn_mfma_f32_32x32x16_bf16(kf_, vf[ks], S[db], 0, 0, 0); }
                }
                HG_BAR();
#pragma unroll
                for (int tt = 0; tt < 8; ++tt) { const int t = wave * 8 + tt; const int m = m0 + t;
                    const f32x2_t ov = *(const LAS f32x2_t*)(OL + t * 128 + 2 * lane); const float o0 = ov.x, o1 = ov.y;
                    const float rstd = __builtin_amdgcn_rsqf(wave_sum(o0 * o0 + o1 * o1) * (1.f / 128.f) + EPS);
                    const float g0 = bflo(graw[tt]), g1 = bfhi(graw[tt]);
                    *(unsigned*)(XN + (size_t)m * D + h * HK + 2 * lane) = cvtpk_s(o0 * rstd * gn0 * g0 * sigm_fast(g0), o1 * rstd * gn1 * g1 * sigm_fast(g1)); }
            }
#undef HG_PRELOAD
#undef HG_GLOAD
            __syncthreads();
        }
        __syncthreads();
        if (BOTH(9)) GRID_BAR();
    }
    if (IN(10)) { const int lane = lane_id(), tid = wave * 64 + lane; (void)tid; (void)lane;
        pg8::Gemm g{XN, WoutC_t, M, D, D}; pg8::StaticOrder S; S.init(M, D, G, bx);
        pg8::EpiResidualB<false> E{X, X};
        pg8::gemm_phase<pg8::EpiResidualB<false>, pg8::StaticOrder, true, false>(L + RING_OFF, g, S, E, nullptr, wave);
        if (BOTH(10)) GRID_BAR();
    }
    if (IN(11)) { const int lane = lane_id(), tid = wave * 64 + lane; (void)tid; (void)lane;
        LAS int* const cnt = (LAS int*)(L);
        float rw[4][4][8]; f32x4 gn[4];
#pragma unroll
        for (int j = 0; j < 4; ++j) { gn[j] = *(const f32x4*)(norm_ffn + D + 4 * lane + 256 * j);
#pragma unroll
            for (int c = 0; c < 4; ++c) { const int col = 4 * lane + 256 * j + c;
#pragma unroll
                for (int e = 0; e < 8; ++e) rw[j][c][e] = router[(size_t)col * NEXP + e] * gn[j][c]; } }
        for (int chunk = bx; chunk < M / 256; chunk += G) {
            __syncthreads();
            if (tid < 8) cnt[tid] = 0;
            __syncthreads();
            for (int r = 0; r < 32; ++r) { const int m = chunk * 256 + wave * 32 + r;
                f32x4 v[4]; float ss = 0.f; float lg[8];
#pragma unroll
                for (int e = 0; e < 8; ++e) lg[e] = 0.f;
#pragma unroll
                for (int j = 0; j < 4; ++j) { v[j] = XROW4(m, j); ss += (v[j].x * v[j].x + v[j].y * v[j].y) + (v[j].z * v[j].z + v[j].w * v[j].w);
#pragma unroll
                    for (int c = 0; c < 4; ++c)
#pragma unroll
                        for (int e = 0; e < 8; ++e) lg[e] += v[j][c] * rw[j][c][e]; }
                const float rstd = 1.f / sqrtf(wave_sum(ss) * (1.f / D) + EPS);
#pragma unroll
                for (int e = 0; e < 8; ++e) lg[e] = wave_sum(lg[e]) * rstd;
                NORM_Q_ROW(v, rstd, gn, m);
                if (lane == 0) {
                    int e0 = 0; float v0 = lg[0];
#pragma unroll
                    for (int e = 1; e < 8; ++e) if (lg[e] > v0) { v0 = lg[e]; e0 = e; }
                    int e1 = -1; float v1 = -INFINITY;
#pragma unroll
                    for (int e = 0; e < 8; ++e) if (e != e0 && lg[e] > v1) { v1 = lg[e]; e1 = e; }
                    const float g1 = 1.f / (1.f + __expf(v0 - v1)), g0 = 1.f - g1;
                    const int r0 = atomicAdd((int*)(cnt + e0), 1), r1 = atomicAdd((int*)(cnt + e1), 1);
                    TOPI[m] = e0 | (e1 << 8); TOPG[2 * m] = g0; TOPG[2 * m + 1] = g1; RANK[2 * m] = r0; RANK[2 * m + 1] = r1;
                }
            }
            __syncthreads();
            if (tid < 8) CNT[chunk * 8 + tid] = cnt[tid];
        }
        __syncthreads();
        if (BOTH(11)) GRID_BAR();
    }
    if (IN(12)) { const int lane = lane_id(), tid = wave * 64 + lane; (void)tid; (void)lane;
        LAS int* const lc = (LAS int*)(L);
        LAS int* const tot = lc + 2048;
        LAS int* const base = tot + 8;
        LAS int* const off = base + 16;
        __syncthreads();
        for (int i = tid; i < 2048; i += NTHR) lc[i] = CNT[i];
        __syncthreads();
        if (tid < 8) { int s = 0; for (int c = 0; c < 256; ++c) s += lc[c * 8 + tid]; tot[tid] = s; }
        __syncthreads();
        if (tid == 0) { int b = 0; for (int e = 0; e < 8; ++e) { base[e] = b; b += (tot[e] + 255) & ~255; } base[8] = b; }
        __syncthreads();
        for (int chunk = bx; chunk < M / 256; chunk += G) {
            __syncthreads();
            if (tid < 8) { int s = base[tid]; for (int c = 0; c < chunk; ++c) s += lc[c * 8 + tid]; off[tid] = s; }
            __syncthreads();
            { const int m = chunk * 256 + (tid >> 1), slot = tid & 1; const int ti = TOPI[m]; const int e = slot ? (ti >> 8) : (ti & 0xff);
              const int pos = off[e] + RANK[2 * m + slot]; ROWMAP[pos] = m; POS[2 * m + slot] = pos; SAS[pos] = SA[m]; }
        }
        if (bx == 0) {
            for (int e = 0; e < 8; ++e) for (int p = base[e] + tot[e] + tid; p < base[e + 1]; p += NTHR) { ROWMAP[p] = 0; SAS[p] = 0.f; }
            if (tid == 0) META[0] = base[8] >> 8;
            for (int p = tid; p < NPMAX; p += NTHR) { int e = 0; for (int k = 1; k < 8; ++k) if (p * 256 >= base[k]) e = k; META[64 + p] = e; }
        }
        __syncthreads();
        if (BOTH(12)) GRID_BAR();
    }
    for (int c = 0; c < NMCH; ++c) {
        if (IN(13 + 2 * c)) { const int lane = lane_id(), tid = wave * 64 + lane; (void)tid; (void)lane;
            const int ptot = __builtin_amdgcn_readfirstlane(META[0]); const int p_lo = c * PCHUNK; int p_n = ptot - p_lo; p_n = p_n < 0 ? 0 : (p_n > PCHUNK ? PCHUNK : p_n);
            int p_tail = (c == NMCH - 1) ? ptot - p_lo - p_n : 0; p_tail = p_tail < 0 ? 0 : p_tail;
            pg8::Gemm g{(const bf16*)XQ, (const bf16*)WguMQ, M, NGUE, D}; pg8::MoeOrder S{p_lo, p_n, p_tail, NGUE / 256, G, bx, 0, META + 64}; S.init();
            pg8::EpiSwiGLUI8F8 E{HIDM, DFFE, p_lo, SAS, SBM};
            pg8::gemm_phase<pg8::EpiSwiGLUI8F8, pg8::MoeOrder, true, true, 1>(L + RING_OFF, g, S, E, ROWMAP, wave);
            if (BOTH(13 + 2 * c)) GRID_BAR();
        }
        if (IN(14 + 2 * c)) { const int lane = lane_id(), tid = wave * 64 + lane; (void)tid; (void)lane;
            const int ptot = __builtin_amdgcn_readfirstlane(META[0]); const int p_lo = c * PCHUNK; int p_n = ptot - p_lo; p_n = p_n < 0 ? 0 : (p_n > PCHUNK ? PCHUNK : p_n);
            int p_tail = (c == NMCH - 1) ? ptot - p_lo - p_n : 0; p_tail = p_tail < 0 ? 0 : p_tail;
            pg8::Gemm g{HIDM, WdownM_t, (PCHUNK + 8) * 256, D, DFFE}; pg8::MoeOrder S{p_lo, p_n, p_tail, D / 256, G, bx, 1, META + 64}; S.init();
            pg8::EpiBf16RowsF8 E{YB, D, p_lo * 256, (const unsigned*)(ctl + CW_WMAX)};
            pg8::gemm_phase<pg8::EpiBf16RowsF8, pg8::MoeOrder, true, false, 2>(L + RING_OFF, g, S, E, nullptr, wave);
            if (BOTH(14 + 2 * c)) GRID_BAR();
        }
    }
    if (IN(13 + 2 * NMCH)) { const int lane = lane_id(), tid = wave * 64 + lane; (void)tid; (void)lane;
        f32x4 gn[4];
#pragma unroll
        for (int j = 0; j < 4; ++j) gn[j] = *(const f32x4*)(norm_final + 4 * lane + 256 * j);
        int pn0 = POS[2 * gw], pn1 = POS[2 * gw + 1]; float gq0 = TOPG[2 * gw], gq1 = TOPG[2 * gw + 1];
        for (int m = gw; m < M; m += NGW) {
            const int p0 = pn0, p1 = pn1; const float g0 = gq0, g1 = gq1;
            const GAS unsigned* y0 = (const GAS unsigned*)(YB + (size_t)p0 * D) + lane; const GAS unsigned* y1 = (const GAS unsigned*)(YB + (size_t)p1 * D) + lane;
            f32x4 v[4]; unsigned ya[4], yb[4]; float ss = 0.f;
#pragma unroll
            for (int j = 0; j < 4; ++j) { v[j] = XROW4(m, j); ya[j] = __builtin_nontemporal_load(y0 + 64 * j); yb[j] = __builtin_nontemporal_load(y1 + 64 * j); }
            { const int mn = (m + NGW < M) ? m + NGW : m; pn0 = POS[2 * mn]; pn1 = POS[2 * mn + 1]; gq0 = TOPG[2 * mn]; gq1 = TOPG[2 * mn + 1]; }
#pragma unroll
            for (int j = 0; j < 4; ++j) { const int a = (int)ya[j], bq = (int)yb[j]; const float h0 = g0 * (1.f / 16.f), h1 = g1 * (1.f / 16.f);
                v[j].x += h0 * __builtin_amdgcn_cvt_f32_fp8(a, 0) + h1 * __builtin_amdgcn_cvt_f32_fp8(bq, 0); v[j].y += h0 * __builtin_amdgcn_cvt_f32_fp8(a, 1) + h1 * __builtin_amdgcn_cvt_f32_fp8(bq, 1);
                v[j].z += h0 * __builtin_amdgcn_cvt_f32_fp8(a, 2) + h1 * __builtin_amdgcn_cvt_f32_fp8(bq, 2); v[j].w += h0 * __builtin_amdgcn_cvt_f32_fp8(a, 3) + h1 * __builtin_amdgcn_cvt_f32_fp8(bq, 3);
                ss += (v[j].x * v[j].x + v[j].y * v[j].y) + (v[j].z * v[j].z + v[j].w * v[j].w); }
            const float rstd = 1.f / sqrtf(wave_sum(ss) * (1.f / D) + EPS);
            GAS f32x4* orow = (GAS f32x4*)(OUTF + (size_t)m * D) + lane;
#pragma unroll
            for (int j = 0; j < 4; ++j) __builtin_nontemporal_store(v[j] * rstd * gn[j], orow + 64 * j);
        }
    }
#undef IN
#undef BOTH
}

extern "C" void kernel_launch(void* const* d_in, const int* in_sizes, int n_in, void* d_out, int out_size, void* d_ws, size_t ws_size, hipStream_t stream) {
    static int grid = 0;
    if (grid == 0) {
        if (n_in != 19 || in_sizes[0] != M * D || out_size != M * D || ws_size < WS_END) { fprintf(stderr, "kernel_launch: unexpected shapes (n_in %d, in0 %d, out %d, ws %zu)\n", n_in, n_in > 0 ? in_sizes[0] : -1, out_size, ws_size); grid = -1; return; }
        int dev = 0, cus = 0, per_cu = 0;
        if (hipGetDevice(&dev) != hipSuccess || hipDeviceGetAttribute(&cus, hipDeviceAttributeMultiprocessorCount, dev) != hipSuccess) { grid = -1; return; }
        if (hipFuncSetAttribute((const void*)fwd_kernel, hipFuncAttributeMaxDynamicSharedMemorySize, LDS_BYTES) != hipSuccess) { fprintf(stderr, "kernel_launch: hipFuncSetAttribute failed\n"); grid = -1; return; }
        if (hipOccupancyMaxActiveBlocksPerMultiprocessor(&per_cu, (const void*)fwd_kernel, NTHR, LDS_BYTES) != hipSuccess || per_cu < 1) fprintf(stderr, "kernel_launch: occupancy query reports %d\n", per_cu);
        (void)hipGetLastError();
        grid = cus;
    }
    if (grid < 0) return;
    if (hipMemsetAsync((char*)d_ws + WS_CTL, 0, CTL_ZERO_BYTES, stream) != hipSuccess) return;
    Args a{};
    for (int i = 0; i < 19; ++i) a.in[i] = (const float*)d_in[i];
    a.out = (float*)d_out; a.ws = (unsigned char*)d_ws;
#if PER_PHASE_LAUNCH
    for (int p = 0; p < NPHASE; ++p) { a.ph_lo = p; a.ph_hi = p + 1; hipLaunchKernelGGL(fwd_kernel, dim3(grid), dim3(NTHR), LDS_BYTES, stream, a); }
#else
    a.ph_lo = 0; a.ph_hi = NPHASE; hipLaunchKernelGGL(fwd_kernel, dim3(grid), dim3(NTHR), LDS_BYTES, stream, a);
#endif
}
```

```cpp
#include <hip/hip_runtime.h>
#include <cstdio>
#include <cstdint>

#ifndef DIL_MFMA
#define DIL_MFMA 1
#endif
#ifndef FOX_MFMA
#define FOX_MFMA 1
#endif
#ifndef PER_PHASE_LAUNCH
#define PER_PHASE_LAUNCH 0
#endif

namespace pg8 {
#define PG8_LAS __attribute__((address_space(3)))
typedef unsigned short bf16_t;
typedef short bf16x8 __attribute__((ext_vector_type(8)));
typedef float f32x4 __attribute__((ext_vector_type(4)));
typedef unsigned u32x4 __attribute__((ext_vector_type(4)));
typedef int i32x4 __attribute__((ext_vector_type(4)));
typedef int i32x8 __attribute__((ext_vector_type(8)));
template <int MODE> struct AccSel { typedef f32x4 T; };
template <> struct AccSel<1> { typedef i32x4 T; };
constexpr int BM = 256, BK = 64, HALF = 128, HTB = HALF * BK * 2  , STAGE_BYTES = 8 * HTB, NXCD = 8, WGM = 8;

__host__ __device__ __forceinline__ int lds_byte(int r, int c) { const int st = (r >> 4) * 2 + (c >> 5), rr = r & 15, cc = c & 31, ob = rr * 64 + cc * 2; return st * 1024 + (ob ^ (((ob >> 9) & 1) << 5)); }
__host__ __device__ __forceinline__ void stage_rc(int b, int& R, int& C) { const int st = b / 1024, sb = b % 1024, swz = sb ^ (((sb >> 9) & 1) << 5); R = (st >> 1) * 16 + swz / 64; C = (st & 1) * 32 + (swz % 64) / 2; }
__host__ __device__ __forceinline__ int perm32(int rho) { const int n = rho >> 4, i = rho & 15; return 8 * (i >> 2) + 4 * n + (i & 3); }

struct Unit { int pm, pn, aux; };
struct Gemm { const bf16_t* A; const bf16_t* Bt; int M, N, K; };

struct StaticOrder {
    int nM, nN, nwg, G, c;
    __host__ __device__ void init(int M, int N, int G_, int c_) { nM = M / BM; nN = N / BM; nwg = nM * nN; G = G_; c = c_; }
    __host__ __device__ bool next(int i, Unit& u) const {
        const long L = (long)i * G + c; if (L >= nwg) return false;
        int wgid = (int)L; { const int q = nwg / NXCD, r = nwg % NXCD, xcd = wgid % NXCD, off = wgid / NXCD; wgid = (xcd < r ? xcd * (q + 1) : r * (q + 1) + (xcd - r) * q) + off; }
        const int nig = WGM * nN, gid = wgid / nig, fm = gid * WGM, gsz = (nM - fm) < WGM ? (nM - fm) : WGM;
        u.pm = fm + ((wgid % nig) % gsz); u.pn = (wgid % nig) / gsz; u.aux = u.pn; return true;
    }
};
struct MoeOrder {
    int p_lo, p_n, p_tail, nN, G, c, a_local; const int* pexp;
    unsigned nreg, R, ntail; int uni, fast, cm, cd, gd, e_fast; int xd, xpl, xpn, e_x0, e_x1;
    __device__ __forceinline__ void init() {
#define PG8_U(x) ((unsigned)__builtin_amdgcn_readfirstlane((int)(x)))
        nreg = (unsigned)p_n * (unsigned)nN; ntail = (unsigned)p_tail * (unsigned)nN; const unsigned qr = PG8_U(nreg / (unsigned)G), rr = PG8_U(nreg % (unsigned)G); R = qr + (rr != 0u);
        uni = (p_tail > 0 && rr != 0u); fast = (p_n > 0) && (PG8_U((unsigned)G % (unsigned)(p_n > 0 ? p_n : 1)) == 0u);
        cm = fast ? (int)PG8_U((unsigned)c % (unsigned)p_n) : 0; cd = fast ? (int)PG8_U((unsigned)c / (unsigned)p_n) : 0; gd = fast ? (int)PG8_U((unsigned)G / (unsigned)p_n) : 0;
        xd = (!uni && G == 256 && p_n == 128 && nN == 4 && a_local == 1);
        xpl = 8 * (c & 7) + (c >> 5); xpn = (c >> 3) & 3;
        e_x0 = xd ? __builtin_amdgcn_readfirstlane(pexp[p_lo + xpl]) : 0; e_x1 = xd ? __builtin_amdgcn_readfirstlane(pexp[p_lo + xpl + 64]) : 0;
        e_fast = fast ? __builtin_amdgcn_readfirstlane(pexp[p_lo + cm]) : 0;
    }
    __device__ __forceinline__ bool next(int i, Unit& u) const {
        int pl, pn; bool known = false; int ek = 0;
        if (xd && i < 2) { pl = xpl + 64 * i; pn = xpn; known = true; ek = i ? e_x1 : e_x0; }
        else if (uni) { const unsigned P = (unsigned)(p_n + p_tail); const unsigned L = (unsigned)i * (unsigned)G + (unsigned)c; if (L >= P * (unsigned)nN) return false; pl = (int)PG8_U(L % P); pn = (int)PG8_U(L / P); }
        else if ((unsigned)i < R) { const unsigned L = (unsigned)i * (unsigned)G + (unsigned)c; if (L >= nreg) return false;
            if (fast) { pl = cm; pn = i * gd + cd; known = true; ek = e_fast; } else { pl = (int)PG8_U(L % (unsigned)p_n); pn = (int)PG8_U(L / (unsigned)p_n); } }
        else { const unsigned L = ((unsigned)i - R) * (unsigned)G + (unsigned)c; if (L >= ntail) return false; pl = p_n + (int)PG8_U(L % (unsigned)p_tail); pn = (int)PG8_U(L / (unsigned)p_tail); }
        const int panel = p_lo + pl;
        int e; if (known) e = ek; else e = __builtin_amdgcn_readfirstlane(pexp[panel]);
        u.pm = __builtin_amdgcn_readfirstlane(a_local ? pl : panel); u.pn = __builtin_amdgcn_readfirstlane(e * nN + pn); u.aux = __builtin_amdgcn_readfirstlane(pn); return true;
    }
};

__device__ __forceinline__ unsigned cvt_pk_bf16(float lo, float hi) { unsigned r; asm volatile("v_cvt_pk_bf16_f32 %0, %1, %2" : "=v"(r) : "v"(lo), "v"(hi)); return r; }


struct EpiBf16S {
    static constexpr bool PERM = true, AFTER_DRAIN = false;
    bf16_t* O; int ldc; int nsc; float sc; const float* sa; const float* sb;
    static constexpr bool LDS_SCALES = true;
    __device__ __forceinline__ const float* row_scales(const Unit& u) const { return sa + (size_t)u.pm * BM; }
    __device__ __forceinline__ const float* col_scales(const Unit& u) const { return sb + (size_t)u.pn * BM; }
    __device__ __forceinline__ void operator()(const i32x4 (&acc)[2][2][4][2], const Unit& u, int wr, int wc, int fr, int fq, const PG8_LAS float* scl) const {
        const int row0 = u.pm * BM + wr * 64 + fr; const int col0 = u.aux * BM + wc * 32 + 8 * fq; const float s = (u.aux < nsc) ? sc : 1.f;
        float srv[2][4];
#pragma unroll
        for (int ai = 0; ai < 2; ++ai)
#pragma unroll
            for (int m = 0; m < 4; ++m) srv[ai][m] = scl[wr * 64 + fr + ai * HALF + m * 16];
#pragma unroll
        for (int bj = 0; bj < 2; ++bj) { const f32x4 sb0 = *(const PG8_LAS f32x4*)(scl + 256 + wc * 32 + 8 * fq + bj * HALF) * s, sb1 = *(const PG8_LAS f32x4*)(scl + 256 + wc * 32 + 8 * fq + bj * HALF + 4) * s;
#pragma unroll
            for (int ai = 0; ai < 2; ++ai)
#pragma unroll
                for (int m = 0; m < 4; ++m) { const int row = row0 + ai * HALF + m * 16; const float sr = srv[ai][m];
                    const f32x4 v0 = __builtin_convertvector(acc[ai][bj][m][0], f32x4) * sb0 * sr, v1 = __builtin_convertvector(acc[ai][bj][m][1], f32x4) * sb1 * sr;
                    u32x4 w; w.x = cvt_pk_bf16(v0[0], v0[1]); w.y = cvt_pk_bf16(v0[2], v0[3]); w.z = cvt_pk_bf16(v1[0], v1[1]); w.w = cvt_pk_bf16(v1[2], v1[3]);
                    *(u32x4*)(O + (size_t)row * ldc + col0 + bj * HALF) = w; } }
    }
};
__device__ __forceinline__ float xor16(float v, int fq) { auto r = __builtin_amdgcn_permlane16_swap(__builtin_bit_cast(unsigned, v), __builtin_bit_cast(unsigned, v), false, false); return __builtin_bit_cast(float, (fq & 1) ? r[0] : r[1]); }
struct EpiProjAB {
    static constexpr bool PERM = true, AFTER_DRAIN = false;
    bf16_t* O; int ldc; const float* rope; float qscale; const float* sa; const float* sb;
    static constexpr bool LDS_SCALES = true;
    __device__ __forceinline__ const float* row_scales(const Unit& u) const { return sa + (size_t)u.pm * BM; }
    __device__ __forceinline__ const float* col_scales(const Unit& u) const { return sb + (size_t)u.pn * BM; }
    __device__ __forceinline__ void operator()(const i32x4 (&acc)[2][2][4][2], const Unit& u, int wr, int wc, int fr, int fq, const PG8_LAS float* scl) const {
        const int row0 = u.pm * BM + wr * 64 + fr; const int col0 = u.aux * BM + wc * 32 + 8 * fq;
        const int tt = u.aux >> 1; const bool do_rope = tt < 2; const float s = (tt == 0 || tt == 3) ? qscale : 1.f;
        const bool rl = ((wc & 1) == 0) && (fq < 2);
        float srv[2][4];
#pragma unroll
        for (int ai = 0; ai < 2; ++ai)
#pragma unroll
            for (int m = 0; m < 4; ++m) srv[ai][m] = scl[wr * 64 + fr + ai * HALF + m * 16];
        f32x4 sbv[2][2];
#pragma unroll
        for (int bj = 0; bj < 2; ++bj) { sbv[bj][0] = *(const PG8_LAS f32x4*)(scl + 256 + wc * 32 + 8 * fq + bj * HALF) * s; sbv[bj][1] = *(const PG8_LAS f32x4*)(scl + 256 + wc * 32 + 8 * fq + bj * HALF + 4) * s; }
        if (!do_rope) {
#pragma unroll
            for (int bj = 0; bj < 2; ++bj)
#pragma unroll
                for (int ai = 0; ai < 2; ++ai)
#pragma unroll
                    for (int m = 0; m < 4; ++m) { const int row = row0 + ai * HALF + m * 16; const float sr = srv[ai][m];
                        const f32x4 v0 = __builtin_convertvector(acc[ai][bj][m][0], f32x4) * sbv[bj][0] * sr, v1 = __builtin_convertvector(acc[ai][bj][m][1], f32x4) * sbv[bj][1] * sr;
                        u32x4 w; w.x = cvt_pk_bf16(v0[0], v0[1]); w.y = cvt_pk_bf16(v0[2], v0[3]); w.z = cvt_pk_bf16(v1[0], v1[1]); w.w = cvt_pk_bf16(v1[2], v1[3]);
                        *(u32x4*)(O + (size_t)row * ldc + col0 + bj * HALF) = w; }
        } else {
            const float sg = (fq == 0) ? -1.f : 1.f;
            f32x4 rc[4];
            { const f32x4* rp = (const f32x4*)(rope + (size_t)row0 * 16); rc[0] = rp[0]; rc[1] = rp[1]; rc[2] = rp[2]; rc[3] = rp[3]; }
#pragma unroll
            for (int idx = 0; idx < 8; ++idx) { const int ai = idx >> 2, m = idx & 3; const int row = row0 + ai * HALF + m * 16; const float sr = srv[ai][m];
                f32x4 rn[4];
                if (idx + 1 < 8) { const int rown = row0 + ((idx + 1) >> 2) * HALF + ((idx + 1) & 3) * 16; const f32x4* rp = (const f32x4*)(rope + (size_t)rown * 16); rn[0] = rp[0]; rn[1] = rp[1]; rn[2] = rp[2]; rn[3] = rp[3]; }
                const f32x4 s0 = rc[2] * sg, s1 = rc[3] * sg;
#pragma unroll
                for (int bj = 0; bj < 2; ++bj) {
                    f32x4 v0 = __builtin_convertvector(acc[ai][bj][m][0], f32x4) * sbv[bj][0] * sr, v1 = __builtin_convertvector(acc[ai][bj][m][1], f32x4) * sbv[bj][1] * sr;
                    f32x4 p0, p1;
#pragma unroll
                    for (int c = 0; c < 4; ++c) { p0[c] = xor16(v0[c], fq); p1[c] = xor16(v1[c], fq); }
                    const f32x4 r0 = v0 * rc[0] + p0 * s0, r1 = v1 * rc[1] + p1 * s1;
#pragma unroll
                    for (int c = 0; c < 4; ++c) { v0[c] = rl ? r0[c] : v0[c]; v1[c] = rl ? r1[c] : v1[c]; }
                    u32x4 w; w.x = cvt_pk_bf16(v0[0], v0[1]); w.y = cvt_pk_bf16(v0[2], v0[3]); w.z = cvt_pk_bf16(v1[0], v1[1]); w.w = cvt_pk_bf16(v1[2], v1[3]);
                    *(u32x4*)(O + (size_t)row * ldc + col0 + bj * HALF) = w; }
                if (idx + 1 < 8) { rc[0] = rn[0]; rc[1] = rn[1]; rc[2] = rn[2]; rc[3] = rn[3]; } }
        }
    }
};
struct EpiSwiGLU {
    static constexpr bool PERM = true, AFTER_DRAIN = false;
    bf16_t* O; int ldc;
    __device__ __forceinline__ void operator()(const f32x4 (&acc)[2][2][4][2], const Unit& u, int wr, int wc, int fr, int fq) const {
        const int row0 = u.pm * BM + wr * 64 + fr; const int col0 = u.aux * HALF + wc * 32 + 8 * fq;
#pragma unroll
        for (int ai = 0; ai < 2; ++ai)
#pragma unroll
            for (int m = 0; m < 4; ++m) { bf16_t* rowp = O + (size_t)(row0 + ai * HALF + m * 16) * ldc + col0;
                float h[8];
#pragma unroll
                for (int n = 0; n < 2; ++n)
#pragma unroll
                    for (int c = 0; c < 4; ++c) { const float g = acc[ai][0][m][n][c], up = acc[ai][1][m][n][c];
                        h[4 * n + c] = g * up * __builtin_amdgcn_rcpf(1.f + __builtin_amdgcn_exp2f(-1.4426950408889634f * g)); }
                u32x4 w; w.x = cvt_pk_bf16(h[0], h[1]); w.y = cvt_pk_bf16(h[2], h[3]); w.z = cvt_pk_bf16(h[4], h[5]); w.w = cvt_pk_bf16(h[6], h[7]);
                *(u32x4*)rowp = w; }
    }
};
struct EpiSwiGLURows {
    static constexpr bool PERM = true, AFTER_DRAIN = false;
    bf16_t* O; int ldc; int p_lo;
    __device__ __forceinline__ void operator()(const f32x4 (&acc)[2][2][4][2], const Unit& u, int wr, int wc, int fr, int fq) const {
        Unit v = u; v.pm = u.pm - p_lo; EpiSwiGLU E{O, ldc}; E(acc, v, wr, wc, fr, fq); }
};
typedef float f32x2v __attribute__((ext_vector_type(2)));
__device__ __forceinline__ f32x2v pkmul(f32x2v a, f32x2v b) { f32x2v d; asm("v_pk_mul_f32 %0, %1, %2" : "=v"(d) : "v"(a), "v"(b)); return d; }
template <bool OUT_F8> struct EpiSwiGLUI8T {
    static constexpr bool PERM = true, AFTER_DRAIN = false;
    bf16_t* O; int ldc; int p_lo; const float* sa; const float* sb;
    static constexpr bool LDS_SCALES = true;
    __device__ __forceinline__ const float* row_scales(const Unit& u) const { return sa + (size_t)u.pm * BM; }
    __device__ __forceinline__ const float* col_scales(const Unit& u) const { return sb + (size_t)u.pn * BM; }
    __device__ __forceinline__ void operator()(const i32x4 (&acc)[2][2][4][2], const Unit& u, int wr, int wc, int fr, int fq, const PG8_LAS float* scl) const {
        const int rl = wr * 64 + fr; const int row0 = (u.pm - p_lo) * BM + rl; const int col0 = u.aux * HALF + wc * 32 + 8 * fq;
        const PG8_LAS float* sbp = scl + 256 + wc * 32 + 8 * fq; const PG8_LAS float* sap = scl + rl;
        f32x4 sg[2], su[2]; float sr[2][4];
#pragma unroll
        for (int n = 0; n < 2; ++n) { sg[n] = *(const PG8_LAS f32x4*)(sbp + 4 * n); su[n] = *(const PG8_LAS f32x4*)(sbp + HALF + 4 * n); }
        f32x2v sgE[2][2], cP[2][2];
#pragma unroll
        for (int n = 0; n < 2; ++n)
#pragma unroll
            for (int hh = 0; hh < 2; ++hh) { sgE[n][hh] = (f32x2v){sg[n][2 * hh], sg[n][2 * hh + 1]} * -1.4426950408889634f; cP[n][hh] = (f32x2v){sg[n][2 * hh] * su[n][2 * hh], sg[n][2 * hh + 1] * su[n][2 * hh + 1]} * (OUT_F8 ? 16.f : 1.f); }
#pragma unroll
        for (int ai = 0; ai < 2; ++ai)
#pragma unroll
            for (int m = 0; m < 4; ++m) sr[ai][m] = sap[ai * HALF + m * 16];
#pragma unroll
        for (int ai = 0; ai < 2; ++ai)
#pragma unroll
            for (int m = 0; m < 4; ++m) { const float r1 = sr[ai][m], rq = r1 * r1; const f32x2v r1p = {r1, r1}, rqp = {rq, rq}; float h[8];
#pragma unroll
                for (int n = 0; n < 2; ++n)
#pragma unroll
                    for (int hh = 0; hh < 2; ++hh) { const f32x2v ag = {(float)acc[ai][0][m][n][2 * hh], (float)acc[ai][0][m][n][2 * hh + 1]}, au = {(float)acc[ai][1][m][n][2 * hh], (float)acc[ai][1][m][n][2 * hh + 1]};
                        const f32x2v e2 = pkmul(ag, pkmul(sgE[n][hh], r1p)), num = pkmul(pkmul(ag, au), pkmul(cP[n][hh], rqp));
                        const f32x2v d2 = (f32x2v){__builtin_amdgcn_exp2f(e2.x), __builtin_amdgcn_exp2f(e2.y)} + 1.f;
                        const f32x2v hv = num * (f32x2v){__builtin_amdgcn_rcpf(d2.x), __builtin_amdgcn_rcpf(d2.y)};
                        h[4 * n + 2 * hh] = hv.x; h[4 * n + 2 * hh + 1] = hv.y; }
                if constexpr (OUT_F8) {
#pragma unroll
                    for (int c = 0; c < 8; ++c) h[c] = __builtin_amdgcn_fmed3f(h[c], -448.f, 448.f);
                    int w0 = 0, w1 = 0; w0 = __builtin_amdgcn_cvt_pk_fp8_f32(h[0], h[1], w0, false); w0 = __builtin_amdgcn_cvt_pk_fp8_f32(h[2], h[3], w0, true);
                    w1 = __builtin_amdgcn_cvt_pk_fp8_f32(h[4], h[5], w1, false); w1 = __builtin_amdgcn_cvt_pk_fp8_f32(h[6], h[7], w1, true);
                    typedef int i32x2 __attribute__((ext_vector_type(2)));
                    *(i32x2*)((unsigned char*)O + (size_t)(row0 + ai * HALF + m * 16) * ldc + col0) = (i32x2){w0, w1};
                } else {
                    u32x4 w; w.x = cvt_pk_bf16(h[0], h[1]); w.y = cvt_pk_bf16(h[2], h[3]); w.z = cvt_pk_bf16(h[4], h[5]); w.w = cvt_pk_bf16(h[6], h[7]);
                    *(u32x4*)(O + (size_t)(row0 + ai * HALF + m * 16) * ldc + col0) = w; } }
    }
};
typedef EpiSwiGLUI8T<false> EpiSwiGLUI8;
typedef EpiSwiGLUI8T<true> EpiSwiGLUI8F8;
struct EpiBf16RowsF8 {
    static constexpr bool PERM = true, AFTER_DRAIN = false;
    unsigned char* O; int ldc; int row_off; const unsigned* wmax;
    __device__ __forceinline__ void operator()(const f32x4 (&acc)[2][2][4][2], const Unit& u, int wr, int wc, int fr, int fq) const {
        const int row0 = row_off + u.pm * BM + wr * 64 + fr; const int col0 = u.aux * BM + wc * 32 + 8 * fq;
        const float sc16 = __uint_as_float(wmax[u.pn >> 2]) * (8.f / 4096.f);
#pragma unroll
        for (int ai = 0; ai < 2; ++ai)
#pragma unroll
            for (int m = 0; m < 4; ++m) { unsigned char* rowp = O + (size_t)(row0 + ai * HALF + m * 16) * ldc + col0;
#pragma unroll
                for (int bj = 0; bj < 2; ++bj) { const f32x4 v0 = acc[ai][bj][m][0] * sc16, v1 = acc[ai][bj][m][1] * sc16;
                    int w0 = 0, w1 = 0;
                    w0 = __builtin_amdgcn_cvt_pk_fp8_f32(__builtin_amdgcn_fmed3f(v0[0], -448.f, 448.f), __builtin_amdgcn_fmed3f(v0[1], -448.f, 448.f), w0, false);
                    w0 = __builtin_amdgcn_cvt_pk_fp8_f32(__builtin_amdgcn_fmed3f(v0[2], -448.f, 448.f), __builtin_amdgcn_fmed3f(v0[3], -448.f, 448.f), w0, true);
                    w1 = __builtin_amdgcn_cvt_pk_fp8_f32(__builtin_amdgcn_fmed3f(v1[0], -448.f, 448.f), __builtin_amdgcn_fmed3f(v1[1], -448.f, 448.f), w1, false);
                    w1 = __builtin_amdgcn_cvt_pk_fp8_f32(__builtin_amdgcn_fmed3f(v1[2], -448.f, 448.f), __builtin_amdgcn_fmed3f(v1[3], -448.f, 448.f), w1, true);
                    typedef int i32x2y __attribute__((ext_vector_type(2)));
                    *(i32x2y*)(rowp + bj * HALF) = (i32x2y){w0, w1}; } }
    }
};
struct EpiResidual {
    static constexpr bool PERM = false, AFTER_DRAIN = false;
    const float* base; float* out; int ldc;
    __device__ __forceinline__ void operator()(const f32x4 (&acc)[2][2][4][2], const Unit& u, int wr, int wc, int fr, int fq) const {
        const int row0 = u.pm * BM + wr * 64 + fr; const int col0 = u.aux * BM + wc * 32 + 4 * fq;
#pragma unroll
        for (int ai = 0; ai < 2; ++ai) {
            f32x4 bb[4][2][2];
#pragma unroll
            for (int m = 0; m < 4; ++m) { const size_t off = (size_t)(row0 + ai * HALF + m * 16) * ldc + col0;
#pragma unroll
                for (int bj = 0; bj < 2; ++bj)
#pragma unroll
                    for (int n = 0; n < 2; ++n) bb[m][bj][n] = *(const f32x4*)(base + off + bj * HALF + n * 16); }
#pragma unroll
            for (int m = 0; m < 4; ++m) { const size_t off = (size_t)(row0 + ai * HALF + m * 16) * ldc + col0;
#pragma unroll
                for (int bj = 0; bj < 2; ++bj)
#pragma unroll
                    for (int n = 0; n < 2; ++n) *(f32x4*)(out + off + bj * HALF + n * 16) = bb[m][bj][n] + acc[ai][bj][m][n]; }
        }
    }
};
template <bool BASE_F32> struct EpiResidualB {
    static constexpr bool PERM = true, AFTER_DRAIN = false;
    const void* base; bf16_t* out;
    __device__ __forceinline__ void operator()(const f32x4 (&acc)[2][2][4][2], const Unit& u, int wr, int wc, int fr, int fq) const {
        const int row0 = u.pm * BM + wr * 64 + fr; const int col0 = u.aux * BM + wc * 32 + 8 * fq;
        static_assert(!BASE_F32, "the stream is bf16 from the first phase on");
        u32x4 raw[2][4][2];
#pragma unroll
        for (int ai = 0; ai < 2; ++ai)
#pragma unroll
            for (int m = 0; m < 4; ++m) { const size_t off = (size_t)(row0 + ai * HALF + m * 16) * 1024 + col0;
#pragma unroll
                for (int bj = 0; bj < 2; ++bj) raw[ai][m][bj] = *(const u32x4*)((const bf16_t*)base + off + bj * HALF); }
#pragma unroll
        for (int ai = 0; ai < 2; ++ai)
#pragma unroll
            for (int m = 0; m < 4; ++m) { const size_t off = (size_t)(row0 + ai * HALF + m * 16) * 1024 + col0;
#pragma unroll
                for (int bj = 0; bj < 2; ++bj) { const u32x4 r = raw[ai][m][bj];
                    const f32x4 v0 = (f32x4){__uint_as_float(r.x << 16), __uint_as_float(r.x & 0xffff0000u), __uint_as_float(r.y << 16), __uint_as_float(r.y & 0xffff0000u)} + acc[ai][bj][m][0];
                    const f32x4 v1 = (f32x4){__uint_as_float(r.z << 16), __uint_as_float(r.z & 0xffff0000u), __uint_as_float(r.w << 16), __uint_as_float(r.w & 0xffff0000u)} + acc[ai][bj][m][1];
                    u32x4 w; w.x = cvt_pk_bf16(v0[0], v0[1]); w.y = cvt_pk_bf16(v0[2], v0[3]); w.z = cvt_pk_bf16(v1[0], v1[1]); w.w = cvt_pk_bf16(v1[2], v1[3]);
                    *(u32x4*)(out + off + bj * HALF) = w; } }
    }
};
struct EpiBf16Rows {
    static constexpr bool PERM = true, AFTER_DRAIN = false;
    bf16_t* O; int ldc; int row_off;
    __device__ __forceinline__ void operator()(const f32x4 (&acc)[2][2][4][2], const Unit& u, int wr, int wc, int fr, int fq) const {
        const int row0 = row_off + u.pm * BM + wr * 64 + fr; const int col0 = u.aux * BM + wc * 32 + 8 * fq;
#pragma unroll
        for (int ai = 0; ai < 2; ++ai)
#pragma unroll
            for (int m = 0; m < 4; ++m) { bf16_t* rowp = O + (size_t)(row0 + ai * HALF + m * 16) * ldc + col0;
#pragma unroll
                for (int bj = 0; bj < 2; ++bj) { const f32x4 v0 = acc[ai][bj][m][0], v1 = acc[ai][bj][m][1];
                    u32x4 w; w.x = cvt_pk_bf16(v0[0], v0[1]); w.y = cvt_pk_bf16(v0[2], v0[3]); w.z = cvt_pk_bf16(v1[0], v1[1]); w.w = cvt_pk_bf16(v1[2], v1[3]);
                    *(u32x4*)(rowp + bj * HALF) = w; } }
    }
};

template <class Epi, class Sched, bool ALIGN_EPI, bool GATHER, int MODE = 0>
__device__ __forceinline__ void gemm_phase(PG8_LAS unsigned char* lds, const Gemm g, const Sched& S, const Epi& E, const int* rowmap, int wave_) {
    int lane; asm volatile("v_mbcnt_lo_u32_b32 %0, -1, 0\n\tv_mbcnt_hi_u32_b32 %0, -1, %0" : "=v"(lane));
    const int wid = wave_, tid = wid * 64 + lane, wr = wid >> 2, wc = wid & 3, fr = lane & 15, fq = lane >> 4;
    typedef typename AccSel<MODE>::T AccT;
    const int K = MODE ? g.K / 2 : g.K, nt = K / BK;
    unsigned voffB[2]; int Rr[2], Cc[2];
#pragma unroll
    for (int i = 0; i < 2; ++i) { int R, C; stage_rc(tid * 16 + i * 8192, R, C); Rr[i] = R; Cc[i] = C; const int Rb = Epi::PERM ? ((R & ~31) + perm32(R & 31)) : R;
        voffB[i] = (unsigned)(Rb * K + C) * 2u; }
    const size_t kstep = (size_t)(BK * 2);
    const size_t hstep = (size_t)HALF * K * 2;
    const size_t tstep = 2 * hstep;
    const unsigned ldsw = (unsigned)wid * 1024u;
    const int aoff = lds_byte(wr * 64 + fr, fq * 8), boff = lds_byte(wc * 32 + fr, fq * 8);
#define PG8_SA(b, h) (((b) * 2 + (h)) * HTB)
#define PG8_SB(b, h) ((4 + (b) * 2 + (h)) * HTB)
#define PG8_STAGE(bufoff, gbase, voff) do { _Pragma("unroll") for (int _i = 0; _i < 2; ++_i) \
        __builtin_amdgcn_global_load_lds((const unsigned*)((const char*)(gbase) + (voff)[_i]), (PG8_LAS unsigned*)(lds + (bufoff) + ldsw + _i * 8192), 16, 0, 0); } while (0)
#define PG8_LD16(off) (*(const PG8_LAS i32x4*)(lds + (off)))
#define PG8_LDA(dst, b, h) do { if constexpr (MODE == 2) { _Pragma("unroll") for (int m = 0; m < 4; ++m) dst##8[m] = __builtin_shufflevector(PG8_LD16(PG8_SA(b, h) + aoff + m * 2048), PG8_LD16(PG8_SA(b, h) + aoff + m * 2048 + 1024), 0, 1, 2, 3, 4, 5, 6, 7); } \
        else { _Pragma("unroll") for (int m = 0; m < 4; ++m) _Pragma("unroll") for (int k = 0; k < 2; ++k) dst[m][k] = *(const PG8_LAS bf16x8*)(lds + PG8_SA(b, h) + aoff + m * 2048 + k * 1024); } } while (0)
#define PG8_LDB(dst, b, h) do { if constexpr (MODE == 2) { _Pragma("unroll") for (int n = 0; n < 2; ++n) dst##8[n] = __builtin_shufflevector(PG8_LD16(PG8_SB(b, h) + boff + n * 2048), PG8_LD16(PG8_SB(b, h) + boff + n * 2048 + 1024), 0, 1, 2, 3, 4, 5, 6, 7); } \
        else { _Pragma("unroll") for (int n = 0; n < 2; ++n) _Pragma("unroll") for (int k = 0; k < 2; ++k) dst[n][k] = *(const PG8_LAS bf16x8*)(lds + PG8_SB(b, h) + boff + n * 2048 + k * 1024); } } while (0)
#define PG8_MMA(ai, bj, At, Bt) do { __builtin_amdgcn_s_setprio(1); _Pragma("unroll") for (int m = 0; m < 4; ++m) _Pragma("unroll") for (int n = 0; n < 2; ++n) { \
        if constexpr (MODE == 2) { asm volatile("v_mfma_scale_f32_16x16x128_f8f6f4 %0, %1, %2, %0, %3, %3 op_sel_hi:[0,0,0]" : "+v"(acc[ai][bj][m][n]) : "v"(Bt##8[n]), "v"(At##8[m]), "v"(sc127_)); } \
        else { _Pragma("unroll") for (int k = 0; k < 2; ++k) { \
          if constexpr (MODE == 1) acc[ai][bj][m][n] = __builtin_bit_cast(AccT, __builtin_amdgcn_mfma_i32_16x16x64_i8(__builtin_bit_cast(i32x4, Bt[n][k]), __builtin_bit_cast(i32x4, At[m][k]), __builtin_bit_cast(i32x4, acc[ai][bj][m][n]), 0, 0, 0)); \
          else acc[ai][bj][m][n] = __builtin_bit_cast(AccT, __builtin_amdgcn_mfma_f32_16x16x32_bf16(Bt[n][k], At[m][k], __builtin_bit_cast(f32x4, acc[ai][bj][m][n]), 0, 0, 0)); } } } __builtin_amdgcn_s_setprio(0); } while (0)
#define PG8_WAIT_V(n) asm volatile("s_waitcnt vmcnt(" #n ")" ::: "memory")
#define PG8_WAIT_L(n) asm volatile("s_waitcnt lgkmcnt(" #n ")" ::: "memory")
#define PG8_BAR __builtin_amdgcn_s_barrier()
#define PG8_SCHED __builtin_amdgcn_sched_barrier(0)
#define PG8_LOAD_VA(dst, u) do { _Pragma("unroll") for (int _h = 0; _h < 2; ++_h) _Pragma("unroll") for (int _i = 0; _i < 2; ++_i) \
        dst[_h][_i] = GATHER ? ((unsigned)rowmap[(u).pm * BM + _h * HALF + Rr[_i]] * (unsigned)(K * 2) + (unsigned)Cc[_i] * 2u) : ((unsigned)((_h * HALF + Rr[_i]) * K + Cc[_i]) * 2u); } while (0)
    Unit cur, nxt; int ui = 0;
    if (!S.next(0, cur)) return;
    AccT acc[2][2][4][2];
#pragma unroll
    for (int a = 0; a < 2; ++a)
#pragma unroll
        for (int b = 0; b < 2; ++b)
#pragma unroll
            for (int m = 0; m < 4; ++m)
#pragma unroll
                for (int n = 0; n < 2; ++n) acc[a][b][m][n] = __builtin_bit_cast(AccT, (f32x4){0.f, 0.f, 0.f, 0.f});
    PG8_LAS float* const sclb = (PG8_LAS float*)(lds + STAGE_BYTES + 4096);
#define PG8_SCALE_DMA(U, PAR) do { if constexpr (MODE == 1) { const float* src_ = (tid < 256) ? E.row_scales(U) + tid : E.col_scales(U) + (tid - 256); \
        __builtin_amdgcn_global_load_lds((const unsigned*)src_, (PG8_LAS unsigned*)(sclb + (PAR) * 512 + wid * 64), 4, 0, 0); } } while (0)
    int sc127_ = 0x7f7f7f7f; asm volatile("" : "+v"(sc127_));
    bf16x8 At[4][2], B0[2][2], B1[2][2]; i32x8 At8[4], B08[2], B18[2];
    unsigned vAc[2][2], vAn[2][2];
    PG8_LOAD_VA(vAc, cur);
    const char* cA = GATHER ? (const char*)g.A : (const char*)g.A + (size_t)cur.pm * tstep; const char* cB = (const char*)g.Bt + (size_t)cur.pn * tstep;
    PG8_SCALE_DMA(cur, 0);
    PG8_STAGE(PG8_SB(0, 0), cB, voffB); PG8_STAGE(PG8_SB(0, 1), cB + hstep, voffB); PG8_STAGE(PG8_SA(0, 0), cA, vAc[0]); PG8_STAGE(PG8_SA(0, 1), cA, vAc[1]);
    if (wr == 1) PG8_BAR;
    PG8_WAIT_V(2); PG8_BAR;
    PG8_STAGE(PG8_SB(1, 0), cB + kstep, voffB); PG8_STAGE(PG8_SA(1, 0), cA + kstep, vAc[0]); PG8_STAGE(PG8_SB(1, 1), cB + hstep + kstep, voffB);
    PG8_WAIT_V(6); PG8_BAR;
    for (;;) {
        const bool has_next = S.next(ui + 1, nxt);
        if constexpr (GATHER) { if (has_next && nxt.pm != cur.pm) { PG8_LOAD_VA(vAn, nxt); } else {
#pragma unroll
            for (int _h = 0; _h < 2; ++_h)
#pragma unroll
                for (int _i = 0; _i < 2; ++_i) vAn[_h][_i] = vAc[_h][_i]; } }
        const char* nA = GATHER ? (const char*)g.A : (has_next ? (const char*)g.A + (size_t)nxt.pm * tstep : cA); const char* nB = has_next ? (const char*)g.Bt + (size_t)nxt.pn * tstep : cB;
        for (int t = 0; t < nt; t += 2) {
            const bool last = (t == nt - 2);
            const char* a1 = cA + (size_t)(t + 1) * kstep;
            const char* a2 = last ? nA : cA + (size_t)(t + 2) * kstep; const char* b2 = last ? nB : cB + (size_t)(t + 2) * kstep;
            const char* a3 = a2 + kstep; const char* b3 = b2 + kstep;
            unsigned o2[2][2];
#pragma unroll
            for (int _h = 0; _h < 2; ++_h)
#pragma unroll
                for (int _i = 0; _i < 2; ++_i) o2[_h][_i] = (GATHER && last) ? vAn[_h][_i] : vAc[_h][_i];
            PG8_LDB(B0, 0, 0); PG8_LDB(B1, 0, 1); PG8_SCHED; PG8_LDA(At, 0, 0); PG8_STAGE(PG8_SA(1, 1), a1, vAc[1]);
            PG8_WAIT_V(8); PG8_WAIT_L(0); PG8_BAR; PG8_MMA(0, 0, At, B0); PG8_MMA(0, 1, At, B1); PG8_BAR; PG8_SCHED;
            PG8_LDA(At, 0, 1); PG8_STAGE(PG8_SB(0, 0), b2, voffB); PG8_STAGE(PG8_SB(0, 1), b2 + hstep, voffB); PG8_STAGE(PG8_SA(0, 0), a2, o2[0]);
            PG8_WAIT_V(8); PG8_WAIT_L(0); PG8_BAR; PG8_MMA(1, 0, At, B0); PG8_MMA(1, 1, At, B1); PG8_BAR; PG8_SCHED;
            PG8_LDB(B0, 1, 0); PG8_LDB(B1, 1, 1); PG8_SCHED; PG8_LDA(At, 1, 0); PG8_STAGE(PG8_SA(0, 1), a2, o2[1]);
            PG8_WAIT_V(8); PG8_WAIT_L(0); PG8_BAR; PG8_MMA(0, 0, At, B0); PG8_MMA(0, 1, At, B1); PG8_BAR; PG8_SCHED;
            PG8_LDA(At, 1, 1); PG8_STAGE(PG8_SB(1, 0), b3, voffB); PG8_STAGE(PG8_SB(1, 1), b3 + hstep, voffB); PG8_STAGE(PG8_SA(1, 0), a3, o2[0]);
            PG8_WAIT_V(8); PG8_WAIT_L(0); PG8_BAR; PG8_MMA(1, 0, At, B0); PG8_MMA(1, 1, At, B1); PG8_BAR; PG8_SCHED;
        }
        if constexpr (ALIGN_EPI) { if (wr == 0) PG8_BAR; }
        if constexpr (MODE == 2) asm volatile("s_nop 15\n\ts_nop 15" ::: "memory");
        { Unit ue = cur; int fr_e = fr, fq_e = fq; asm volatile("" : "+s"(ue.pm), "+s"(ue.pn), "+s"(ue.aux), "+v"(fr_e), "+v"(fq_e));
          if constexpr (MODE == 1) E(acc, ue, wr, wc, fr_e, fq_e, sclb + (ui & 1) * 512); else E(acc, ue, wr, wc, fr_e, fq_e); }
        if (!has_next) break;
#pragma unroll
        for (int a = 0; a < 2; ++a)
#pragma unroll
            for (int b = 0; b < 2; ++b)
#pragma unroll
                for (int m = 0; m < 4; ++m)
#pragma unroll
                    for (int n = 0; n < 2; ++n) { typedef double f64x2 __attribute__((ext_vector_type(2))); double z0, z1;
                        asm("v_mov_b64 %0, 0" : "=v"(z0)); asm("v_mov_b64 %0, 0" : "=v"(z1)); acc[a][b][m][n] = __builtin_bit_cast(AccT, (f64x2){z0, z1}); }
        cur = nxt; cA = nA; cB = nB; ++ui;
        PG8_SCALE_DMA(cur, ui & 1);
        if constexpr (GATHER) {
#pragma unroll
        for (int _h = 0; _h < 2; ++_h)
#pragma unroll
            for (int _i = 0; _i < 2; ++_i) vAc[_h][_i] = vAn[_h][_i]; }
        if constexpr (ALIGN_EPI) { if (wr == 1) PG8_BAR; }
    }
    PG8_WAIT_V(0);
    if constexpr (!ALIGN_EPI) { if (wr == 0) PG8_BAR; }
    PG8_BAR;
#undef PG8_SA
#undef PG8_SB
#undef PG8_STAGE
#undef PG8_LDA
#undef PG8_LDB
#undef PG8_MMA
#undef PG8_WAIT_V
#undef PG8_WAIT_L
#undef PG8_BAR
#undef PG8_SCHED
#undef PG8_LOAD_VA
#undef PG8_SCALE_DMA
}
}

constexpr int NWAVES = 8, NTHR = NWAVES * 64;
constexpr int BATCH = 32, SEQ = 2048, D = 1024, M = BATCH * SEQ;
constexpr int NAB = 3072, IN_AB = 3080, HD = 64, NH = 8;
constexpr int DFF = 2816, NGU = 2 * DFF;
constexpr int NC = 4096, HK = 128;
constexpr int NEXP = 8, DFFE = 3584, NGUE = 2 * DFFE;
constexpr float EPS = 1e-6f;
constexpr float LOG2E = 1.4426950408889634f;
constexpr float QSCALE_AB = 0.125f * LOG2E;
constexpr float QSCALE_C = 0.08838834764831845f;
constexpr int PCHUNK = 128, NPMAX = 520, NMCH = 4;
constexpr int NPHASE = 13 + 2 * NMCH + 1;

constexpr size_t MiB = 1u << 20;
constexpr size_t WS_CTL = 0, CTL_ZERO_BYTES = 64 * 1024;
constexpr size_t WS_ROPE = 1 * MiB;
constexpr size_t WS_LOGF = 5 * MiB;
constexpr size_t WS_CUM = 7 * MiB;
constexpr size_t WS_TOPI = 9 * MiB;
constexpr size_t WS_TOPG = 9 * MiB + 256 * 1024;
constexpr size_t WS_RANK = 9 * MiB + 768 * 1024;
constexpr size_t WS_POS = 10 * MiB + 256 * 1024;
constexpr size_t WS_ROWMAP = 10 * MiB + 768 * 1024;
constexpr size_t WS_CNT = 11 * MiB + 512 * 1024;
constexpr size_t WS_META = 11 * MiB + 768 * 1024;
constexpr size_t WS_SA = 12 * MiB;
constexpr size_t WS_SAS = 12 * MiB + 512 * 1024;
constexpr size_t WS_SBD = 13 * MiB + 256 * 1024;
constexpr size_t WS_SBM = 13 * MiB + 512 * 1024;
constexpr size_t WS_SBAB = 13 * MiB + 768 * 1024;
constexpr size_t WS_SBC = 13 * MiB + 832 * 1024;
constexpr size_t WS_WINAB = 16 * MiB, WS_WOUTAB = 22 * MiB, WS_WGU = 24 * MiB, WS_WDOWN = 35 * MiB, WS_WINC = 41 * MiB, WS_WOUTC = 49 * MiB, WS_WGUM = 51 * MiB, WS_WDOWNM = 163 * MiB;
constexpr size_t WS_XN = 224 * MiB;
constexpr size_t WS_BIG = 352 * MiB;
constexpr size_t WS_Y = 580 * MiB;
constexpr size_t WS_END = 1024 * MiB;
static_assert(WS_WDOWNM + (size_t)NEXP * D * DFFE * 2 <= WS_XN && WS_BIG + (size_t)M * NC * 2 <= WS_END && WS_BIG + (size_t)(PCHUNK + 8) * 256 * DFFE <= WS_Y && WS_Y + (size_t)NPMAX * 256 * D * 2 <= WS_END, "ws map");
constexpr int CW_TMO = 0, CW_BAR = 4096, CW_WMAX = 8192;

constexpr int RING_OFF = 0, RING_BYTES = 131072;
constexpr int LDSCTL_OFF = RING_BYTES, MISC_OFF = LDSCTL_OFF + 320;
constexpr int LDS_BYTES = 147456;

#define GAS __attribute__((address_space(1)))
#define LAS __attribute__((address_space(3)))
typedef unsigned short bf16;
typedef unsigned v4u __attribute__((ext_vector_type(4)));
typedef unsigned v2u __attribute__((ext_vector_type(2)));
typedef float f32x4 __attribute__((ext_vector_type(4)));
typedef GAS unsigned gu32;
#define RLX_AGENT __ATOMIC_RELAXED, __HIP_MEMORY_SCOPE_AGENT
#define LDS_WAIT() asm volatile("s_waitcnt lgkmcnt(0)" ::: "memory")
#define VM_WAIT() asm volatile("s_waitcnt vmcnt(0)" ::: "memory")
__device__ __forceinline__ unsigned f2bf(float f) { unsigned u = __builtin_bit_cast(unsigned, f); return (u + 0x7fffu + ((u >> 16) & 1u)) >> 16; }
__device__ __forceinline__ unsigned pk2(float lo, float hi) { return f2bf(lo) | (f2bf(hi) << 16); }
__device__ __forceinline__ float bflo(unsigned u) { return __uint_as_float(u << 16); }
__device__ __forceinline__ float bfhi(unsigned u) { return __uint_as_float(u & 0xffff0000u); }
__device__ __forceinline__ float bf1(bf16 h) { return __uint_as_float((unsigned)h << 16); }

#define XB_TMO      128
#define XB_XCNT(j)  (256  + 64 * (j))
#define XB_XSUB(j)  (1280 + 64 * (j))
#define XB_XGEN(j)  (2304 + 64 * (j))
#define XB_TOP      3328
#define XB_TOPGEN   3392
#define XCD_BAR_WORDS 3456
#define XB_SPIN_CAP (1u << 22)
__device__ __forceinline__ unsigned xb_ld(unsigned* p)              { return __hip_atomic_load(p, __ATOMIC_RELAXED, __HIP_MEMORY_SCOPE_AGENT); }
__device__ __forceinline__ unsigned xb_add(unsigned* p, unsigned v) { return __hip_atomic_fetch_add(p, v, __ATOMIC_RELAXED, __HIP_MEMORY_SCOPE_AGENT); }
__device__ __forceinline__ unsigned xb_xcc_id() { return (unsigned)__builtin_amdgcn_s_getreg((3 << 11) | 20) & 0xFu; }
#define XB_SPIN(cond, bar) do { unsigned _sp = 0; while (cond) { __builtin_amdgcn_s_sleep(1); \
    if ((++_sp & 255u) == 0u) { if (xb_ld(&(bar)[XB_TMO])) break; if (_sp > XB_SPIN_CAP) { atomicAdd(&(bar)[XB_TMO], 1u); break; } } } } while (0)
struct XcdBarrier { unsigned* bar; unsigned x; volatile LAS unsigned* st; };
__device__ __forceinline__ XcdBarrier xcd_barrier_post(unsigned* bar, volatile LAS unsigned* st, bool t0) {
    XcdBarrier b; b.bar = bar; b.x = xb_xcc_id(); b.st = st;
    if (t0) (void)xb_add(&bar[XB_XCNT(b.x)], 1u);
    return b;
}
__device__ __forceinline__ void xcd_barrier_complete(unsigned* bar, unsigned x, unsigned& nloc, unsigned& nx) {
    const unsigned G = gridDim.x * gridDim.y * gridDim.z;
    unsigned sum, cnt, mine, sp = 0u;
    for (;;) {
        sum = 0u; cnt = 0u; mine = 0u;
#pragma unroll
        for (unsigned j = 0; j < 16; ++j) { const unsigned c = xb_ld(&bar[XB_XCNT(j)]); sum += c; cnt += (c > 0u) ? 1u : 0u; mine = (j == x) ? c : mine; }
        if (sum == G) break;
        __builtin_amdgcn_s_sleep(1);
        if ((++sp & 255u) == 0u) { if (xb_ld(&bar[XB_TMO])) break; if (sp > XB_SPIN_CAP) { atomicAdd(&bar[XB_TMO], 1u); break; } }
    }
    nloc = mine > 0u ? mine : 1u; nx = cnt > 0u ? cnt : 1u;
}
__device__ __forceinline__ void xcd_barrier(const XcdBarrier& b, bool t0) {
    asm volatile("s_waitcnt vmcnt(0)" ::: "memory");
    __syncthreads();
    if (t0) {
        unsigned* bar = b.bar;
        __builtin_amdgcn_s_waitcnt(0);
        unsigned nloc = b.st[0], nx = b.st[1];
        if (nloc == 0u) { xcd_barrier_complete(bar, b.x, nloc, nx); b.st[0] = nloc; b.st[1] = nx; }
        const unsigned old = xb_add(&bar[XB_XSUB(b.x)], 1u);
        const unsigned gen = old / nloc;
        if (old + 1u == (gen + 1u) * nloc) {
            __builtin_amdgcn_fence(__ATOMIC_RELEASE, "agent");
            asm volatile("s_waitcnt vmcnt(0)" ::: "memory");
            const unsigned og = xb_add(&bar[XB_TOP], 1u);
            const unsigned tg = og / nx;
            if (og + 1u == (tg + 1u) * nx) xb_add(&bar[XB_TOPGEN], 1u);
            else XB_SPIN(xb_ld(&bar[XB_TOPGEN]) == tg, bar);
            __builtin_amdgcn_fence(__ATOMIC_ACQUIRE, "agent");
            xb_add(&bar[XB_XGEN(b.x)], 1u);
            asm volatile("s_waitcnt vmcnt(0)" ::: "memory");
        } else {
            XB_SPIN(xb_ld(&bar[XB_XGEN(b.x)]) == gen, bar);
            __builtin_amdgcn_fence(__ATOMIC_ACQUIRE, "agent");
            asm volatile("s_waitcnt vmcnt(0)" ::: "memory");
        }
    }
    __syncthreads();
}

__device__ __forceinline__ int lane_id() { int l; asm volatile("v_mbcnt_lo_u32_b32 %0, -1, 0\n\tv_mbcnt_hi_u32_b32 %0, -1, %0" : "=v"(l)); return l; }
template <int CTRL> __device__ __forceinline__ float dpp_f(float v) { return __int_as_float(__builtin_amdgcn_update_dpp(0, __float_as_int(v), CTRL, 0xf, 0xf, true)); }
__device__ __forceinline__ float wave_sum(float v) {
    v += dpp_f<0xB1>(v); v += dpp_f<0x4E>(v); v += dpp_f<0x141>(v); v += dpp_f<0x140>(v);
    { auto r = __builtin_amdgcn_permlane16_swap(__float_as_uint(v), __float_as_uint(v), false, false); v = __uint_as_float(r[0]) + __uint_as_float(r[1]); }
    { auto r = __builtin_amdgcn_permlane32_swap(__float_as_uint(v), __float_as_uint(v), false, false); v = __uint_as_float(r[0]) + __uint_as_float(r[1]); }
    return v;
}
__device__ __forceinline__ float wave_max(float v) {
    v = fmaxf(v, dpp_f<0xB1>(v)); v = fmaxf(v, dpp_f<0x4E>(v)); v = fmaxf(v, dpp_f<0x141>(v)); v = fmaxf(v, dpp_f<0x140>(v));
    { auto r = __builtin_amdgcn_permlane16_swap(__float_as_uint(v), __float_as_uint(v), false, false); v = fmaxf(__uint_as_float(r[0]), __uint_as_float(r[1])); }
    { auto r = __builtin_amdgcn_permlane32_swap(__float_as_uint(v), __float_as_uint(v), false, false); v = fmaxf(__uint_as_float(r[0]), __uint_as_float(r[1])); }
    return v;
}
__device__ __forceinline__ float sigmoidf_(float z) { return 1.f / (1.f + __expf(-z)); }
__device__ __forceinline__ float sigm_fast(float z) { return __builtin_amdgcn_rcpf(1.f + __builtin_amdgcn_exp2f(-1.4426950408889634f * z)); }

__device__ __forceinline__ void transpose_item(const float* W, int ldw, int K, bf16* WT, int k0, int n0, int dst_row0, LAS float* scr, int lane) {
#pragma unroll 16
    for (int i = 0; i < 32; ++i) { const int kk = 2 * i + (lane >> 5); scr[kk * 33 + (lane & 31)] = W[(size_t)(k0 + kk) * ldw + n0 + (lane & 31)]; }
    LDS_WAIT(); asm volatile("" ::: "memory");
    const int c = lane & 7;
#pragma unroll
    for (int j = 0; j < 4; ++j) { const int n = (lane >> 3) + 8 * j; const LAS float* s = scr + (8 * c) * 33 + n;
        v4u o; o.x = pk2(s[0 * 33], s[1 * 33]); o.y = pk2(s[2 * 33], s[3 * 33]); o.z = pk2(s[4 * 33], s[5 * 33]); o.w = pk2(s[6 * 33], s[7 * 33]);
        *(GAS v4u*)(WT + (size_t)(dst_row0 + n) * K + k0 + 8 * c) = o; }
    LDS_WAIT(); asm volatile("" ::: "memory");
}


typedef float f32x16 __attribute__((ext_vector_type(16)));
typedef short s16x4 __attribute__((ext_vector_type(4)));
typedef short v4i16_t __attribute__((ext_vector_type(4)));
typedef short bf16x8v __attribute__((ext_vector_type(8)));
typedef float f32x2_t __attribute__((ext_vector_type(2))); typedef __bf16 bf16x2_t __attribute__((ext_vector_type(2)));
__device__ __forceinline__ unsigned cvtpk_s(float lo, float hi) { f32x2_t v = {lo, hi}; bf16x2_t b = __builtin_convertvector(v, bf16x2_t); return __builtin_bit_cast(unsigned, b); }
__device__ __forceinline__ s16x4 vtr(const LAS unsigned char* p) { return __builtin_bit_cast(s16x4, __builtin_amdgcn_ds_read_tr16_b64_v4i16((LAS v4i16_t*)p)); }
__device__ __forceinline__ float max3f(float a, float b, float c) { float r; asm("v_max3_f32 %0, %1, %2, %3" : "=v"(r) : "v"(a), "v"(b), "v"(c)); return r; }
__device__ __forceinline__ float max2f(float a, float b) { float r; asm("v_max_f32_e32 %0, %1, %2" : "=v"(r) : "v"(a), "v"(b)); return r; }
typedef float f32x16r __attribute__((ext_vector_type(16)));
__device__ __forceinline__ float rowmax16(f32x16r& s) {
    asm volatile("s_nop 15\n\ts_nop 7" : "+v"(s));
    float a = max3f(s[0], s[1], s[2]), b = max3f(s[3], s[4], s[5]);
    a = max3f(a, s[6], s[7]); b = max3f(b, s[8], s[9]); a = max3f(a, s[10], s[11]); b = max3f(b, s[12], s[13]); a = max3f(a, s[14], s[15]);
    float m = max2f(a, b);
    auto rr = __builtin_amdgcn_permlane32_swap(__float_as_uint(m), __float_as_uint(m), false, false);
    return max2f(__uint_as_float(rr[0]), __uint_as_float(rr[1]));
}
__device__ __forceinline__ float halfmax(float m) { auto rr = __builtin_amdgcn_permlane32_swap(__float_as_uint(m), __float_as_uint(m), false, false); return fmaxf(__uint_as_float(rr[0]), __uint_as_float(rr[1])); }
__device__ __forceinline__ float halfsum(float m) { auto rr = __builtin_amdgcn_permlane32_swap(__float_as_uint(m), __float_as_uint(m), false, false); return __uint_as_float(rr[0]) + __uint_as_float(rr[1]); }
struct FlashSt { float m, l; f32x16 o0, o1; };
template <bool HAS_BIAS>
__device__ __forceinline__ void flash_tiles(FlashSt& st, const bf16x8v (&qf)[4], const bf16* Kb, const bf16* Vb, int tok0, int stride, int ntiles, int tstep, int LQ, int LK0, int W,
                                            const LAS float* cumL, LAS unsigned char* vbuf, int lane) {
    const int r32 = lane & 31, hi = lane >> 5, vj = lane >> 3, vc = lane & 7;
    LAS unsigned char* const vw = vbuf + (vc >> 2) * 2048 + vj * 64 + (vc & 3) * 16;
    const LAS unsigned char* const vr = vbuf + ((lane >> 4) & 1) * 32 + (lane & 3) * 8 + (4 * hi + ((lane & 15) >> 2)) * 64;
    bf16x8v kf[4]; v4u vch[4];
#define FL_LOAD(KT, KF, VCH) do { const int t0_ = tok0 + (KT) * tstep; int tk_ = t0_ + stride * r32; tk_ = tk_ < 0 ? 0 : tk_; const bf16* kp_ = Kb + (size_t)tk_ * NAB + 8 * hi; \
        _Pragma("unroll") for (int d0 = 0; d0 < 4; ++d0) KF[d0] = *(const bf16x8v*)(kp_ + 16 * d0); \
        _Pragma("unroll") for (int i = 0; i < 4; ++i) { int tv_ = t0_ + stride * (vj + 8 * i); tv_ = tv_ < 0 ? 0 : tv_; VCH[i] = *(const v4u*)(Vb + (size_t)tv_ * NAB + 8 * vc); } } while (0)
    FL_LOAD(0, kf, vch);
    for (int kt = 0; kt < ntiles; ++kt) {
        bf16x8v kfn[4]; v4u vchn[4];
        { const int ktn = (kt + 1 < ntiles) ? kt + 1 : kt; FL_LOAD(ktn, kfn, vchn); }
#pragma unroll
        for (int i = 0; i < 4; ++i) *(LAS v4u*)(vw + i * 512) = vch[i];
        asm volatile("s_waitcnt lgkmcnt(0)" ::: "memory");
        f32x16 s; const int LKt = LK0 + 32 * kt;
        if (HAS_BIAS) { const LAS float* cp = cumL + tok0 + kt * tstep + 4 * hi;
#pragma unroll
            for (int g = 0; g < 4; ++g) { const f32x4 c4 = *(const LAS f32x4*)(cp + 8 * g);
#pragma unroll
                for (int c = 0; c < 4; ++c) s[4 * g + c] = -c4[c]; } }
        else {
#pragma unroll
            for (int r = 0; r < 16; ++r) s[r] = 0.f; }
        { const int e = LQ - LKt - 4 * hi; int lo = e - W; const int lo3 = -LKt - 4 * hi; lo = lo > lo3 ? lo : lo3;
          if (!__all(lo <= 0 && e >= 27)) {
#pragma unroll
              for (int r = 0; r < 16; ++r) { const int jr = (r & 3) + 8 * (r >> 2); if (jr < lo || jr > e) s[r] = -INFINITY; } } }
        asm volatile("" : "+v"(s));
#pragma unroll
        for (int d0 = 0; d0 < 4; ++d0) s = __builtin_amdgcn_mfma_f32_32x32x16_bf16(kf[d0], qf[d0], s, 0, 0, 0);
        const float mloc = rowmax16(s);
        const float mnew = fmaxf(st.m, mloc); const float alpha = __builtin_amdgcn_exp2f(st.m - mnew); st.m = mnew;
        float lsum = 0.f;
#pragma unroll
        for (int r = 0; r < 16; ++r) { s[r] = __builtin_amdgcn_exp2f(s[r] - mnew); lsum += s[r]; }
        st.l = st.l * alpha + lsum;
        if (__any(alpha != 1.f)) { st.o0 = st.o0 * alpha; st.o1 = st.o1 * alpha; }
        v4u pw0, pw1;
        pw0.x = cvtpk_s(s[0], s[1]); pw0.y = cvtpk_s(s[2], s[3]); pw0.z = cvtpk_s(s[4], s[5]); pw0.w = cvtpk_s(s[6], s[7]);
        pw1.x = cvtpk_s(s[8], s[9]); pw1.y = cvtpk_s(s[10], s[11]); pw1.z = cvtpk_s(s[12], s[13]); pw1.w = cvtpk_s(s[14], s[15]);
        const bf16x8v pf0 = __builtin_bit_cast(bf16x8v, pw0), pf1 = __builtin_bit_cast(bf16x8v, pw1);
#define FL_VF(D0, KS) ({ const s16x4 lo_ = vtr(vr + (D0) * 2048 + (KS) * 1024), hi_ = vtr(vr + (D0) * 2048 + (KS) * 1024 + 512); (bf16x8v){lo_[0], lo_[1], lo_[2], lo_[3], hi_[0], hi_[1], hi_[2], hi_[3]}; })
        { const bf16x8v a00 = FL_VF(0, 0), a01 = FL_VF(0, 1), a10 = FL_VF(1, 0), a11 = FL_VF(1, 1);
          st.o0 = __builtin_amdgcn_mfma_f32_32x32x16_bf16(a00, pf0, st.o0, 0, 0, 0); st.o0 = __builtin_amdgcn_mfma_f32_32x32x16_bf16(a01, pf1, st.o0, 0, 0, 0);
          st.o1 = __builtin_amdgcn_mfma_f32_32x32x16_bf16(a10, pf0, st.o1, 0, 0, 0); st.o1 = __builtin_amdgcn_mfma_f32_32x32x16_bf16(a11, pf1, st.o1, 0, 0, 0); }
#undef FL_VF
        asm volatile("s_waitcnt lgkmcnt(0)" ::: "memory");
#pragma unroll
        for (int d0 = 0; d0 < 4; ++d0) kf[d0] = kfn[d0];
#pragma unroll
        for (int i = 0; i < 4; ++i) vch[i] = vchn[i];
    }
#undef FL_LOAD
}
__device__ __forceinline__ void flash_tiles2(FlashSt (&st)[2], const bf16x8v (&qf)[2][4], const bf16* Kb, const bf16* Vb, int tok0, int stride, int ntiles, int tstep, const int (&LQ)[2], const int (&LQb)[2], int LK0, int W,
                                             LAS unsigned char* vbuf, int lane) {
    const int r32 = lane & 31, hi = lane >> 5, vj = lane >> 3, vc = lane & 7;
    LAS unsigned char* const vw = vbuf + (vc >> 2) * 2048 + vj * 64 + (vc & 3) * 16;
    const LAS unsigned char* const vr = vbuf + ((lane >> 4) & 1) * 32 + (lane & 3) * 8 + (4 * hi + ((lane & 15) >> 2)) * 64;
    bf16x8v kf[4]; v4u vch[4];
#define FL_LOAD(KT, KF, VCH) do { const int t0_ = tok0 + (KT) * tstep; int tk_ = t0_ + stride * r32; tk_ = tk_ < 0 ? 0 : tk_; const bf16* kp_ = Kb + (size_t)tk_ * NAB + 8 * hi; \
        _Pragma("unroll") for (int d0 = 0; d0 < 4; ++d0) KF[d0] = *(const bf16x8v*)(kp_ + 16 * d0); \
        _Pragma("unroll") for (int i = 0; i < 4; ++i) { int tv_ = t0_ + stride * (vj + 8 * i); tv_ = tv_ < 0 ? 0 : tv_; VCH[i] = *(const v4u*)(Vb + (size_t)tv_ * NAB + 8 * vc); } } while (0)
    FL_LOAD(0, kf, vch);
    for (int kt = 0; kt < ntiles; ++kt) {
        bf16x8v kfn[4]; v4u vchn[4];
        { const int ktn = (kt + 1 < ntiles) ? kt + 1 : kt; FL_LOAD(ktn, kfn, vchn); }
#pragma unroll
        for (int i = 0; i < 4; ++i) *(LAS v4u*)(vw + i * 512) = vch[i];
        asm volatile("s_waitcnt lgkmcnt(0)" ::: "memory");
        const int LKt = LK0 + 32 * kt;
#define FL_VF(D0, KS) ({ const s16x4 lo_ = vtr(vr + (D0) * 2048 + (KS) * 1024), hi_ = vtr(vr + (D0) * 2048 + (KS) * 1024 + 512); (bf16x8v){lo_[0], lo_[1], lo_[2], lo_[3], hi_[0], hi_[1], hi_[2], hi_[3]}; })
        const bf16x8v a00 = FL_VF(0, 0), a01 = FL_VF(0, 1), a10 = FL_VF(1, 0), a11 = FL_VF(1, 1);
#undef FL_VF
#pragma unroll
        for (int q = 0; q < 2; ++q) if (LKt <= LQb[q] + 31 && LKt + 31 >= LQb[q] - W && LKt + 31 >= 0) {
            f32x16 s;
#pragma unroll
            for (int r = 0; r < 16; ++r) s[r] = 0.f;
            { const int e = LQ[q] - LKt - 4 * hi; int lo = e - W; const int lo3 = -LKt - 4 * hi; lo = lo > lo3 ? lo : lo3;
              if (!__all(lo <= 0 && e >= 27)) {
#pragma unroll
                  for (int r = 0; r < 16; ++r) { const int jr = (r & 3) + 8 * (r >> 2); if (jr < lo || jr > e) s[r] = -INFINITY; } } }
            asm volatile("" : "+v"(s));
#pragma unroll
            for (int d0 = 0; d0 < 4; ++d0) s = __builtin_amdgcn_mfma_f32_32x32x16_bf16(kf[d0], qf[q][d0], s, 0, 0, 0);
            const float mloc = rowmax16(s);
            const float mnew = fmaxf(st[q].m, mloc); const float alpha = __builtin_amdgcn_exp2f(st[q].m - mnew); st[q].m = mnew;
            float lsum = 0.f;
#pragma unroll
            for (int r = 0; r < 16; ++r) { s[r] = __builtin_amdgcn_exp2f(s[r] - mnew); lsum += s[r]; }
            st[q].l = st[q].l * alpha + lsum;
            if (__any(alpha != 1.f)) { st[q].o0 = st[q].o0 * alpha; st[q].o1 = st[q].o1 * alpha; }
            v4u pw0, pw1;
            pw0.x = cvtpk_s(s[0], s[1]); pw0.y = cvtpk_s(s[2], s[3]); pw0.z = cvtpk_s(s[4], s[5]); pw0.w = cvtpk_s(s[6], s[7]);
            pw1.x = cvtpk_s(s[8], s[9]); pw1.y = cvtpk_s(s[10], s[11]); pw1.z = cvtpk_s(s[12], s[13]); pw1.w = cvtpk_s(s[14], s[15]);
            const bf16x8v pf0 = __builtin_bit_cast(bf16x8v, pw0), pf1 = __builtin_bit_cast(bf16x8v, pw1);
            st[q].o0 = __builtin_amdgcn_mfma_f32_32x32x16_bf16(a00, pf0, st[q].o0, 0, 0, 0); st[q].o0 = __builtin_amdgcn_mfma_f32_32x32x16_bf16(a01, pf1, st[q].o0, 0, 0, 0);
            st[q].o1 = __builtin_amdgcn_mfma_f32_32x32x16_bf16(a10, pf0, st[q].o1, 0, 0, 0); st[q].o1 = __builtin_amdgcn_mfma_f32_32x32x16_bf16(a11, pf1, st[q].o1, 0, 0, 0);
        }
        asm volatile("s_waitcnt lgkmcnt(0)" ::: "memory");
#pragma unroll
        for (int d0 = 0; d0 < 4; ++d0) kf[d0] = kfn[d0];
#pragma unroll
        for (int i = 0; i < 4; ++i) vch[i] = vchn[i];
    }
#undef FL_LOAD
}
__device__ __forceinline__ void flash_init(FlashSt& st) { st.m = -1e30f; st.l = 0.f;
#pragma unroll
    for (int r = 0; r < 16; ++r) { st.o0[r] = 0.f; st.o1[r] = 0.f; } }
__device__ __forceinline__ void flash_store(const FlashSt& st, bf16* orow, int lane) {
    const int hi = lane >> 5; const float inv = 1.f / halfsum(st.l);
    bf16* const dst = orow + 8 * hi;
#pragma unroll
    for (int kk = 0; kk < 4; ++kk) {
        const int g0 = (2 * kk) & 3, g1 = (2 * kk + 1) & 3;
        unsigned ax, ay, bx, by;
        if (kk < 2) { ax = cvtpk_s(st.o0[4 * g0] * inv, st.o0[4 * g0 + 1] * inv); ay = cvtpk_s(st.o0[4 * g0 + 2] * inv, st.o0[4 * g0 + 3] * inv);
                      bx = cvtpk_s(st.o0[4 * g1] * inv, st.o0[4 * g1 + 1] * inv); by = cvtpk_s(st.o0[4 * g1 + 2] * inv, st.o0[4 * g1 + 3] * inv); }
        else        { ax = cvtpk_s(st.o1[4 * g0] * inv, st.o1[4 * g0 + 1] * inv); ay = cvtpk_s(st.o1[4 * g0 + 2] * inv, st.o1[4 * g0 + 3] * inv);
                      bx = cvtpk_s(st.o1[4 * g1] * inv, st.o1[4 * g1 + 1] * inv); by = cvtpk_s(st.o1[4 * g1 + 2] * inv, st.o1[4 * g1 + 3] * inv); }
        { auto r = __builtin_amdgcn_permlane32_swap(ax, bx, false, false); ax = r[0]; bx = r[1]; }
        { auto r = __builtin_amdgcn_permlane32_swap(ay, by, false, false); ay = r[0]; by = r[1]; }
        v4u w; w.x = ax; w.y = ay; w.z = bx; w.w = by;
        *(v4u*)(dst + 16 * kk) = w; }
}

__device__ __forceinline__ void quant_item(const float* W, int ldw, int K, signed char* WQ, float* sb, int n0, int dst_row0, LAS float* scr, int lane) {
    float cmax = 0.f;
#pragma nounroll
    for (int k0 = 0; k0 < K; k0 += 64) {
#pragma unroll
        for (int i = 0; i < 32; ++i) { const int kk = 2 * i + (lane >> 5); cmax = fmaxf(cmax, fabsf(W[(size_t)(k0 + kk) * ldw + n0 + (lane & 31)])); } }
    cmax = halfmax(cmax);
    const float sc = cmax > 0.f ? cmax * (1.f / 127.f) : 1.f;
    LAS float* scl = scr + 64 * 33;
    if (lane < 32) { scl[lane] = 1.f / sc; sb[dst_row0 + lane] = sc; }
    LDS_WAIT(); asm volatile("" ::: "memory");
    const int c = lane & 7;
#pragma nounroll
    for (int k0 = 0; k0 < K; k0 += 64) {
        LAS float* scr_ = scr; asm volatile("" : "+v"(scr_));
#pragma unroll 16
        for (int i = 0; i < 32; ++i) { const int kk = 2 * i + (lane >> 5); scr_[kk * 33 + (lane & 31)] = W[(size_t)(k0 + kk) * ldw + n0 + (lane & 31)]; }
        LDS_WAIT(); asm volatile("" ::: "memory");
#pragma unroll
        for (int j = 0; j < 4; ++j) { const int n = (lane >> 3) + 8 * j; const LAS float* sp = scr_ + (8 * c) * 33 + n; const float is = scl[n];
            int q[8];
#pragma unroll
            for (int e = 0; e < 8; ++e) q[e] = (int)rintf(sp[e * 33] * is) & 0xff;
            v2u o; o.x = (unsigned)q[0] | ((unsigned)q[1] << 8) | ((unsigned)q[2] << 16) | ((unsigned)q[3] << 24); o.y = (unsigned)q[4] | ((unsigned)q[5] << 8) | ((unsigned)q[6] << 16) | ((unsigned)q[7] << 24);
            *(GAS v2u*)(WQ + (size_t)(dst_row0 + n) * K + k0 + 8 * c) = o; }
        LDS_WAIT(); asm volatile("" ::: "memory");
    }
}


__device__ __forceinline__ void st_save(const FlashSt& st, LAS float* row) {
    *(LAS f32x2_t*)row = (f32x2_t){st.m, st.l};
#pragma unroll
    for (int g = 0; g < 4; ++g) { *(LAS f32x4*)(row + 4 + 4 * g) = (f32x4){st.o0[4 * g], st.o0[4 * g + 1], st.o0[4 * g + 2], st.o0[4 * g + 3]};
        *(LAS f32x4*)(row + 20 + 4 * g) = (f32x4){st.o1[4 * g], st.o1[4 * g + 1], st.o1[4 * g + 2], st.o1[4 * g + 3]}; }
}
__device__ __forceinline__ void st_load(FlashSt& st, const LAS float* row) {
    const f32x2_t ml = *(const LAS f32x2_t*)row; st.m = ml.x; st.l = ml.y;
#pragma unroll
    for (int g = 0; g < 4; ++g) { const f32x4 a = *(const LAS f32x4*)(row + 4 + 4 * g), b = *(const LAS f32x4*)(row + 20 + 4 * g);
#pragma unroll
        for (int c = 0; c < 4; ++c) { st.o0[4 * g + c] = a[c]; st.o1[4 * g + c] = b[c]; } }
}
__device__ __forceinline__ void st_save16(const FlashSt& st, LAS unsigned char* row) {
#pragma unroll
    for (int g = 0; g < 2; ++g) { v4u a, b;
        a.x = cvtpk_s(st.o0[8 * g], st.o0[8 * g + 1]); a.y = cvtpk_s(st.o0[8 * g + 2], st.o0[8 * g + 3]); a.z = cvtpk_s(st.o0[8 * g + 4], st.o0[8 * g + 5]); a.w = cvtpk_s(st.o0[8 * g + 6], st.o0[8 * g + 7]);
        b.x = cvtpk_s(st.o1[8 * g], st.o1[8 * g + 1]); b.y = cvtpk_s(st.o1[8 * g + 2], st.o1[8 * g + 3]); b.z = cvtpk_s(st.o1[8 * g + 4], st.o1[8 * g + 5]); b.w = cvtpk_s(st.o1[8 * g + 6], st.o1[8 * g + 7]);
        *(LAS v4u*)(row + 16 * g) = a; *(LAS v4u*)(row + 32 + 16 * g) = b; }
    *(LAS f32x2_t*)(row + 64) = (f32x2_t){st.m, st.l};
}
__device__ __forceinline__ void st_load16(FlashSt& st, const LAS unsigned char* row) {
#pragma unroll
    for (int g = 0; g < 2; ++g) { const v4u a = *(const LAS v4u*)(row + 16 * g), b = *(const LAS v4u*)(row + 32 + 16 * g);
        st.o0[8 * g] = bflo(a.x); st.o0[8 * g + 1] = bfhi(a.x); st.o0[8 * g + 2] = bflo(a.y); st.o0[8 * g + 3] = bfhi(a.y); st.o0[8 * g + 4] = bflo(a.z); st.o0[8 * g + 5] = bfhi(a.z); st.o0[8 * g + 6] = bflo(a.w); st.o0[8 * g + 7] = bfhi(a.w);
        st.o1[8 * g] = bflo(b.x); st.o1[8 * g + 1] = bfhi(b.x); st.o1[8 * g + 2] = bflo(b.y); st.o1[8 * g + 3] = bfhi(b.y); st.o1[8 * g + 4] = bflo(b.z); st.o1[8 * g + 5] = bfhi(b.z); st.o1[8 * g + 6] = bflo(b.w); st.o1[8 * g + 7] = bfhi(b.w); }
    const f32x2_t ml = *(const LAS f32x2_t*)(row + 64); st.m = ml.x; st.l = ml.y;
}
template <bool HAS_BIAS, int NQ, int SUB = 1>
__device__ __forceinline__ void coop_block(FlashSt (&st)[NQ], const bf16x8v (&qf)[NQ][4], const bf16* Kb, const bf16* Vb, int T0, int NT, const int (&LQ)[NQ], int W, const int (&qlast)[NQ], const int (&kmin)[NQ], const LAS float* cumL, LAS unsigned char* stage, int wave, int lane) {
    const int r32 = lane & 31, h5 = lane >> 5;
    const int drow = 8 * wave + (lane >> 3);
    const bf16* const ksrc = Kb + 8 * ((lane & 7) ^ (lane >> 3));
    const bf16* const vsrc = Vb + 8 * ((lane & 7) ^ (((lane >> 4) & 1) << 2));
    const LAS unsigned char* const kr = stage + r32 * 128;
    const int trq_ = (lane & 15) >> 2;
    const LAS unsigned char* const vr = stage + 8192 + (4 * h5 + trq_) * 128 + ((lane >> 4) & 1) * 32 + (lane & 3) * 8;
#define CB_DMA(T, B) do { _Pragma("unroll") for (int sb_ = 0; sb_ < SUB; ++sb_) { int rk_ = T0 + 64 * SUB * (T) + 64 * sb_ + drow; rk_ = rk_ < 0 ? 0 : rk_; \
        __builtin_amdgcn_global_load_lds((const unsigned*)(ksrc + (size_t)rk_ * NAB), (LAS unsigned*)(stage + ((B) * SUB + sb_) * 16384 + wave * 1024), 16, 0, 0); \
        __builtin_amdgcn_global_load_lds((const unsigned*)(vsrc + (size_t)rk_ * NAB), (LAS unsigned*)(stage + ((B) * SUB + sb_) * 16384 + 8192 + wave * 1024), 16, 0, 0); } } while (0)
    CB_DMA(NT - 1, 0);
    for (int tt = 0; tt < NT; ++tt) { const int t = NT - 1 - tt;
        asm volatile("s_waitcnt vmcnt(0)" ::: "memory"); __builtin_amdgcn_s_barrier(); asm volatile("" ::: "memory");
        if (tt + 1 < NT) CB_DMA(t - 1, (tt + 1) & 1);
        const int bo0 = (tt & 1) * SUB * 16384;
#pragma unroll
        for (int kq = 0; kq < 2 * SUB; ++kq) { const int kh2 = 2 * SUB - 1 - kq, kh = kh2 & 1, bo = bo0 + (kh2 >> 1) * 16384; const int k0 = T0 + 64 * SUB * t + 32 * kh2;
            bool need[NQ]; bool any = false;
#pragma unroll
            for (int q = 0; q < NQ; ++q) { need[q] = (k0 <= qlast[q]) && (k0 + 31 >= kmin[q]); any = any || need[q]; }
            if (any) {
                bf16x8v kf[4];
#pragma unroll
                for (int d0 = 0; d0 < 4; ++d0) kf[d0] = *(const LAS bf16x8v*)(kr + bo + kh * 4096 + (((2 * d0 + h5) ^ (r32 & 7)) << 4));
                f32x4 cb[4];
                if (HAS_BIAS) { const LAS float* cp = cumL + k0 + 4 * h5;
#pragma unroll
                    for (int g = 0; g < 4; ++g) cb[g] = *(const LAS f32x4*)(cp + 8 * g); }
                const LAS unsigned char* vb = vr + bo + kh * 4096;
#define FX_VF(DH, KS) ({ const s16x4 lo_ = vtr(vb + (((DH) ^ (trq_ >> 1)) * 64) + (KS) * 2048), hi_ = vtr(vb + (((DH) ^ (trq_ >> 1)) * 64) + (KS) * 2048 + 1024); (bf16x8v){lo_[0], lo_[1], lo_[2], lo_[3], hi_[0], hi_[1], hi_[2], hi_[3]}; })
                const bf16x8v a00 = FX_VF(0, 0), a01 = FX_VF(0, 1), a10 = FX_VF(1, 0), a11 = FX_VF(1, 1);
#undef FX_VF
#pragma unroll
                for (int q = 0; q < NQ; ++q) if (need[q]) {
                    f32x16 s;
                    if (HAS_BIAS) {
#pragma unroll
                        for (int g = 0; g < 4; ++g)
#pragma unroll
                            for (int c = 0; c < 4; ++c) s[4 * g + c] = cb[g][c]; }
                    else {
#pragma unroll
                        for (int r = 0; r < 16; ++r) s[r] = 0.f; }
                    { const int e = LQ[q] - k0 - 4 * h5; int lo = e - W; const int lo3 = -k0 - 4 * h5; lo = lo > lo3 ? lo : lo3;
                      if (!__all(lo <= 0 && e >= 27)) {
#pragma unroll
                          for (int r = 0; r < 16; ++r) { const int jr = (r & 3) + 8 * (r >> 2); if (jr < lo || jr > e) s[r] = -INFINITY; } } }
                    asm volatile("" : "+v"(s));
#pragma unroll
                    for (int d0 = 0; d0 < 4; ++d0) s = __builtin_amdgcn_mfma_f32_32x32x16_bf16(kf[d0], qf[q][d0], s, 0, 0, 0);
                    const float mloc = rowmax16(s);
                    const float mnew = fmaxf(st[q].m, mloc); const float alpha = __builtin_amdgcn_exp2f(st[q].m - mnew); st[q].m = mnew;
                    f32x2_t ls2 = {0.f, 0.f}; const f32x2_t mn2 = {mnew, mnew};
#pragma unroll
                    for (int r = 0; r < 16; r += 2) { f32x2_t d2 = (f32x2_t){s[r], s[r + 1]} - mn2; d2.x = __builtin_amdgcn_exp2f(d2.x); d2.y = __builtin_amdgcn_exp2f(d2.y); ls2 += d2; s[r] = d2.x; s[r + 1] = d2.y; }
                    st[q].l = st[q].l * alpha + (ls2.x + ls2.y);
                    if (__any(alpha != 1.f)) { st[q].o0 = st[q].o0 * alpha; st[q].o1 = st[q].o1 * alpha; }
                    v4u pw0, pw1;
                    pw0.x = cvtpk_s(s[0], s[1]); pw0.y = cvtpk_s(s[2], s[3]); pw0.z = cvtpk_s(s[4], s[5]); pw0.w = cvtpk_s(s[6], s[7]);
                    pw1.x = cvtpk_s(s[8], s[9]); pw1.y = cvtpk_s(s[10], s[11]); pw1.z = cvtpk_s(s[12], s[13]); pw1.w = cvtpk_s(s[14], s[15]);
                    const bf16x8v pf0 = __builtin_bit_cast(bf16x8v, pw0), pf1 = __builtin_bit_cast(bf16x8v, pw1);
                    st[q].o0 = __builtin_amdgcn_mfma_f32_32x32x16_bf16(a00, pf0, st[q].o0, 0, 0, 0); st[q].o0 = __builtin_amdgcn_mfma_f32_32x32x16_bf16(a01, pf1, st[q].o0, 0, 0, 0);
                    st[q].o1 = __builtin_amdgcn_mfma_f32_32x32x16_bf16(a10, pf0, st[q].o1, 0, 0, 0); st[q].o1 = __builtin_amdgcn_mfma_f32_32x32x16_bf16(a11, pf1, st[q].o1, 0, 0, 0);
                }
            }
        }
        asm volatile("s_waitcnt lgkmcnt(0)" ::: "memory");
    }
    __builtin_amdgcn_s_barrier(); asm volatile("" ::: "memory");
#undef CB_DMA
}

__device__ __forceinline__ void absmax_item(const float* W, int ldw, int k0, int n0, unsigned* wm, int lane) {
    float mx = 0.f;
#pragma unroll
    for (int i = 0; i < 32; ++i) { const int kk = 2 * i + (lane >> 5); mx = fmaxf(mx, fabsf(W[(size_t)(k0 + kk) * ldw + n0 + (lane & 31)])); }
    mx = wave_max(mx);
    if (lane == 0) atomicMax(wm, __float_as_uint(mx));
}
__device__ __forceinline__ void transpose_item_f8(const float* W, int ldw, int K, unsigned char* WT, int k0, int n0, int dst_row0, float sc, LAS float* scr, int lane) {
#pragma unroll 16
    for (int i = 0; i < 32; ++i) { const int kk = 2 * i + (lane >> 5); scr[kk * 33 + (lane & 31)] = W[(size_t)(k0 + kk) * ldw + n0 + (lane & 31)]; }
    LDS_WAIT(); asm volatile("" ::: "memory");
    const int c = lane & 7;
#pragma unroll
    for (int j = 0; j < 4; ++j) { const int n = (lane >> 3) + 8 * j; const LAS float* sp = scr + (8 * c) * 33 + n; float v[8];
#pragma unroll
        for (int e = 0; e < 8; ++e) v[e] = __builtin_amdgcn_fmed3f(sp[e * 33] * sc, -448.f, 448.f);
        int w0 = 0, w1 = 0;
        w0 = __builtin_amdgcn_cvt_pk_fp8_f32(v[0], v[1], w0, false); w0 = __builtin_amdgcn_cvt_pk_fp8_f32(v[2], v[3], w0, true);
        w1 = __builtin_amdgcn_cvt_pk_fp8_f32(v[4], v[5], w1, false); w1 = __builtin_amdgcn_cvt_pk_fp8_f32(v[6], v[7], w1, true);
        v2u o; o.x = (unsigned)w0; o.y = (unsigned)w1;
        *(GAS v2u*)(WT + (size_t)(dst_row0 + n) * K + k0 + 8 * c) = o; }
    LDS_WAIT(); asm volatile("" ::: "memory");
}

#define NORM_Q_ROW(v, rstd, gn, m) do { float am_ = 0.f; \
        _Pragma("unroll") for (int j = 0; j < 4; ++j) { v[j] = v[j] * rstd * gn[j]; am_ = fmaxf(am_, fmaxf(fmaxf(fabsf(v[j].x), fabsf(v[j].y)), fmaxf(fabsf(v[j].z), fabsf(v[j].w)))); } \
        am_ = wave_max(am_); \
        const float sc_ = am_ > 0.f ? am_ * (1.f / 127.f) : 1.f, is_ = 1.f / sc_; if (lane == 0) SA[m] = sc_; \
        GAS unsigned* q4_ = (GAS unsigned*)(XQ + (size_t)(m) * D) + lane; \
        _Pragma("unroll") for (int j = 0; j < 4; ++j) q4_[64 * j] = ((unsigned)((int)rintf(v[j].x * is_) & 0xff)) | ((unsigned)((int)rintf(v[j].y * is_) & 0xff) << 8) | ((unsigned)((int)rintf(v[j].z * is_) & 0xff) << 16) | ((unsigned)((int)rintf(v[j].w * is_) & 0xff) << 24); } while (0)
#define XROW4(MROW, J) ({ const v2u u_ = *(const GAS v2u*)(X + (size_t)(MROW) * D + 4 * lane + 256 * (J)); (f32x4){bflo(u_.x), bfhi(u_.x), bflo(u_.y), bfhi(u_.y)}; })
#define NORM_Q_PHASE(gain) do { f32x4 gn[4]; _Pragma("unroll") for (int j = 0; j < 4; ++j) gn[j] = *(const f32x4*)((gain) + 4 * lane + 256 * j); \
        for (int m = gw; m < M; m += 2 * NGW) { const int m2 = m + NGW; const bool has2 = m2 < M;       \
            f32x4 v[4], w[4]; float ss = 0.f, ss2 = 0.f; \
            _Pragma("unroll") for (int j = 0; j < 4; ++j) { v[j] = XROW4(m, j); w[j] = XROW4(has2 ? m2 : m, j); } \
            _Pragma("unroll") for (int j = 0; j < 4; ++j) { ss += (v[j].x * v[j].x + v[j].y * v[j].y) + (v[j].z * v[j].z + v[j].w * v[j].w); ss2 += (w[j].x * w[j].x + w[j].y * w[j].y) + (w[j].z * w[j].z + w[j].w * w[j].w); } \
            const float rstd = 1.f / sqrtf(wave_sum(ss) * (1.f / D) + EPS); NORM_Q_ROW(v, rstd, gn, m); \
            if (has2) { const float rstd2 = 1.f / sqrtf(wave_sum(ss2) * (1.f / D) + EPS); NORM_Q_ROW(w, rstd2, gn, m2); } } } while (0)

__device__ __forceinline__ void quant_block(const float* W, int ldw, signed char* WQ, float* sb, int n0, int dst_row0, LAS unsigned char* T, LAS float* red, int wave, int lane) {
    const int tid = wave * 64 + lane;
    { const float* src = W + (size_t)(8 * wave + (lane >> 3)) * ldw + n0 + 4 * (lane & 7);
#pragma unroll
      for (int i = 0; i < 16; ++i) __builtin_amdgcn_global_load_lds((const unsigned*)(src + (size_t)(64 * i) * ldw), (LAS unsigned*)(T + (8 * wave + 64 * i) * 128), 16, 0, 0); }
    asm volatile("s_waitcnt vmcnt(0)" ::: "memory"); __builtin_amdgcn_s_barrier(); asm volatile("" ::: "memory");
    const LAS float* Tf = (const LAS float*)T;
    { const int n = tid & 31, part = tid >> 5; float mx = 0.f;
#pragma unroll 16
      for (int k = 0; k < 64; ++k) mx = fmaxf(mx, fabsf(Tf[(64 * part + k) * 32 + n]));
      red[part * 32 + n] = mx; }
    asm volatile("s_waitcnt lgkmcnt(0)" ::: "memory"); __builtin_amdgcn_s_barrier(); asm volatile("" ::: "memory");
    if (tid < 32) { float m = red[tid];
#pragma unroll
        for (int p = 1; p < 16; ++p) m = fmaxf(m, red[p * 32 + tid]);
        const float sc = m > 0.f ? m * (1.f / 127.f) : 1.f; red[512 + tid] = 1.f / sc; sb[dst_row0 + tid] = sc; }
    asm volatile("s_waitcnt lgkmcnt(0)" ::: "memory"); __builtin_amdgcn_s_barrier(); asm volatile("" ::: "memory");
    { const int n = tid & 31; const float is = red[512 + n];
#pragma unroll 2
      for (int i = 0; i < 8; ++i) { const int c = (tid >> 5) + 16 * i; const LAS float* sp = Tf + (8 * c) * 32 + n; int q[8];
#pragma unroll
          for (int e = 0; e < 8; ++e) q[e] = (int)rintf(sp[e * 32] * is) & 0xff;
          v2u o; o.x = (unsigned)q[0] | ((unsigned)q[1] << 8) | ((unsigned)q[2] << 16) | ((unsigned)q[3] << 24); o.y = (unsigned)q[4] | ((unsigned)q[5] << 8) | ((unsigned)q[6] << 16) | ((unsigned)q[7] << 24);
          *(GAS v2u*)(WQ + (size_t)(dst_row0 + n) * 1024 + 8 * c) = o; } }
    asm volatile("s_waitcnt lgkmcnt(0)" ::: "memory"); __builtin_amdgcn_s_barrier(); asm volatile("" ::: "memory");
}

struct Args { const float* in[19]; float* out; unsigned char* ws; int ph_lo, ph_hi; };

__global__ void __launch_bounds__(NTHR, 2) fwd_kernel(Args args) {
    extern __shared__ __attribute__((aligned(16))) unsigned char lds[];
    LAS unsigned char* const L = (LAS unsigned char*)lds;
    volatile LAS unsigned* const MISC = (volatile LAS unsigned*)(L + MISC_OFF);
    const int wave = __builtin_amdgcn_readfirstlane((int)threadIdx.x >> 6);
    const int G = gridDim.x, bx = blockIdx.x;
    const int gw = bx * NWAVES + wave, NGW = G * NWAVES;
    unsigned char* const ws = args.ws;
    gu32* const ctl = (gu32*)(ws + WS_CTL);
    const float* const x_in = args.in[0]; const int* const positions = (const int*)args.in[1];
    const float* const norm_mix = args.in[2]; const float* const norm_ffn = args.in[3];
    const float* const w_in_ab = args.in[4]; const float* const fgate_bias = args.in[5]; const float* const w_out_ab = args.in[6];
    const float* const w_in_c = args.in[7]; const float* const lower_bounds = args.in[8]; const float* const gnorm_c = args.in[9]; const float* const w_out_c = args.in[10];
    const float* const w_gate_ffn = args.in[11]; const float* const w_up_ffn = args.in[12]; const float* const w_down_ffn = args.in[13];
    const float* const router = args.in[14]; const float* const w_gate_moe = args.in[15]; const float* const w_up_moe = args.in[16]; const float* const w_down_moe = args.in[17];
    const float* const norm_final = args.in[18];
    bf16* const X = (bf16*)(ws + 880 * MiB);
    float* const OUTF = args.out;
#define ROPE ((float*)(ws + WS_ROPE))
#define LOGF ((float*)(ws + WS_LOGF))
#define CUM ((float*)(ws + WS_CUM))
#define TOPI ((int*)(ws + WS_TOPI))
#define TOPG ((float*)(ws + WS_TOPG))
#define RANK ((int*)(ws + WS_RANK))
#define POS ((int*)(ws + WS_POS))
#define ROWMAP ((int*)(ws + WS_ROWMAP))
#define CNT ((int*)(ws + WS_CNT))
#define META ((int*)(ws + WS_META))
#define WinAB_t ((bf16*)(ws + WS_WINAB))
#define WoutAB_t ((bf16*)(ws + WS_WOUTAB))
#define Wgu_t ((bf16*)(ws + WS_WGU))
#define Wdown_t ((bf16*)(ws + WS_WDOWN))
#define WinC_t ((bf16*)(ws + WS_WINC))
#define WoutC_t ((bf16*)(ws + WS_WOUTC))
#define WguM_t ((bf16*)(ws + WS_WGUM))
#define WdownM_t ((bf16*)(ws + WS_WDOWNM))
#define XN ((bf16*)(ws + WS_XN))
#define PROJ ((bf16*)(ws + WS_BIG))
#define HID ((bf16*)(ws + WS_BIG))
#define PROJC ((bf16*)(ws + WS_BIG))
#define HIDM ((bf16*)(ws + WS_BIG))
#define YB ((unsigned char*)(ws + WS_Y))
#define ATT XN
#define XQ ((signed char*)(ws + WS_XN))
#define SA ((float*)(ws + WS_SA))
#define SAS ((float*)(ws + WS_SAS))
#define SBD ((float*)(ws + WS_SBD))
#define SBM ((float*)(ws + WS_SBM))
#define WguQ ((signed char*)(ws + WS_WGU))
#define WinABQ ((signed char*)(ws + WS_WINAB))
#define WinCQ ((signed char*)(ws + WS_WINC))
#define SBAB ((float*)(ws + WS_SBAB))
#define SBC ((float*)(ws + WS_SBC))
#define WguMQ ((signed char*)(ws + WS_WGUM))

    { const int tid = wave * 64 + lane_id(); for (int u = tid; u < (LDS_BYTES - LDSCTL_OFF) / 4; u += NTHR) ((LAS unsigned*)(L + LDSCTL_OFF))[u] = 0u; }
    __syncthreads();
    if (!PER_PHASE_LAUNCH) (void)xcd_barrier_post((unsigned*)(ctl + CW_BAR), MISC + 8, wave == 0 && lane_id() == 0);
#define GRID_BAR() do { if (!PER_PHASE_LAUNCH) { XcdBarrier b_; b_.bar = (unsigned*)((gu32*)(args.ws + WS_CTL) + CW_BAR); b_.x = xb_xcc_id(); b_.st = (volatile LAS unsigned*)(L + MISC_OFF) + 8; xcd_barrier(b_, wave == 0 && lane_id() == 0); } } while (0)
    const int PH_LO = args.ph_lo, PH_HI = args.ph_hi;
#define IN(k) (PH_LO <= (k) && (k) < PH_HI)
#define BOTH(k) (IN(k) && IN((k) + 1))

    if (IN(0)) { const int lane = lane_id(), tid = wave * 64 + lane; (void)tid; (void)lane;
        { constexpr int NB_D = DFF / 32, NB_E = DFFE / 32, NB_AB = NAB / 32, NB_C = NC / 32;
          constexpr int NQ = NB_AB + NB_C + 2 * NB_D + NEXP * 2 * NB_E;
          LAS float* const red = (LAS float*)(L + LDSCTL_OFF + 1024);
          for (int q0_ = bx; q0_ < NQ; q0_ += G) {
              const float* src; int ldw, up = 0, nb, dst0; signed char* dq; float* sbq; int q = q0_;
              if (q < NB_AB + NB_C) { const bool isc = q >= NB_AB; nb = isc ? q - NB_AB : q; src = isc ? w_in_c : w_in_ab; ldw = isc ? NC : IN_AB; dq = isc ? WinCQ : WinABQ; sbq = isc ? SBC : SBAB; dst0 = 32 * nb; }
              else { q -= NB_AB + NB_C;
                  if (q < 2 * NB_D) { up = q >= NB_D; nb = up ? q - NB_D : q; src = up ? w_up_ffn : w_gate_ffn; ldw = DFF; dq = WguQ; sbq = SBD; }
                  else { const int r = q - 2 * NB_D, e = r / (2 * NB_E), rr = r - e * (2 * NB_E); up = rr >= NB_E; nb = up ? rr - NB_E : rr;
                      src = (up ? w_up_moe : w_gate_moe) + (size_t)e * D * DFFE; ldw = DFFE; dq = WguMQ + (size_t)e * NGUE * D; sbq = SBM + (size_t)e * NGUE; }
                  const int n0 = 32 * nb; dst0 = (n0 >> 7) * 256 + up * 128 + (n0 & 127); }
              quant_block(src, ldw, dq, sbq, 32 * nb, dst0, L + RING_OFF, red, wave, lane); } }
        LAS float* scr = (LAS float*)(L + RING_OFF + wave * 16384);
        {
          constexpr int I0 = (D / 64) * (NAB / 32), I1 = (D / 64) * (D / 32), I2 = (DFF / 64) * (D / 32), I3 = (D / 64) * (NC / 32), I4 = I1, I5E = (DFFE / 64) * (D / 32);
          constexpr int NIT = I1 + I2 + I4 + NEXP * I5E; (void)I0; (void)I3;
          for (int it = gw; it < NIT; it += NGW) {
              int r = it; const float* src; int ldw, Kd, nblk; bf16* dst;
              if (false) { src = nullptr; ldw = 0; Kd = 0; nblk = 1; dst = nullptr; }
              else if (r < I1) { src = w_out_ab; ldw = D; Kd = D; nblk = D / 32; dst = WoutAB_t; }
              else if ((r -= I1) < I2) { src = w_down_ffn; ldw = D; Kd = DFF; nblk = D / 32; dst = Wdown_t; }
              else if ((r -= I2) < I4) { src = w_out_c; ldw = D; Kd = D; nblk = D / 32; dst = WoutC_t; }
              else { r -= I4; const int e = r / I5E; r -= e * I5E; const int kb = r / (D / 32), nb = r - kb * (D / 32);
                  absmax_item(w_down_moe + (size_t)e * DFFE * D, D, 64 * kb, 32 * nb, (unsigned*)(ctl + CW_WMAX) + e, lane); continue; }
              const int kb = r / nblk, nb = r - kb * nblk;
              transpose_item(src, ldw, Kd, dst, 64 * kb, 32 * nb, 32 * nb, scr, lane); } }
        for (int idx = bx * NTHR + tid; idx < M * 8; idx += G * NTHR) { const int m = idx >> 3, i = idx & 7;
            const float invf = exp2f(-(float)i * (18.931568569324174f / 8.0f)); const float ang = (float)positions[m] * invf;
            ROPE[m * 16 + i] = cosf(ang); ROPE[m * 16 + 8 + i] = sinf(ang); }
        {
            float gw_[4][4][8]; f32x4 gn[4];
#pragma unroll
            for (int j = 0; j < 4; ++j) { gn[j] = *(const f32x4*)(norm_mix + 4 * lane + 256 * j);
#pragma unroll
                for (int c = 0; c < 4; ++c) { const int col = 4 * lane + 256 * j + c;
#pragma unroll
                    for (int h = 0; h < 8; ++h) gw_[j][c][h] = w_in_ab[(size_t)col * IN_AB + NAB + h] * gn[j][c]; } }
            float fb = (lane < 8) ? fgate_bias[lane] : 0.f;
            for (int m = gw; m < M; m += NGW) {
                const GAS f32x4* xr = (const GAS f32x4*)(x_in + (size_t)m * D) + lane;
                f32x4 v[4]; float ss = 0.f; float fl[8];
#pragma unroll
                for (int h = 0; h < 8; ++h) fl[h] = 0.f;
#pragma unroll
                for (int j = 0; j < 4; ++j) { v[j] = xr[64 * j]; ss += (v[j].x * v[j].x + v[j].y * v[j].y) + (v[j].z * v[j].z + v[j].w * v[j].w);
#pragma unroll
                    for (int c = 0; c < 4; ++c)
#pragma unroll
                        for (int h = 0; h < 8; ++h) fl[h] += v[j][c] * gw_[j][c][h]; }
                { GAS v2u* xo = (GAS v2u*)(X + (size_t)m * D) + lane;
#pragma unroll
                  for (int j = 0; j < 4; ++j) { v2u o; o.x = pk2(v[j].x, v[j].y); o.y = pk2(v[j].z, v[j].w); xo[64 * j] = o; } }
                const float rstd = 1.f / sqrtf(wave_sum(ss) * (1.f / D) + EPS);
                float mine = 0.f;
#pragma unroll
                for (int h = 0; h < 8; ++h) { const float t = wave_sum(fl[h]); if (lane == h) mine = t; }
                if (lane < 8) { const float z = mine * rstd + fb; LOGF[(size_t)m * 8 + lane] = fminf(z, 0.f) - log1pf(__expf(-fabsf(z))); }
                NORM_Q_ROW(v, rstd, gn, m);
            }
        }
        if (BOTH(0)) GRID_BAR();
    }

    if (IN(1)) { const int lane = lane_id(), tid = wave * 64 + lane; (void)tid; (void)lane;
        if (wave == 0) for (int bh = bx; bh < BATCH * NH; bh += G) { const int b = bh >> 3, h = bh & 7;
            float loc[32]; float s = 0.f;
#pragma unroll
            for (int i = 0; i < 32; ++i) { s += LOGF[((size_t)(b * SEQ + lane * 32 + i)) * 8 + h]; loc[i] = s; }
            float incl = s;
#pragma unroll
            for (int o = 1; o < 64; o <<= 1) { const float t = __shfl_up(incl, o); if (lane >= o) incl += t; }
            const float excl = incl - s;
#pragma unroll
            for (int i = 0; i < 32; ++i) CUM[(size_t)bh * SEQ + lane * 32 + i] = (excl + loc[i]) * LOG2E; }
        { LAS float* scr = (LAS float*)(L + RING_OFF + wave * 16384);
          constexpr int I5E = (DFFE / 64) * (D / 32);
          for (int it = gw; it < NEXP * I5E; it += NGW) { const int e = it / I5E, r = it - e * I5E, kb = r / (D / 32), nb = r - kb * (D / 32);
              const float am = __uint_as_float(((const unsigned*)(ctl + CW_WMAX))[e]); const float sc = am > 0.f ? 256.f / am : 1.f;
              transpose_item_f8(w_down_moe + (size_t)e * DFFE * D, D, DFFE, (unsigned char*)WdownM_t + (size_t)e * D * DFFE, 64 * kb, 32 * nb, 32 * nb, sc, scr, lane); }
          __syncthreads(); }
        pg8::Gemm g{(const bf16*)XQ, (const bf16*)WinABQ, M, NAB, D}; pg8::StaticOrder S; S.init(M, NAB, G, bx);
        pg8::EpiProjAB E{PROJ, NAB, ROPE, QSCALE_AB, SA, SBAB};
        pg8::gemm_phase<pg8::EpiProjAB, pg8::StaticOrder, true, false, 1>(L + RING_OFF, g, S, E, nullptr, wave);
        if (BOTH(1)) GRID_BAR();
    }

    if (IN(2)) { const int lane = lane_id(), tid = wave * 64 + lane; (void)tid; (void)lane;
        LAS unsigned char* const vbuf = L + wave * 4096;
        LAS float* const cumL = (LAS float*)(L + 32768);
        const int r32 = lane & 31, hi = lane >> 5;
        for (int bh = bx; bh < BATCH * NH; bh += G) { const int b = bh >> 3, h = bh & 7;
            const bf16* const Pb = PROJ + (size_t)b * SEQ * NAB;
            { const bf16* const Qb = Pb + h * HD; const bf16* const Kb = Pb + 512 + h * HD; const bf16* const Vb = Pb + 1024 + h * HD;
              LAS unsigned char* const STL = L + 40960;
              for (int qb2 = 0; qb2 < SEQ / 512; ++qb2) { const int q0 = 512 * qb2;
                { bf16x8v qfa[2][4]; FlashSt sta[2]; int lqa[2], qla[2], kma[2];
#pragma unroll
                  for (int q = 0; q < 2; ++q) { const int tq = q0 + 256 * q + 32 * wave + r32; lqa[q] = tq; qla[q] = q0 + 256 * q + 32 * wave + 31; kma[q] = q0 + 256 * q + 32 * wave - 128; flash_init(sta[q]);
#pragma unroll
                      for (int d0 = 0; d0 < 4; ++d0) qfa[q][d0] = *(const bf16x8v*)(Qb + (size_t)tq * NAB + 16 * d0 + 8 * hi); }
                  coop_block<false, 2>(sta, qfa, Kb, Vb, q0 - 128, 10, lqa, 128, qla, kma, cumL, L, wave, lane);
#pragma unroll
                  for (int q = 0; q < 2; ++q) st_save16(sta[q], STL + ((lqa[q] - q0) * 2 + hi) * 80); }
                __syncthreads();
                { const int c4 = wave & 3, hf = wave >> 2, l4b = (q0 >> 2) + 64 * hf;
                  bf16x8v qf2[2][4]; FlashSt st2[2]; int lq2[2], lqb2[2];
#pragma unroll
                  for (int q = 0; q < 2; ++q) { lqb2[q] = l4b + 32 * q; lq2[q] = lqb2[q] + r32; const int tq = 4 * lq2[q] + c4;
#pragma unroll
                      for (int d0 = 0; d0 < 4; ++d0) qf2[q][d0] = *(const bf16x8v*)(Qb + (size_t)tq * NAB + 16 * d0 + 8 * hi);
                      st_load16(st2[q], STL + ((tq - q0) * 2 + hi) * 80); }
                  flash_tiles2(st2, qf2, Kb, Vb, 4 * (l4b - 128) + c4, 4, 6, 128, lq2, lqb2, l4b - 128, 128, vbuf, lane);
#pragma unroll
                  for (int q = 0; q < 2; ++q) { const int tq = 4 * lq2[q] + c4; st_save16(st2[q], STL + ((tq - q0) * 2 + hi) * 80); } }
                __syncthreads();
                for (int cc = 0; cc < 2; ++cc) { const int cls = 2 * wave + cc, l16q = (q0 >> 4) + r32, tq = 16 * l16q + cls; bf16x8v qf[4];
#pragma unroll
                  for (int d0 = 0; d0 < 4; ++d0) qf[d0] = *(const bf16x8v*)(Qb + (size_t)tq * NAB + 16 * d0 + 8 * hi);
                  FlashSt st; st_load16(st, STL + ((tq - q0) * 2 + hi) * 80);
                  const int nt = ((q0 >> 4) + 32 + 31) >> 5;
                  flash_tiles<false>(st, qf, Kb, Vb, cls, 16, nt, 512, l16q, 0, 1 << 20, cumL, vbuf, lane);
                  flash_store(st, ATT + (size_t)(b * SEQ + tq) * D + h * HD, lane); }
                __syncthreads(); } }
            __syncthreads();
            LAS float* const cumF = (LAS float*)(L + 65536);
            for (int i = tid; i < SEQ; i += NTHR) cumF[i] = -CUM[(size_t)bh * SEQ + i];
            __syncthreads();
            { const bf16* const Qb = Pb + 1536 + h * HD; const bf16* const Kb = Pb + 2048 + h * HD; const bf16* const Vb = Pb + 2560 + h * HD;
              for (int qb = 0; qb < SEQ / 512; ++qb) { const int tq = 512 * qb + 32 * wave + r32;
                bf16x8v qf2[2][4];
#pragma unroll
                for (int q = 0; q < 2; ++q)
#pragma unroll
                    for (int d0 = 0; d0 < 4; ++d0) qf2[q][d0] = *(const bf16x8v*)(Qb + (size_t)(tq + 256 * q) * NAB + 16 * d0 + 8 * hi);
                FlashSt st2[2]; flash_init(st2[0]); flash_init(st2[1]);
                { const int lq2[2] = {tq, tq + 256}, ql2[2] = {512 * qb + 32 * wave + 31, 512 * qb + 256 + 32 * wave + 31}, km2[2] = {-(1 << 30), -(1 << 30)};
                  coop_block<true, 2, 2>(st2, qf2, Kb, Vb, 0, (512 * qb + 512) >> 7, lq2, 4096, ql2, km2, cumF, L, wave, lane); }
#pragma unroll
                for (int q = 0; q < 2; ++q) flash_store(st2[q], ATT + (size_t)(b * SEQ + tq + 256 * q) * D + 512 + h * HD, lane); } }
        }
        __syncthreads();
        if (BOTH(2)) GRID_BAR();
    }

    if (IN(3)) { const int lane = lane_id(), tid = wave * 64 + lane; (void)tid; (void)lane;
        pg8::Gemm g{ATT, WoutAB_t, M, D, D}; pg8::StaticOrder S; S.init(M, D, G, bx);
        pg8::EpiResidualB<false> E{X, X};
        pg8::gemm_phase<pg8::EpiResidualB<false>, pg8::StaticOrder, true, false>(L + RING_OFF, g, S, E, nullptr, wave);
        if (BOTH(3)) GRID_BAR();
    }

#define NORM_PHASE(gain) do { f32x4 gn[4]; _Pragma("unroll") for (int j = 0; j < 4; ++j) gn[j] = *(const f32x4*)((gain) + 4 * lane + 256 * j); \
        for (int m = gw; m < M; m += NGW) { f32x4 v[4]; float ss = 0.f; \
            _Pragma("unroll") for (int j = 0; j < 4; ++j) { v[j] = XROW4(m, j); ss += (v[j].x * v[j].x + v[j].y * v[j].y) + (v[j].z * v[j].z + v[j].w * v[j].w); } \
            const float rstd = 1.f / sqrtf(wave_sum(ss) * (1.f / D) + EPS); \
            GAS unsigned long long* o8 = (GAS unsigned long long*)(XN + (size_t)m * D) + lane; \
            _Pragma("unroll") for (int j = 0; j < 4; ++j) { const f32x4 y = v[j] * rstd * gn[j]; o8[64 * j] = (unsigned long long)pk2(y.x, y.y) | ((unsigned long long)pk2(y.z, y.w) << 32); } } } while (0)

    if (IN(4)) { const int lane = lane_id(), tid = wave * 64 + lane; (void)tid; (void)lane; NORM_Q_PHASE(norm_ffn); if (BOTH(4)) GRID_BAR(); }

    if (IN(5)) { const int lane = lane_id(), tid = wave * 64 + lane; (void)tid; (void)lane;
        pg8::Gemm g{(const bf16*)XQ, (const bf16*)WguQ, M, NGU, D}; pg8::StaticOrder S; S.init(M, NGU, G, bx);
        pg8::EpiSwiGLUI8 E{HID, DFF, 0, SA, SBD};
        pg8::gemm_phase<pg8::EpiSwiGLUI8, pg8::StaticOrder, true, false, 1>(L + RING_OFF, g, S, E, nullptr, wave);
        if (BOTH(5)) GRID_BAR();
    }
    if (IN(6)) { const int lane = lane_id(), tid = wave * 64 + lane; (void)tid; (void)lane;
        pg8::Gemm g{HID, Wdown_t, M, D, DFF}; pg8::StaticOrder S; S.init(M, D, G, bx);
        pg8::EpiResidualB<false> E{X, X};
        pg8::gemm_phase<pg8::EpiResidualB<false>, pg8::StaticOrder, true, false>(L + RING_OFF, g, S, E, nullptr, wave);
        if (BOTH(6)) GRID_BAR();
    }
    if (IN(7)) { const int lane = lane_id(), tid = wave * 64 + lane; (void)tid; (void)lane; NORM_Q_PHASE(norm_mix + D); if (BOTH(7)) GRID_BAR(); }
    if (IN(8)) { const int lane = lane_id(), tid = wave * 64 + lane; (void)tid; (void)lane;
        pg8::Gemm g{(const bf16*)XQ, (const bf16*)WinCQ, M, NC, D}; pg8::StaticOrder S; S.init(M, NC, G, bx);
        pg8::EpiBf16S E{PROJC, NC, 4, QSCALE_C, SA, SBC};
        pg8::gemm_phase<pg8::EpiBf16S, pg8::StaticOrder, true, false, 1>(L + RING_OFF, g, S, E, nullptr, wave);
        if (BOTH(8)) GRID_BAR();
    }
    if (IN(9)) { const int lane = lane_id(), tid = wave * 64 + lane; (void)tid; (void)lane;
#define HG_BAR() do { asm volatile("s_waitcnt lgkmcnt(0)" ::: "memory"); __builtin_amdgcn_s_barrier(); asm volatile("" ::: "memory"); } while (0)
        constexpr int PQ = 272, PV = 320;
        LAS unsigned char* const QT = L;
        LAS unsigned char* const KT = L + 17408;
        LAS unsigned char* const KH = L + 34816;
        LAS unsigned char* const VT = L + 55296;
        LAS float* const OL = (LAS float*)(L + 75776);
        LAS float* const EBL = (LAS float*)(L + 108544);
        LAS float* const GT = (LAS float*)(L + 109056);
        const int r32 = lane & 31, h5 = lane >> 5, tb = wave >> 2, eb = wave & 3, dp = lane, grp = wave;
        const int trq = (lane & 15) >> 2, trp = lane & 3, trc = (lane >> 4) & 1;
        for (int bh = bx; bh < BATCH * NH; bh += G) { const int b = bh >> 3, h = bh & 7;
            const float lbv0 = sigm_fast(lower_bounds[D + h * HK + 2 * dp] - lower_bounds[h * HK + 2 * dp]), lbv1 = sigm_fast(lower_bounds[D + h * HK + 2 * dp + 1] - lower_bounds[h * HK + 2 * dp + 1]);
            const float gn0 = gnorm_c[2 * lane], gn1 = gnorm_c[2 * lane + 1];
            f32x16 S[4];
#pragma unroll
            for (int i = 0; i < 4; ++i)
#pragma unroll
                for (int r = 0; r < 16; ++r) S[i][r] = 0.f;
            unsigned fraw[8], qraw[8]; v4u vraw[2]; unsigned graw[8];
#define HG_PRELOAD(CH) do { const int m0_ = b * SEQ + (CH) * 64; \
                _Pragma("unroll") for (int j = 0; j < 8; ++j) { const bf16* pr = PROJC + (size_t)(m0_ + 8 * grp + j) * NC + h * HK + 2 * dp; fraw[j] = *(const unsigned*)(pr + D); qraw[j] = *(const unsigned*)pr; } \
                _Pragma("unroll") for (int i = 0; i < 2; ++i) { const int c = tid + 512 * i, row = c >> 4, c16 = c & 15; vraw[i] = *(const v4u*)(PROJC + (size_t)(m0_ + row) * NC + 2 * D + h * HK + 8 * c16); } } while (0)
#define HG_GLOAD(CH) do { const int m0_ = b * SEQ + (CH) * 64; \
                _Pragma("unroll") for (int tt = 0; tt < 8; ++tt) graw[tt] = *(const unsigned*)(PROJC + (size_t)(m0_ + wave * 8 + tt) * NC + 3 * D + h * HK + 2 * lane); } while (0)
            HG_PRELOAD(0);
            for (int ch = 0; ch < SEQ / 64; ++ch) { const int m0 = b * SEQ + ch * 64;
                float bl0[8], bl1[8], k0[8], k1[8], q0[8], q1[8]; float run0 = 1.f, run1 = 1.f;
#pragma unroll
                for (int j = 0; j < 8; ++j) { const float f0 = lbv0 + (1.f - lbv0) * sigm_fast(bflo(fraw[j])), f1 = lbv1 + (1.f - lbv1) * sigm_fast(bfhi(fraw[j]));
                    run0 *= f0; run1 *= f1; bl0[j] = run0; bl1[j] = run1; k0[j] = 1.f - f0; k1[j] = 1.f - f1; q0[j] = bflo(qraw[j]); q1[j] = bfhi(qraw[j]); }
                *(LAS f32x2_t*)(GT + grp * 128 + 2 * dp) = (f32x2_t){run0, run1};
#pragma unroll
                for (int i = 0; i < 2; ++i) { const int c = tid + 512 * i, row = c >> 4, c16 = c & 15; *(LAS v4u*)(VT + row * PV + c16 * 16) = vraw[i]; }
                HG_BAR();
                { float off0 = 1.f, off1 = 1.f, tot0 = 1.f, tot1 = 1.f;
#pragma unroll
                  for (int g2 = 0; g2 < 8; ++g2) { const f32x2_t v = *(const LAS f32x2_t*)(GT + g2 * 128 + 2 * dp); tot0 *= v.x; tot1 *= v.y; if (g2 < grp) { off0 *= v.x; off1 *= v.y; } }
                  const float et0 = tot0, et1 = tot1;
#pragma unroll
                  for (int j = 0; j < 8; ++j) { const int t = 8 * grp + j;
                      const float e0 = off0 * bl0[j], e1 = off1 * bl1[j]; const float kt0 = k0[j] * __builtin_amdgcn_rcpf(e0), kt1 = k1[j] * __builtin_amdgcn_rcpf(e1);
                      *(LAS unsigned*)(QT + t * PQ + dp * 4) = cvtpk_s(q0[j] * e0, q1[j] * e1);
                      *(LAS unsigned*)(KT + t * PQ + dp * 4) = cvtpk_s(kt0, kt1);
                      *(LAS unsigned*)(KH + t * PV + dp * 4) = cvtpk_s(kt0 * et0, kt1 * et1); }
                  if (grp == 0) *(LAS f32x2_t*)(EBL + 2 * dp) = (f32x2_t){et0, et1}; }
                HG_GLOAD(ch); if (ch + 1 < SEQ / 64) HG_PRELOAD(ch + 1);
                HG_BAR();
                {
                    f32x16 o, sc;
#pragma unroll
                    for (int r = 0; r < 16; ++r) { o[r] = 0.f; sc[r] = 0.f; }
                    asm volatile("" : "+v"(o), "+v"(sc));
                    bf16x8v qb[8];
#pragma unroll
                    for (int ks = 0; ks < 8; ++ks) qb[ks] = *(const LAS bf16x8v*)(QT + (32 * tb + r32) * PQ + (16 * ks + 8 * h5) * 2);
#pragma unroll
                    for (int ks = 0; ks < 8; ++ks) { const int db = ks >> 1, k2 = ks & 1;
                        v4u bw; bw.x = cvtpk_s(S[db][8 * k2], S[db][8 * k2 + 1]); bw.y = cvtpk_s(S[db][8 * k2 + 2], S[db][8 * k2 + 3]); bw.z = cvtpk_s(S[db][8 * k2 + 4], S[db][8 * k2 + 5]); bw.w = cvtpk_s(S[db][8 * k2 + 6], S[db][8 * k2 + 7]);
                        const LAS unsigned char* qa = QT + (32 * tb + r32) * PQ + (32 * db + 16 * k2 + 4 * h5) * 2;
                        const v2u a0 = *(const LAS v2u*)qa, a1 = *(const LAS v2u*)(qa + 16);
                        v4u aw; aw.x = a0.x; aw.y = a0.y; aw.z = a1.x; aw.w = a1.y;
                        const bf16x8v ka = *(const LAS bf16x8v*)(KT + r32 * PQ + (16 * ks + 8 * h5) * 2);
                        o = __builtin_amdgcn_mfma_f32_32x32x16_bf16(__builtin_bit_cast(bf16x8v, aw), __builtin_bit_cast(bf16x8v, bw), o, 0, 0, 0);
                        sc = __builtin_amdgcn_mfma_f32_32x32x16_bf16(ka, qb[ks], sc, 0, 0, 0); }
                    for (int sb = 0; sb <= tb; ++sb) {
                        if (sb == 1) {
#pragma unroll
                            for (int r = 0; r < 16; ++r) sc[r] = 0.f;
                            asm volatile("" : "+v"(sc));
#pragma unroll
                            for (int ks = 0; ks < 8; ++ks) { const bf16x8v ka = *(const LAS bf16x8v*)(KT + (32 + r32) * PQ + (16 * ks + 8 * h5) * 2);
                                sc = __builtin_amdgcn_mfma_f32_32x32x16_bf16(ka, qb[ks], sc, 0, 0, 0); } }
                        if (sb == tb) {
#pragma unroll
                            for (int r = 0; r < 16; ++r) { const int sl = (r & 3) + 8 * (r >> 2) + 4 * h5; if (sl > r32) sc[r] = 0.f; } }
                        v4u p0, p1;
                        p0.x = cvtpk_s(sc[0], sc[1]); p0.y = cvtpk_s(sc[2], sc[3]); p0.z = cvtpk_s(sc[4], sc[5]); p0.w = cvtpk_s(sc[6], sc[7]);
                        p1.x = cvtpk_s(sc[8], sc[9]); p1.y = cvtpk_s(sc[10], sc[11]); p1.z = cvtpk_s(sc[12], sc[13]); p1.w = cvtpk_s(sc[14], sc[15]);
                        const LAS unsigned char* vb = VT + (32 * sb + 4 * h5 + trq) * PV + (32 * eb + 16 * trc + 4 * trp) * 2;
                        { const s16x4 l0 = vtr(vb), u0 = vtr(vb + 8 * PV), l1 = vtr(vb + 16 * PV), u1 = vtr(vb + 24 * PV);
                          const bf16x8v v0 = (bf16x8v){l0[0], l0[1], l0[2], l0[3], u0[0], u0[1], u0[2], u0[3]}, v1 = (bf16x8v){l1[0], l1[1], l1[2], l1[3], u1[0], u1[1], u1[2], u1[3]};
                          o = __builtin_amdgcn_mfma_f32_32x32x16_bf16(__builtin_bit_cast(bf16x8v, p0), v0, o, 0, 0, 0);
                          o = __builtin_amdgcn_mfma_f32_32x32x16_bf16(__builtin_bit_cast(bf16x8v, p1), v1, o, 0, 0, 0); }
                    }
#pragma unroll
                    for (int r = 0; r < 16; ++r) OL[(32 * tb + (r & 3) + 8 * (r >> 2) + 4 * h5) * 128 + 32 * eb + r32] = o[r];
                    const LAS unsigned char* kb_ = KH + (8 * h5 + trq) * PV + (16 * trc + 4 * trp) * 2;
                    const LAS unsigned char* vb_ = VT + (8 * h5 + trq) * PV + (32 * eb + 16 * trc + 4 * trp) * 2;
                    bf16x8v vf[4];
#pragma unroll
                    for (int ks = 0; ks < 4; ++ks) { const s16x4 l = vtr(vb_ + 16 * ks * PV), u = vtr(vb_ + (16 * ks + 4) * PV); vf[ks] = (bf16x8v){l[0], l[1], l[2], l[3], u[0], u[1], u[2], u[3]}; }
#pragma unroll
                    for (int db = 0; db < 4; ++db)
#pragma unroll
                        for (int g2 = 0; g2 < 4; ++g2) { const f32x4 e4 = *(const LAS f32x4*)(EBL + 32 * db + 8 * g2 + 4 * h5);
#pragma unroll
                            for (int c = 0; c < 4; ++c) S[db][4 * g2 + c] *= e4[c]; }
#pragma unroll
                    for (int ks = 0; ks < 4; ++ks)
#pragma unroll
                        for (int db = 0; db < 4; ++db) { const s16x4 l = vtr(kb_ + 16 * ks * PV + 64 * db), u = vtr(kb_ + (16 * ks + 4) * PV + 64 * db);
                            const bf16x8v kf_ = (bf16x8v){l[0], l[1], l[2], l[3], u[0], u[1], u[2], u[3]};
                            S[db] = __builtin_amdgcn_mfma_f32_32x32x16_bf16(kf_, vf[ks], S[db], 0, 0, 0); }
                }
                HG_BAR();
#pragma unroll
                for (int tt = 0; tt < 8; ++tt) { const int t = wave * 8 + tt; const int m = m0 + t;
                    const f32x2_t ov = *(const LAS f32x2_t*)(OL + t * 128 + 2 * lane); const float o0 = ov.x, o1 = ov.y;
                    const float rstd = __builtin_amdgcn_rsqf(wave_sum(o0 * o0 + o1 * o1) * (1.f / 128.f) + EPS);
                    const float g0 = bflo(graw[tt]), g1 = bfhi(graw[tt]);
                    *(unsigned*)(XN + (size_t)m * D + h * HK + 2 * lane) = cvtpk_s(o0 * rstd * gn0 * g0 * sigm_fast(g0), o1 * rstd * gn1 * g1 * sigm_fast(g1)); }
            }
#undef HG_PRELOAD
#undef HG_GLOAD
            __syncthreads();
        }
        __syncthreads();
        if (BOTH(9)) GRID_BAR();
    }
    if (IN(10)) { const int lane = lane_id(), tid = wave * 64 + lane; (void)tid; (void)lane;
        pg8::Gemm g{XN, WoutC_t, M, D, D}; pg8::StaticOrder S; S.init(M, D, G, bx);
        pg8::EpiResidualB<false> E{X, X};
        pg8::gemm_phase<pg8::EpiResidualB<false>, pg8::StaticOrder, true, false>(L + RING_OFF, g, S, E, nullptr, wave);
        if (BOTH(10)) GRID_BAR();
    }
    if (IN(11)) { const int lane = lane_id(), tid = wave * 64 + lane; (void)tid; (void)lane;
        LAS int* const cnt = (LAS int*)(L);
        float rw[4][4][8]; f32x4 gn[4];
#pragma unroll
        for (int j = 0; j < 4; ++j) { gn[j] = *(const f32x4*)(norm_ffn + D + 4 * lane + 256 * j);
#pragma unroll
            for (int c = 0; c < 4; ++c) { const int col = 4 * lane + 256 * j + c;
#pragma unroll
                for (int e = 0; e < 8; ++e) rw[j][c][e] = router[(size_t)col * NEXP + e] * gn[j][c]; } }
        for (int chunk = bx; chunk < M / 256; chunk += G) {
            __syncthreads();
            if (tid < 8) cnt[tid] = 0;
            __syncthreads();
            for (int r = 0; r < 32; ++r) { const int m = chunk * 256 + wave * 32 + r;
                f32x4 v[4]; float ss = 0.f; float lg[8];
#pragma unroll
                for (int e = 0; e < 8; ++e) lg[e] = 0.f;
#pragma unroll
                for (int j = 0; j < 4; ++j) { v[j] = XROW4(m, j); ss += (v[j].x * v[j].x + v[j].y * v[j].y) + (v[j].z * v[j].z + v[j].w * v[j].w);
#pragma unroll
                    for (int c = 0; c < 4; ++c)
#pragma unroll
                        for (int e = 0; e < 8; ++e) lg[e] += v[j][c] * rw[j][c][e]; }
                const float rstd = 1.f / sqrtf(wave_sum(ss) * (1.f / D) + EPS);
#pragma unroll
                for (int e = 0; e < 8; ++e) lg[e] = wave_sum(lg[e]) * rstd;
                NORM_Q_ROW(v, rstd, gn, m);
                if (lane == 0) {
                    int e0 = 0; float v0 = lg[0];
#pragma unroll
                    for (int e = 1; e < 8; ++e) if (lg[e] > v0) { v0 = lg[e]; e0 = e; }
                    int e1 = -1; float v1 = -INFINITY;
#pragma unroll
                    for (int e = 0; e < 8; ++e) if (e != e0 && lg[e] > v1) { v1 = lg[e]; e1 = e; }
                    const float g1 = 1.f / (1.f + __expf(v0 - v1)), g0 = 1.f - g1;
                    const int r0 = atomicAdd((int*)(cnt + e0), 1), r1 = atomicAdd((int*)(cnt + e1), 1);
                    TOPI[m] = e0 | (e1 << 8); TOPG[2 * m] = g0; TOPG[2 * m + 1] = g1; RANK[2 * m] = r0; RANK[2 * m + 1] = r1;
                }
            }
            __syncthreads();
            if (tid < 8) CNT[chunk * 8 + tid] = cnt[tid];
        }
        __syncthreads();
        if (BOTH(11)) GRID_BAR();
    }
    if (IN(12)) { const int lane = lane_id(), tid = wave * 64 + lane; (void)tid; (void)lane;
        LAS int* const lc = (LAS int*)(L);
        LAS int* const tot = lc + 2048;
        LAS int* const base = tot + 8;
        LAS int* const off = base + 16;
        __syncthreads();
        for (int i = tid; i < 2048; i += NTHR) lc[i] = CNT[i];
        __syncthreads();
        if (tid < 8) { int s = 0; for (int c = 0; c < 256; ++c) s += lc[c * 8 + tid]; tot[tid] = s; }
        __syncthreads();
        if (tid == 0) { int b = 0; for (int e = 0; e < 8; ++e) { base[e] = b; b += (tot[e] + 255) & ~255; } base[8] = b; }
        __syncthreads();
        for (int chunk = bx; chunk < M / 256; chunk += G) {
            __syncthreads();
            if (tid < 8) { int s = base[tid]; for (int c = 0; c < chunk; ++c) s += lc[c * 8 + tid]; off[tid] = s; }
            __syncthreads();
            { const int m = chunk * 256 + (tid >> 1), slot = tid & 1; const int ti = TOPI[m]; const int e = slot ? (ti >> 8) : (ti & 0xff);
              const int pos = off[e] + RANK[2 * m + slot]; ROWMAP[pos] = m; POS[2 * m + slot] = pos; SAS[pos] = SA[m]; }
        }
        if (bx == 0) {
            for (int e = 0; e < 8; ++e) for (int p = base[e] + tot[e] + tid; p < base[e + 1]; p += NTHR) { ROWMAP[p] = 0; SAS[p] = 0.f; }
            if (tid == 0) META[0] = base[8] >> 8;
            for (int p = tid; p < NPMAX; p += NTHR) { int e = 0; for (int k = 1; k < 8; ++k) if (p * 256 >= base[k]) e = k; META[64 + p] = e; }
        }
        __syncthreads();
        if (BOTH(12)) GRID_BAR();
    }
    for (int c = 0; c < NMCH; ++c) {
        if (IN(13 + 2 * c)) { const int lane = lane_id(), tid = wave * 64 + lane; (void)tid; (void)lane;
            const int ptot = __builtin_amdgcn_readfirstlane(META[0]); const int p_lo = c * PCHUNK; int p_n = ptot - p_lo; p_n = p_n < 0 ? 0 : (p_n > PCHUNK ? PCHUNK : p_n);
            int p_tail = (c == NMCH - 1) ? ptot - p_lo - p_n : 0; p_tail = p_tail < 0 ? 0 : p_tail;
            pg8::Gemm g{(const bf16*)XQ, (const bf16*)WguMQ, M, NGUE, D}; pg8::MoeOrder S{p_lo, p_n, p_tail, NGUE / 256, G, bx, 0, META + 64}; S.init();
            pg8::EpiSwiGLUI8F8 E{HIDM, DFFE, p_lo, SAS, SBM};
            pg8::gemm_phase<pg8::EpiSwiGLUI8F8, pg8::MoeOrder, true, true, 1>(L + RING_OFF, g, S, E, ROWMAP, wave);
            if (BOTH(13 + 2 * c)) GRID_BAR();
        }
        if (IN(14 + 2 * c)) { const int lane = lane_id(), tid = wave * 64 + lane; (void)tid; (void)lane;
            const int ptot = __builtin_amdgcn_readfirstlane(META[0]); const int p_lo = c * PCHUNK; int p_n = ptot - p_lo; p_n = p_n < 0 ? 0 : (p_n > PCHUNK ? PCHUNK : p_n);
            int p_tail = (c == NMCH - 1) ? ptot - p_lo - p_n : 0; p_tail = p_tail < 0 ? 0 : p_tail;
            pg8::Gemm g{HIDM, WdownM_t, (PCHUNK + 8) * 256, D, DFFE}; pg8::MoeOrder S{p_lo, p_n, p_tail, D / 256, G, bx, 1, META + 64}; S.init();
            pg8::EpiBf16RowsF8 E{YB, D, p_lo * 256, (const unsigned*)(ctl + CW_WMAX)};
            pg8::gemm_phase<pg8::EpiBf16RowsF8, pg8::MoeOrder, true, false, 2>(L + RING_OFF, g, S, E, nullptr, wave);
            if (BOTH(14 + 2 * c)) GRID_BAR();
        }
    }
    if (IN(13 + 2 * NMCH)) { const int lane = lane_id(), tid = wave * 64 + lane; (void)tid; (void)lane;
        f32x4 gn[4];
#pragma unroll
        for (int j = 0; j < 4; ++j) gn[j] = *(const f32x4*)(norm_final + 4 * lane + 256 * j);
        int pn0 = POS[2 * gw], pn1 = POS[2 * gw + 1]; float gq0 = TOPG[2 * gw], gq1 = TOPG[2 * gw + 1];
        for (int m = gw; m < M; m += NGW) {
            const int p0 = pn0, p1 = pn1; const float g0 = gq0, g1 = gq1;
            const GAS unsigned* y0 = (const GAS unsigned*)(YB + (size_t)p0 * D) + lane; const GAS unsigned* y1 = (const GAS unsigned*)(YB + (size_t)p1 * D) + lane;
            f32x4 v[4]; unsigned ya[4], yb[4]; float ss = 0.f;
#pragma unroll
            for (int j = 0; j < 4; ++j) { v[j] = XROW4(m, j); ya[j] = __builtin_nontemporal_load(y0 + 64 * j); yb[j] = __builtin_nontemporal_load(y1 + 64 * j); }
            { const int mn = (m + NGW < M) ? m + NGW : m; pn0 = POS[2 * mn]; pn1 = POS[2 * mn + 1]; gq0 = TOPG[2 * mn]; gq1 = TOPG[2 * mn + 1]; }
#pragma unroll
            for (int j = 0; j < 4; ++j) { const int a = (int)ya[j], bq = (int)yb[j]; const float h0 = g0 * (1.f / 8.f), h1 = g1 * (1.f / 8.f);
                v[j].x += h0 * __builtin_amdgcn_cvt_f32_fp8(a, 0) + h1 * __builtin_amdgcn_cvt_f32_fp8(bq, 0); v[j].y += h0 * __builtin_amdgcn_cvt_f32_fp8(a, 1) + h1 * __builtin_amdgcn_cvt_f32_fp8(bq, 1);
                v[j].z += h0 * __builtin_amdgcn_cvt_f32_fp8(a, 2) + h1 * __builtin_amdgcn_cvt_f32_fp8(bq, 2); v[j].w += h0 * __builtin_amdgcn_cvt_f32_fp8(a, 3) + h1 * __builtin_amdgcn_cvt_f32_fp8(bq, 3);
                ss += (v[j].x * v[j].x + v[j].y * v[j].y) + (v[j].z * v[j].z + v[j].w * v[j].w); }
            const float rstd = 1.f / sqrtf(wave_sum(ss) * (1.f / D) + EPS);
            GAS f32x4* orow = (GAS f32x4*)(OUTF + (size_t)m * D) + lane;
#pragma unroll
            for (int j = 0; j < 4; ++j) __builtin_nontemporal_store(v[j] * rstd * gn[j], orow + 64 * j);
        }
    }
#undef IN
#undef BOTH
}

extern "C" void kernel_launch(void* const* d_in, const int* in_sizes, int n_in, void* d_out, int out_size, void* d_ws, size_t ws_size, hipStream_t stream) {
    static int grid = 0;
    if (grid == 0) {
        if (n_in != 19 || in_sizes[0] != M * D || out_size != M * D || ws_size < WS_END) { fprintf(stderr, "kernel_launch: unexpected shapes (n_in %d, in0 %d, out %d, ws %zu)\n", n_in, n_in > 0 ? in_sizes[0] : -1, out_size, ws_size); grid = -1; return; }
        int dev = 0, cus = 0, per_cu = 0;
        if (hipGetDevice(&dev) != hipSuccess || hipDeviceGetAttribute(&cus, hipDeviceAttributeMultiprocessorCount, dev) != hipSuccess) { grid = -1; return; }
        if (hipFuncSetAttribute((const void*)fwd_kernel, hipFuncAttributeMaxDynamicSharedMemorySize, LDS_BYTES) != hipSuccess) { fprintf(stderr, "kernel_launch: hipFuncSetAttribute failed\n"); grid = -1; return; }
        if (hipOccupancyMaxActiveBlocksPerMultiprocessor(&per_cu, (const void*)fwd_kernel, NTHR, LDS_BYTES) != hipSuccess || per_cu < 1) fprintf(stderr, "kernel_launch: occupancy query reports %d\n", per_cu);
        (void)hipGetLastError();
        grid = cus;
    }
    if (grid < 0) return;
    if (hipMemsetAsync((char*)d_ws + WS_CTL, 0, CTL_ZERO_BYTES, stream) != hipSuccess) return;
    Args a{};
    for (int i = 0; i < 19; ++i) a.in[i] = (const float*)d_in[i];
    a.out = (float*)d_out; a.ws = (unsigned char*)d_ws;
#if PER_PHASE_LAUNCH
    for (int p = 0; p < NPHASE; ++p) { a.ph_lo = p; a.ph_hi = p + 1; hipLaunchKernelGGL(fwd_kernel, dim3(grid), dim3(NTHR), LDS_BYTES, stream, a); }
#else
    a.ph_lo = 0; a.ph_hi = NPHASE; hipLaunchKernelGGL(fwd_kernel, dim3(grid), dim3(NTHR), LDS_BYTES, stream, a);
#endif
}
```
